# Optimizing an MI355X kernel written in HIP

```python
import jax, jax.numpy as jnp
from jax import lax
import numpy as np

D_MODEL = 2048
BATCH = 4
SEQ = 2048
DEPTH = 2

POOL_WIDTH = D_MODEL // 4
POOL_WINDOWS = (2, 4, 8, 16)
POOL_GROUPS = len(POOL_WINDOWS)
POOL_GROUP_DIM = POOL_WIDTH // POOL_GROUPS
SB_HEAD_DIM = 128
SB_WIDTH = D_MODEL // 2
SB_HEADS = SB_WIDTH // SB_HEAD_DIM
Q_BLOCK = 128
HG_HEAD_DIM = 128
HG_WIDTH = D_MODEL // 4
HG_HEADS = HG_WIDTH // HG_HEAD_DIM
HG_CHUNK = 64
LB_FLOOR = 1e-20
N_BRANCH = 3
D_FF = -(-8 * D_MODEL // (3 * 256)) * 256
PLE_DIM = 256
EPS = 1e-6

IN_SPLITS = (POOL_WIDTH, SB_WIDTH, SB_WIDTH, SB_WIDTH,
             HG_WIDTH, HG_WIDTH, HG_WIDTH, HG_WIDTH, N_BRANCH * D_MODEL)
IN_COLS = sum(IN_SPLITS)

kernel_name = "pool_stickbreak_hgrn2_gated_hybrid"


def rms_norm(x, g):
    xf = x.astype(jnp.float32)
    y = xf * lax.rsqrt(jnp.mean(xf * xf, axis=-1, keepdims=True) + EPS)
    return (y * g.astype(jnp.float32)).astype(x.dtype)


def pool_mixer(u, w_group, scale):
    B, S, _ = u.shape
    ug = u.reshape(B, S, POOL_GROUPS, POOL_GROUP_DIM).astype(jnp.float32)
    c = jnp.cumsum(ug, axis=1)
    pos = jnp.arange(S)
    means = []
    for gi, w in enumerate(POOL_WINDOWS):
        cp = jnp.pad(c[:, :, gi], ((0, 0), (w, 0), (0, 0)))
        win_sum = cp[:, w:w + S] - cp[:, :S]
        cnt = jnp.minimum(pos + 1, w).astype(jnp.float32)
        means.append(win_sum / cnt[None, :, None])
    mean = jnp.stack(means, axis=2)
    mixed = (mean - ug).astype(u.dtype)
    y = jnp.einsum('bsgc,gcd->bsgd', mixed, w_group)
    return y.reshape(B, S, POOL_WIDTH) * scale


def stick_breaking_attention(q, k, v):
    S = q.shape[2]
    scale = SB_HEAD_DIM ** -0.5
    outs = []
    for blk in range(S // Q_BLOCK):
        q0 = blk * Q_BLOCK
        kend = q0 + Q_BLOCK
        qb = q[:, :, q0:kend]
        kb = k[:, :, :kend]
        vb = v[:, :, :kend]
        z = jnp.einsum('bhtd,bhsd->bhts', qb, kb).astype(jnp.float32) * scale
        tpos = q0 + jnp.arange(Q_BLOCK)
        spos = jnp.arange(kend)
        mask = spos[None, :] < tpos[:, None]
        log_1mb = jnp.where(mask, jax.nn.log_sigmoid(-z), 0.0)
        later = lax.cumsum(log_1mb, axis=3, reverse=True) - log_1mb
        a = jnp.where(mask, jnp.exp(jax.nn.log_sigmoid(z) + later), 0.0)
        outs.append(jnp.einsum('bhts,bhsd->bhtd', a.astype(v.dtype), vb))
    return jnp.concatenate(outs, axis=2)


def hgrn2_recurrence(q, k, v, log_f):
    B, H, S, Dk = q.shape
    Dv = v.shape[-1]
    n = S // HG_CHUNK

    def to_chunks(a):
        return a.reshape(B, H, n, HG_CHUNK, a.shape[-1]).transpose(2, 0, 1, 3, 4)

    qc, kc, vc, fc = to_chunks(q), to_chunks(k), to_chunks(v), to_chunks(log_f)
    causal = jnp.tril(jnp.ones((HG_CHUNK, HG_CHUNK), dtype=bool))[:, :, None]

    def step(state, inp):
        qi, ki, vi, fi = inp
        b = jnp.cumsum(fi, axis=2)
        o_inter = jnp.einsum('bhtk,bhkv->bhtv', qi * jnp.exp(b), state)
        diff = b[:, :, :, None, :] - b[:, :, None, :, :]
        decay = jnp.where(causal, jnp.exp(jnp.minimum(diff, 0.0)), 0.0)
        scores = jnp.einsum('bhtk,bhsk,bhtsk->bhts', qi, ki, decay)
        o_intra = jnp.einsum('bhts,bhsv->bhtv', scores, vi)
        b_last = b[:, :, -1:, :]
        k_dec = ki * jnp.exp(b_last - b)
        new_state = state * jnp.exp(b_last[:, :, 0, :, None]) + jnp.einsum('bhsk,bhsv->bhkv', k_dec, vi)
        return new_state, o_inter + o_intra

    state0 = jnp.zeros((B, H, Dk, Dv), jnp.float32)
    _, ys = lax.scan(step, state0, (qc, kc, vc, fc))
    return ys.transpose(1, 2, 0, 3, 4).reshape(B, H, S, Dv)


def setup_inputs(seed: int = 0) -> dict:
    key = jax.random.key(seed)
    ks = jax.random.split(key, 20)
    f32 = jnp.float32

    def dense(k, shape, fan_in):
        return jax.random.normal(k, shape, f32) * (fan_in ** -0.5)

    def gain(k, shape):
        return 1.0 + 0.02 * jax.random.normal(k, shape, f32)

    return {
        "x": jax.random.normal(ks[0], (BATCH, SEQ, D_MODEL), f32),
        "p": jax.random.normal(ks[1], (DEPTH, BATCH, SEQ, PLE_DIM), f32),
        "norm_mix": gain(ks[2], (DEPTH, D_MODEL)),
        "w_in": dense(ks[3], (DEPTH, D_MODEL, IN_COLS), D_MODEL),
        "pool_w": dense(ks[4], (DEPTH, POOL_GROUPS, POOL_GROUP_DIM, POOL_GROUP_DIM), POOL_GROUP_DIM),
        "pool_scale": gain(ks[5], (DEPTH, POOL_WIDTH)),
        "hg_lb": 0.1 * jax.random.normal(ks[6], (DEPTH, HG_WIDTH), f32),
        "hg_norm": gain(ks[7], (DEPTH, HG_WIDTH)),
        "w_br_pool": dense(ks[8], (DEPTH, POOL_WIDTH, D_MODEL), POOL_WIDTH),
        "w_br_sb": dense(ks[9], (DEPTH, SB_WIDTH, D_MODEL), SB_WIDTH),
        "w_br_hg": dense(ks[10], (DEPTH, HG_WIDTH, D_MODEL), HG_WIDTH),
        "w_out": dense(ks[11], (DEPTH, D_MODEL, D_MODEL), D_MODEL),
        "norm_ffn": gain(ks[12], (DEPTH, D_MODEL)),
        "w_gate_up": dense(ks[13], (DEPTH, D_MODEL, 2 * D_FF), D_MODEL),
        "w_down": dense(ks[14], (DEPTH, D_FF, D_MODEL), D_FF),
        "norm_ple": gain(ks[15], (DEPTH, D_MODEL)),
        "w_ple_gate": dense(ks[16], (DEPTH, D_MODEL, D_MODEL), D_MODEL),
        "w_ple_proj": dense(ks[17], (DEPTH, PLE_DIM, D_MODEL), PLE_DIM),
        "norm_final": gain(ks[18], (D_MODEL,)),
    }


def reference(x, p, norm_mix, w_in, pool_w, pool_scale, hg_lb, hg_norm, w_br_pool, w_br_sb, w_br_hg,
              w_out, norm_ffn, w_gate_up, w_down, norm_ple, w_ple_gate, w_ple_proj, norm_final):
    B, S, _ = x.shape
    split_points = [int(c) for c in np.cumsum(IN_SPLITS)[:-1]]

    def heads(t, n):
        return t.reshape(B, S, n, -1).transpose(0, 2, 1, 3)

    def merge(t):
        return t.transpose(0, 2, 1, 3).reshape(B, S, -1)

    lb_sm = jax.nn.softmax(hg_lb.astype(jnp.float32), axis=0)
    lower_bounds = jnp.cumsum(lb_sm, axis=0) - lb_sm[0:1]

    for i in range(DEPTH):
        h = rms_norm(x, norm_mix[i])
        proj = h @ w_in[i]
        u_pool, sq, sk, sv, zf, hv, hq, og, gl = jnp.split(proj, split_points, axis=-1)

        y_pool = pool_mixer(u_pool, pool_w[i], pool_scale[i])

        y_sb = merge(stick_breaking_attention(heads(sq, SB_HEADS), heads(sk, SB_HEADS), heads(sv, SB_HEADS)))

        lb = jnp.clip(lower_bounds[i], 0.0, 1.0)
        zf32 = zf.astype(jnp.float32)
        log_f = jnp.logaddexp(jnp.log(jnp.maximum(lb, LB_FLOOR)),
                              jnp.log1p(-jnp.minimum(lb, 1.0 - 1e-6)) + jax.nn.log_sigmoid(zf32))
        k_in = (1.0 - lb) * jax.nn.sigmoid(-zf32)
        q_hg = jax.nn.silu(hq.astype(jnp.float32))
        o = hgrn2_recurrence(heads(q_hg, HG_HEADS), heads(k_in, HG_HEADS),
                             heads(hv.astype(jnp.float32), HG_HEADS), heads(log_f, HG_HEADS))
        o = o * lax.rsqrt(jnp.mean(o * o, axis=-1, keepdims=True) + EPS)
        y_hg = (merge(o) * hg_norm[i].astype(jnp.float32) * jax.nn.silu(og.astype(jnp.float32))).astype(x.dtype)

        gates = jax.nn.sigmoid(gl).reshape(B, S, N_BRANCH, D_MODEL)
        mixed = (gates[:, :, 0] * (y_pool @ w_br_pool[i])
                 + gates[:, :, 1] * (y_sb @ w_br_sb[i])
                 + gates[:, :, 2] * (y_hg @ w_br_hg[i]))
        x = x + mixed @ w_out[i]

        h = rms_norm(x, norm_ffn[i])
        g_ff, u_ff = jnp.split(h @ w_gate_up[i], 2, axis=-1)
        x = x + (jax.nn.silu(g_ff) * u_ff) @ w_down[i]

        ple_gate = jax.nn.sigmoid(rms_norm(x, norm_ple[i]) @ w_ple_gate[i])
        x = x + ple_gate * (p[i] @ w_ple_proj[i])

    return rms_norm(x, norm_final)
```

```cpp
#include <hip/hip_runtime.h>
#include <hip/hip_cooperative_groups.h>
#include <cstdio>
#include <cstdint>
namespace cg = cooperative_groups;

#ifndef PHMASK
#define PHMASK 0xFFFF
#endif
#ifndef REP_MASK
#define REP_MASK 0
#endif
#ifndef EXTRA_SYNCS
#define EXTRA_SYNCS 0
#endif
#ifndef CHAIN_TWICE
#define CHAIN_TWICE 0
#endif
#ifndef MK_MULTI
#define MK_MULTI 0
#endif

typedef unsigned short bf16_t;
typedef short bf16x8 __attribute__((ext_vector_type(8)));
typedef short s16x4 __attribute__((ext_vector_type(4)));
typedef float f32x4 __attribute__((ext_vector_type(4)));
typedef float f32x16 __attribute__((ext_vector_type(16)));
typedef unsigned u32x4 __attribute__((ext_vector_type(4)));
typedef unsigned u32x2 __attribute__((ext_vector_type(2)));

constexpr int TT = 8192, DM = 2048, SEQ = 2048, INC = 11776, DFF = 5632, PLE = 256, NLAYER = 2;
constexpr float EPS = 1e-6f;

__device__ __forceinline__ unsigned cvt_pk_bf16(float lo, float hi) { unsigned r; asm volatile("v_cvt_pk_bf16_f32 %0, %1, %2" : "=v"(r) : "v"(lo), "v"(hi)); return r; }
__device__ __forceinline__ float bf2f(unsigned short b) { return __uint_as_float(((unsigned)b) << 16); }
__device__ __forceinline__ float bflo(unsigned w) { return __uint_as_float(w << 16); }
__device__ __forceinline__ float bfhi(unsigned w) { return __uint_as_float(w & 0xffff0000u); }
__device__ __forceinline__ float sigmoidf_(float x) { return 1.0f / (1.0f + __expf(-x)); }
__device__ __forceinline__ bf16x8 pack8(float a0, float a1, float a2, float a3, float a4, float a5, float a6, float a7) {
    u32x4 w; w.x = cvt_pk_bf16(a0, a1); w.y = cvt_pk_bf16(a2, a3); w.z = cvt_pk_bf16(a4, a5); w.w = cvt_pk_bf16(a6, a7);
    return __builtin_bit_cast(bf16x8, w);
}
__device__ __forceinline__ int crow(int r, int hi) { return (r & 3) + 8 * (r >> 2) + 4 * hi; }
__device__ __forceinline__ int opaque_tid() { int t = threadIdx.x; asm volatile("" : "+v"(t)); return t; }
__device__ __forceinline__ float shflx(float v, int m, int lane) { return __int_as_float(__builtin_amdgcn_ds_bpermute((lane ^ m) << 2, __float_as_int(v))); }
#define MFMA32(a, b, c) __builtin_amdgcn_mfma_f32_32x32x16_bf16((a), (b), (c), 0, 0, 0)

namespace pg8 {
#define PG8_LAS __attribute__((address_space(3)))
constexpr int BM = 256, BK = 64, HALF = 128, HTB = HALF * BK * 2, STAGE_BYTES = 8 * HTB, NXCD = 8, WGM = 8;
__host__ __device__ __forceinline__ int lds_byte(int r, int c) { const int st = (r >> 4) * 2 + (c >> 5), rr = r & 15, cc = c & 31, ob = rr * 64 + cc * 2; return st * 1024 + (ob ^ (((ob >> 9) & 1) << 5)); }
__host__ __device__ __forceinline__ void stage_rc(int b, int& R, int& C) { const int st = b / 1024, sb = b % 1024, swz = sb ^ (((sb >> 9) & 1) << 5); R = (st >> 1) * 16 + swz / 64; C = (st & 1) * 32 + (swz % 64) / 2; }
__host__ __device__ __forceinline__ int perm32(int rho) { const int n = rho >> 4, i = rho & 15; return 8 * (i >> 2) + 4 * n + (i & 3); }

struct Unit { int pm, pn, kind; };
struct Gemm { const bf16_t* A; const bf16_t* Bt; int M, N, lda, ldb; int nseg; int kofs0, kofs1, kofs2; int nt0, nt1, nt2; };

struct StaticOrder {
    int nM, nN, nwg, G, c, nseg;
    __device__ void init(int M, int N, int G_, int c_, int nseg_) { nM = M / BM; nN = N / BM; nwg = nM * nN; G = G_; c = c_; nseg = nseg_; }
    __device__ bool next(int i, Unit& u) const {
        int j = i, kd = 0; if (nseg == 3) { j = i / 3; kd = i - 3 * j; }
        u.kind = kd;
        const long L = (long)j * G + c; if (L >= nwg) return false;
        int wgid = (int)L; { const int q = nwg / NXCD, r = nwg % NXCD, xcd = wgid % NXCD, off = wgid / NXCD; wgid = (xcd < r ? xcd * (q + 1) : r * (q + 1) + (xcd - r) * q) + off; }
        const int nig = WGM * nN, gid = wgid / nig, fm = gid * WGM, gsz = (nM - fm) < WGM ? (nM - fm) : WGM;
        u.pm = fm + ((wgid % nig) % gsz); u.pn = (wgid % nig) / gsz; return true;
    }
};

struct OneUnit { int pm, pn; __device__ bool next(int i, Unit& u) const { u.pm = pm; u.pn = pn; u.kind = 0; return i == 0; } };
template <class Epi, class Sched>
__device__ __forceinline__ void gemm_phase(PG8_LAS unsigned char* lds, const Gemm g, const Sched& S, const Epi& E) {
    const int tid = opaque_tid(), wid = __builtin_amdgcn_readfirstlane(tid >> 6), lane = tid & 63, wr = wid >> 2, wc = wid & 3, fr = lane & 15, fq = lane >> 4;
    unsigned voffA, voffB;
    { int R, C; stage_rc(tid * 16, R, C); const int Rb = (R & ~31) + perm32(R & 31);
      voffA = (unsigned)(R * g.lda + C) * 2u; voffB = (unsigned)(Rb * g.ldb + C) * 2u; }
    const size_t qstepoffA = (size_t)64 * g.lda * 2, qstepoffB = (size_t)64 * g.ldb * 2;
    const size_t kstep = (size_t)(BK * 2);
    const size_t hstepA = (size_t)HALF * g.lda * 2, hstepB = (size_t)HALF * g.ldb * 2;
    const size_t tstepA = 2 * hstepA, tstepB = 2 * hstepB;
    const unsigned ldsw = (unsigned)wid * 1024u;
    const int aoff = lds_byte(wr * 64 + fr, fq * 8), boff = lds_byte(wc * 32 + fr, fq * 8);
#define PG8_SA(b, h) (((b) * 2 + (h)) * HTB)
#define PG8_SB(b, h) ((4 + (b) * 2 + (h)) * HTB)
#define PG8_STAGE(bufoff, gbase, voff) do { _Pragma("unroll") for (int _i = 0; _i < 2; ++_i) \
        __builtin_amdgcn_global_load_lds((const unsigned*)((const char*)(gbase) + (size_t)_i * qstep##voff + v##voff), (PG8_LAS unsigned*)(lds + (bufoff) + ldsw + _i * 8192), 16, 0, 0); } while (0)
#define PG8_LDA(dst, b, h) do { _Pragma("unroll") for (int m = 0; m < 4; ++m) _Pragma("unroll") for (int k = 0; k < 2; ++k) dst[m][k] = *(const PG8_LAS bf16x8*)(lds + PG8_SA(b, h) + aoff + m * 2048 + k * 1024); } while (0)
#define PG8_LDB(dst, b, h) do { _Pragma("unroll") for (int n = 0; n < 2; ++n) _Pragma("unroll") for (int k = 0; k < 2; ++k) dst[n][k] = *(const PG8_LAS bf16x8*)(lds + PG8_SB(b, h) + boff + n * 2048 + k * 1024); } while (0)
#define PG8_MMA(ai, bj, At, Bt) do { __builtin_amdgcn_s_setprio(1); _Pragma("unroll") for (int m = 0; m < 4; ++m) _Pragma("unroll") for (int n = 0; n < 2; ++n) _Pragma("unroll") for (int k = 0; k < 2; ++k) \
        acc[ai][bj][m][n] = __builtin_amdgcn_mfma_f32_16x16x32_bf16(Bt[n][k], At[m][k], acc[ai][bj][m][n], 0, 0, 0); __builtin_amdgcn_s_setprio(0); } while (0)
#define PG8_WAIT_V(n) asm volatile("s_waitcnt vmcnt(" #n ")" ::: "memory")
#define PG8_WAIT_L(n) asm volatile("s_waitcnt lgkmcnt(" #n ")" ::: "memory")
#define PG8_BAR __builtin_amdgcn_s_barrier()
#define PG8_SCHED __builtin_amdgcn_sched_barrier(0)
#define PG8_KOFS(u) ((u).kind == 0 ? g.kofs0 : ((u).kind == 1 ? g.kofs1 : g.kofs2))
#define PG8_NT(u) ((u).kind == 0 ? g.nt0 : ((u).kind == 1 ? g.nt1 : g.nt2))
    Unit cur, nxt; int ui = 0;
    if (!S.next(0, cur)) return;
    f32x4 acc[2][2][4][2];
#pragma unroll
    for (int a = 0; a < 2; ++a)
#pragma unroll
        for (int b = 0; b < 2; ++b)
#pragma unroll
            for (int m = 0; m < 4; ++m)
#pragma unroll
                for (int n = 0; n < 2; ++n) acc[a][b][m][n] = (f32x4){0.f, 0.f, 0.f, 0.f};
    bf16x8 At[4][2], B0[2][2], B1[2][2];
    const char* cA = (const char*)g.A + (size_t)cur.pm * tstepA + (size_t)PG8_KOFS(cur) * 2; const char* cB = (const char*)g.Bt + (size_t)cur.pn * tstepB + (size_t)PG8_KOFS(cur) * 2;
    PG8_STAGE(PG8_SB(0, 0), cB, offB); PG8_STAGE(PG8_SB(0, 1), cB + hstepB, offB); PG8_STAGE(PG8_SA(0, 0), cA, offA); PG8_STAGE(PG8_SA(0, 1), cA + hstepA, offA);
    if (wr == 1) PG8_BAR;
    PG8_WAIT_V(2); PG8_BAR;
    PG8_STAGE(PG8_SB(1, 0), cB + kstep, offB); PG8_STAGE(PG8_SA(1, 0), cA + kstep, offA); PG8_STAGE(PG8_SB(1, 1), cB + hstepB + kstep, offB);
    PG8_WAIT_V(6); PG8_BAR;
    for (;;) {
        const bool has_next = S.next(ui + 1, nxt);
        const char* nA = has_next ? (const char*)g.A + (size_t)nxt.pm * tstepA + (size_t)PG8_KOFS(nxt) * 2 : cA;
        const char* nB = has_next ? (const char*)g.Bt + (size_t)nxt.pn * tstepB + (size_t)PG8_KOFS(nxt) * 2 : cB;
        const int nt = PG8_NT(cur);
        for (int t = 0; t < nt; t += 2) {
            const bool last = (t == nt - 2);
            const char* a1 = cA + (size_t)(t + 1) * kstep;
            const char* a2 = last ? nA : cA + (size_t)(t + 2) * kstep; const char* b2 = last ? nB : cB + (size_t)(t + 2) * kstep;
            const char* a3 = a2 + kstep; const char* b3 = b2 + kstep;
            PG8_LDB(B0, 0, 0); PG8_LDB(B1, 0, 1); PG8_SCHED; PG8_LDA(At, 0, 0); PG8_STAGE(PG8_SA(1, 1), a1 + hstepA, offA);
            PG8_WAIT_V(8); PG8_WAIT_L(0); PG8_BAR; PG8_MMA(0, 0, At, B0); PG8_MMA(0, 1, At, B1); PG8_BAR; PG8_SCHED;
            PG8_LDA(At, 0, 1); PG8_STAGE(PG8_SB(0, 0), b2, offB); PG8_STAGE(PG8_SB(0, 1), b2 + hstepB, offB); PG8_STAGE(PG8_SA(0, 0), a2, offA);
            PG8_WAIT_V(8); PG8_WAIT_L(0); PG8_BAR; PG8_MMA(1, 0, At, B0); PG8_MMA(1, 1, At, B1); PG8_BAR; PG8_SCHED;
            PG8_LDB(B0, 1, 0); PG8_LDB(B1, 1, 1); PG8_SCHED; PG8_LDA(At, 1, 0); PG8_STAGE(PG8_SA(0, 1), a2 + hstepA, offA);
            PG8_WAIT_V(8); PG8_WAIT_L(0); PG8_BAR; PG8_MMA(0, 0, At, B0); PG8_MMA(0, 1, At, B1); PG8_BAR; PG8_SCHED;
            PG8_LDA(At, 1, 1); PG8_STAGE(PG8_SB(1, 0), b3, offB); PG8_STAGE(PG8_SB(1, 1), b3 + hstepB, offB); PG8_STAGE(PG8_SA(1, 0), a3, offA);
            PG8_WAIT_V(8); PG8_WAIT_L(0); PG8_BAR; PG8_MMA(1, 0, At, B0); PG8_MMA(1, 1, At, B1); PG8_BAR; PG8_SCHED;
        }
        if (wr == 0) PG8_BAR;
        const bool keep = E(acc, cur, wr, wc, fr, fq);
        if (!has_next) break;
        if (!keep) {
#pragma unroll
        for (int a = 0; a < 2; ++a)
#pragma unroll
            for (int b = 0; b < 2; ++b)
#pragma unroll
                for (int m = 0; m < 4; ++m)
#pragma unroll
                    for (int n = 0; n < 2; ++n) acc[a][b][m][n] = (f32x4){0.f, 0.f, 0.f, 0.f};
        }
        cur = nxt; cA = nA; cB = nB; ++ui;
        if (wr == 1) PG8_BAR;
    }
    PG8_WAIT_V(0);
    PG8_BAR;
#undef PG8_SA
#undef PG8_SB
#undef PG8_STAGE
#undef PG8_LDA
#undef PG8_LDB
#undef PG8_MMA
#undef PG8_WAIT_V
#undef PG8_WAIT_L
#undef PG8_BAR
#undef PG8_SCHED
#undef PG8_KOFS
#undef PG8_NT
}
}

constexpr size_t MiB = 1u << 20;
constexpr size_t WS_CTL = 0;
constexpr size_t WS_W0 = 1 * MiB;
constexpr size_t WL_IN = 0, WL_BR = 46 * MiB, WL_OUT = 54 * MiB, WL_GU = 62 * MiB, WL_DN = 106 * MiB, WL_PG = 128 * MiB, WL_PP = 136 * MiB, WL_SIZE = 137 * MiB;
constexpr size_t WS_H = WS_W0 + 2 * WL_SIZE;
constexpr size_t WS_X = WS_H + 32 * MiB;
constexpr size_t WS_U = WS_X + 64 * MiB;
constexpr size_t WS_SQ = WS_U + 16 * MiB;
constexpr size_t WS_SK = WS_SQ + 16 * MiB;
constexpr size_t WS_VT = WS_SK + 16 * MiB;
constexpr size_t WS_ZF = WS_VT + 16 * MiB;
constexpr size_t WS_HV = WS_ZF + 16 * MiB;
constexpr size_t WS_HQ = WS_HV + 8 * MiB;
constexpr size_t WS_OG = WS_HQ + 16 * MiB;
constexpr size_t WS_GT = WS_OG + 8 * MiB;
constexpr size_t WS_ACT = WS_GT;
constexpr size_t WS_Y = WS_GT + 96 * MiB;
constexpr size_t WS_MIX = WS_Y + 32 * MiB;
constexpr size_t WS_PB = WS_MIX + 32 * MiB;
constexpr size_t WS_HVT = WS_PB + 8 * MiB;
constexpr size_t WS_HDEC = WS_HVT + 8 * MiB;
constexpr size_t WS_HB = WS_HDEC + 1 * MiB;
constexpr size_t WS_PPB = WS_HB + 32 * MiB;
constexpr size_t WS_END = WS_PPB + 32 * MiB;
constexpr size_t WS_HOI = WS_MIX;
constexpr size_t WS_HQD = WS_MIX + 16 * MiB;
constexpr size_t WS_HKD = WS_MIX + 24 * MiB;
constexpr size_t CTL_SS = 65536;
constexpr size_t CTL_ZERO = CTL_SS + 7 * TT * 4;

constexpr int LDS_PSUM_OFF = 132096;
typedef f32x4 AccT[2][2][4][2];
#define EPI_LOOP_BEGIN  const int row0_ = u.pm * 256 + wr * 64 + fr; \
    _Pragma("unroll") for (int ai = 0; ai < 2; ++ai) _Pragma("unroll") for (int m = 0; m < 4; ++m) { const int row = row0_ + ai * 128 + m * 16; \
    _Pragma("unroll") for (int bj = 0; bj < 2; ++bj) { const int col = u.pn * 256 + bj * 128 + wc * 32 + 8 * fq; f32x4 v0 = acc[ai][bj][m][0], v1 = acc[ai][bj][m][1];
#define EPI_LOOP_END }}
__device__ __forceinline__ float rstd_of(float ss) { return 1.0f / sqrtf(ss * (1.0f / DM) + EPS); }
__device__ __forceinline__ float rstd_row(const float* SSP, int row) { const f32x4 a = *(const f32x4*)(SSP + (size_t)row * 8), b = *(const f32x4*)(SSP + (size_t)row * 8 + 4);
    return rstd_of(((a[0] + a[1]) + (a[2] + a[3])) + ((b[0] + b[1]) + (b[2] + b[3]))); }
__device__ __forceinline__ void ps_write(int rit, int wc, float sq) {
    extern __shared__ __attribute__((aligned(16))) unsigned char lds_e_[];
    ((float*)(lds_e_ + LDS_PSUM_OFF))[rit * 4 + wc] = sq;
}
__device__ __forceinline__ void ps_finish(float* SSP, const pg8::Unit& u, int wr, int wc, int fr, int fq) {
    extern __shared__ __attribute__((aligned(16))) unsigned char lds_e_[];
    const float* PS = (const float*)(lds_e_ + LDS_PSUM_OFF);
    asm volatile("s_waitcnt lgkmcnt(0)" ::: "memory"); __builtin_amdgcn_s_barrier(); asm volatile("" ::: "memory");
    const int t_ = (wr * 4 + wc) * 64 + fq * 16 + fr;
    if (t_ < 256) { const f32x4 p = *(const f32x4*)(PS + t_ * 4); SSP[(size_t)(u.pm * 256 + t_) * 8 + u.pn] = (p[0] + p[1]) + (p[2] + p[3]); }
}
#define EPI_LOOP_BEGIN_R(SSP)  const int row0_ = u.pm * 256 + wr * 64 + fr; \
    _Pragma("unroll") for (int ai = 0; ai < 2; ++ai) _Pragma("unroll") for (int m = 0; m < 4; ++m) { const int row = row0_ + ai * 128 + m * 16; const float rs_ = rstd_row((SSP), row); \
    _Pragma("unroll") for (int bj = 0; bj < 2; ++bj) { const int col = u.pn * 256 + bj * 128 + wc * 32 + 8 * fq; f32x4 v0 = acc[ai][bj][m][0] * rs_, v1 = acc[ai][bj][m][1] * rs_;

__device__ __forceinline__ u32x4 pack8v(f32x4 v0, f32x4 v1) { u32x4 w; w.x = cvt_pk_bf16(v0[0], v0[1]); w.y = cvt_pk_bf16(v0[2], v0[3]); w.z = cvt_pk_bf16(v1[0], v1[1]); w.w = cvt_pk_bf16(v1[2], v1[3]); return w; }

struct EpiIn {
    unsigned char* ws; int ssofs;
    __device__ __forceinline__ bool operator()(AccT& acc, const pg8::Unit& u, int wr, int wc, int fr, int fq) const {
        float* U = (float*)(ws + WS_U); bf16_t* SQ = (bf16_t*)(ws + WS_SQ); bf16_t* SK = (bf16_t*)(ws + WS_SK); bf16_t* VT = (bf16_t*)(ws + WS_VT); float* ZF = (float*)(ws + WS_ZF);
        bf16_t* HV = (bf16_t*)(ws + WS_HV); float* HQ = (float*)(ws + WS_HQ); bf16_t* OG = (bf16_t*)(ws + WS_OG); bf16_t* GT = (bf16_t*)(ws + WS_GT);
        const float* SS = (const float*)(ws + WS_X) + (size_t)ssofs * 8; const float qscale = 0.08838834764831845f * 1.4426950408889634f;
        const int colt = u.pn * 256;
        if (colt < 512) {
            EPI_LOOP_BEGIN_R(SS) float* p = U + (size_t)row * 512 + col; *(f32x4*)p = v0; *(f32x4*)(p + 4) = v1; EPI_LOOP_END
        } else if (colt < 1536) {
            const float s = qscale;
            EPI_LOOP_BEGIN_R(SS) *(u32x4*)(SQ + (size_t)row * 1024 + (col - 512)) = pack8v(v0 * s, v1 * s); EPI_LOOP_END
        } else if (colt < 2560) {
            EPI_LOOP_BEGIN_R(SS) *(u32x4*)(SK + (size_t)row * 1024 + (col - 1536)) = pack8v(v0, v1); EPI_LOOP_END
        } else if (colt < 3584) {
            EPI_LOOP_BEGIN_R(SS) const int cc = col - 2560, hh = cc >> 7, d = cc & 127, b = row >> 11, s = row & 2047;
                bf16_t* p = VT + (((size_t)(b * 8 + hh) * 128 + d) << 11) + s; const u32x4 w = pack8v(v0, v1);
                p[0] = (bf16_t)(w.x & 0xffff); p[2048] = (bf16_t)(w.x >> 16); p[2 * 2048] = (bf16_t)(w.y & 0xffff); p[3 * 2048] = (bf16_t)(w.y >> 16);
                p[4 * 2048] = (bf16_t)(w.z & 0xffff); p[5 * 2048] = (bf16_t)(w.z >> 16); p[6 * 2048] = (bf16_t)(w.w & 0xffff); p[7 * 2048] = (bf16_t)(w.w >> 16); EPI_LOOP_END
        } else if (colt < 4096) {
            EPI_LOOP_BEGIN_R(SS) float* p = ZF + (size_t)row * 512 + (col - 3584); *(f32x4*)p = v0; *(f32x4*)(p + 4) = v1; EPI_LOOP_END
        } else if (colt < 4608) {
            EPI_LOOP_BEGIN_R(SS) *(u32x4*)(HV + (size_t)row * 512 + (col - 4096)) = pack8v(v0, v1); EPI_LOOP_END
        } else if (colt < 5120) {
            EPI_LOOP_BEGIN_R(SS)
#pragma unroll
                for (int j = 0; j < 4; ++j) { v0[j] = v0[j] * sigmoidf_(v0[j]); v1[j] = v1[j] * sigmoidf_(v1[j]); }
                float* p = HQ + (size_t)row * 512 + (col - 4608); *(f32x4*)p = v0; *(f32x4*)(p + 4) = v1; EPI_LOOP_END
        } else if (colt < 5632) {
            EPI_LOOP_BEGIN_R(SS)
#pragma unroll
                for (int j = 0; j < 4; ++j) { v0[j] = v0[j] * sigmoidf_(v0[j]); v1[j] = v1[j] * sigmoidf_(v1[j]); }
                *(u32x4*)(OG + (size_t)row * 512 + (col - 5120)) = pack8v(v0, v1); EPI_LOOP_END
        } else {
            EPI_LOOP_BEGIN_R(SS)
#pragma unroll
                for (int j = 0; j < 4; ++j) { v0[j] = sigmoidf_(v0[j]); v1[j] = sigmoidf_(v1[j]); }
                *(u32x4*)(GT + (size_t)row * 6144 + (col - 5632)) = pack8v(v0, v1); EPI_LOOP_END
        }
        return false;
    }
};
struct EpiBranch {
    unsigned char* ws;
    __device__ __forceinline__ bool operator()(AccT& acc, const pg8::Unit& u, int wr, int wc, int fr, int fq) const {
        const bf16_t* GT = (const bf16_t*)(ws + WS_GT); bf16_t* MIX = (bf16_t*)(ws + WS_MIX);
        const int kind = u.kind;
        const int row0_ = u.pm * 256 + wr * 64 + fr;
#pragma unroll
        for (int ai = 0; ai < 2; ++ai)
#pragma unroll
            for (int m = 0; m < 4; ++m) { const int row = row0_ + ai * 128 + m * 16;
#pragma unroll
                for (int bj = 0; bj < 2; ++bj) { const int col = u.pn * 256 + bj * 128 + wc * 32 + 8 * fq;
                    const u32x4 ga = *(const u32x4*)(GT + (size_t)row * 6144 + kind * 2048 + col);
                    float a[8] = {bflo(ga.x), bfhi(ga.x), bflo(ga.y), bfhi(ga.y), bflo(ga.z), bfhi(ga.z), bflo(ga.w), bfhi(ga.w)};
#pragma unroll
                    for (int j = 0; j < 8; ++j) a[j] = fmaxf(a[j], 1e-30f);
                    if (kind < 2) {
                        const u32x4 gb = *(const u32x4*)(GT + (size_t)row * 6144 + (kind + 1) * 2048 + col);
                        float b[8] = {bflo(gb.x), bfhi(gb.x), bflo(gb.y), bfhi(gb.y), bflo(gb.z), bfhi(gb.z), bflo(gb.w), bfhi(gb.w)};
#pragma unroll
                        for (int j = 0; j < 8; ++j) { const float rr = a[j] / fmaxf(b[j], 1e-30f); if (j < 4) acc[ai][bj][m][0][j] *= rr; else acc[ai][bj][m][1][j - 4] *= rr; }
                    } else {
                        f32x4 v0 = acc[ai][bj][m][0], v1 = acc[ai][bj][m][1];
#pragma unroll
                        for (int j = 0; j < 4; ++j) { v0[j] *= a[j]; v1[j] *= a[j + 4]; }
                        *(u32x4*)(MIX + (size_t)row * 2048 + col) = pack8v(v0, v1);
                    }
                } }
        return kind < 2;
    }
};
struct EpiResid {
    unsigned char* ws; int rboff, xboff, ssofs;
    __device__ __forceinline__ bool operator()(AccT& acc, const pg8::Unit& u, int wr, int wc, int fr, int fq) const {
        const bf16_t* RB = (const bf16_t*)(ws + WS_H + (size_t)rboff); bf16_t* XB = (bf16_t*)(ws + WS_H + (size_t)xboff); float* SSO = (float*)(ws + WS_X) + (size_t)ssofs * 8;
        const int row0_ = u.pm * 256 + wr * 64 + fr;
#pragma unroll
        for (int ai = 0; ai < 2; ++ai)
#pragma unroll
            for (int m = 0; m < 4; ++m) { const int row = row0_ + ai * 128 + m * 16; float sq = 0.f;
#pragma unroll
                for (int bj = 0; bj < 2; ++bj) { const int col = u.pn * 256 + bj * 128 + wc * 32 + 8 * fq; const size_t o = (size_t)row * 2048 + col;
                    const u32x4 rw = *(const u32x4*)(RB + o); f32x4 v0 = acc[ai][bj][m][0], v1 = acc[ai][bj][m][1];
                    v0[0] += bflo(rw.x); v0[1] += bfhi(rw.x); v0[2] += bflo(rw.y); v0[3] += bfhi(rw.y); v1[0] += bflo(rw.z); v1[1] += bfhi(rw.z); v1[2] += bflo(rw.w); v1[3] += bfhi(rw.w);
                    *(u32x4*)(XB + o) = pack8v(v0, v1);
                    sq += (v0[0] * v0[0] + v0[1] * v0[1]) + (v0[2] * v0[2] + v0[3] * v0[3]) + (v1[0] * v1[0] + v1[1] * v1[1]) + (v1[2] * v1[2] + v1[3] * v1[3]); }
                sq += shflx(sq, 16, fr + 16 * fq); sq += shflx(sq, 32, fr + 16 * fq); if (fq == 0) ps_write(ai * 128 + wr * 64 + m * 16 + fr, wc, sq); }
        ps_finish(SSO, u, wr, wc, fr, fq);
        return false;
    }
};
struct EpiSwiglu {
    unsigned char* ws; int ssofs;
    __device__ __forceinline__ bool operator()(AccT& acc, const pg8::Unit& u, int wr, int wc, int fr, int fq) const {
        bf16_t* ACT = (bf16_t*)(ws + WS_ACT); const float* SS = (const float*)(ws + WS_X) + (size_t)ssofs * 8;
        const int row0_ = u.pm * 256 + wr * 64 + fr;
#pragma unroll
        for (int ai = 0; ai < 2; ++ai)
#pragma unroll
            for (int m = 0; m < 4; ++m) { const int row = row0_ + ai * 128 + m * 16; const int col = u.pn * 128 + wc * 32 + 8 * fq; const float rs_ = rstd_row(SS, row);
                f32x4 g0 = acc[ai][0][m][0] * rs_, g1 = acc[ai][0][m][1] * rs_; const f32x4 u0 = acc[ai][1][m][0] * rs_, u1 = acc[ai][1][m][1] * rs_;
#pragma unroll
                for (int j = 0; j < 4; ++j) { g0[j] = g0[j] * sigmoidf_(g0[j]) * u0[j]; g1[j] = g1[j] * sigmoidf_(g1[j]) * u1[j]; }
                *(u32x4*)(ACT + (size_t)row * DFF + col) = pack8v(g0, g1); }
        return false;
    }
};
struct EpiBf16 {
    unsigned char* ws;
    __device__ __forceinline__ bool operator()(AccT& acc, const pg8::Unit& u, int wr, int wc, int fr, int fq) const {
        bf16_t* OUT = (bf16_t*)(ws + WS_PPB);
        EPI_LOOP_BEGIN *(u32x4*)(OUT + (size_t)row * 2048 + col) = pack8v(v0, v1); EPI_LOOP_END
        return false;
    }
};
struct EpiPle {
    unsigned char* ws; int ssofs;
    __device__ __forceinline__ bool operator()(AccT& acc, const pg8::Unit& u, int wr, int wc, int fr, int fq) const {
        const bf16_t* RB = (const bf16_t*)(ws + WS_HB); const bf16_t* PP = (const bf16_t*)(ws + WS_PPB); bf16_t* XB = (bf16_t*)(ws + WS_H);
        const float* SS = (const float*)(ws + WS_X) + (size_t)ssofs * 8; float* SSO = (float*)(ws + WS_X) + (size_t)(ssofs + TT) * 8;
        const int row0_ = u.pm * 256 + wr * 64 + fr;
#pragma unroll
        for (int ai = 0; ai < 2; ++ai)
#pragma unroll
            for (int m = 0; m < 4; ++m) { const int row = row0_ + ai * 128 + m * 16; const float rs_ = rstd_row(SS, row); float sq = 0.f;
#pragma unroll
                for (int bj = 0; bj < 2; ++bj) { const int col = u.pn * 256 + bj * 128 + wc * 32 + 8 * fq; const size_t o = (size_t)row * 2048 + col;
                    const u32x4 rw = *(const u32x4*)(RB + o); const u32x4 pw = *(const u32x4*)(PP + o);
                    f32x4 v0 = acc[ai][bj][m][0] * rs_, v1 = acc[ai][bj][m][1] * rs_;
                    v0[0] = bflo(rw.x) + sigmoidf_(v0[0]) * bflo(pw.x); v0[1] = bfhi(rw.x) + sigmoidf_(v0[1]) * bfhi(pw.x); v0[2] = bflo(rw.y) + sigmoidf_(v0[2]) * bflo(pw.y); v0[3] = bfhi(rw.y) + sigmoidf_(v0[3]) * bfhi(pw.y);
                    v1[0] = bflo(rw.z) + sigmoidf_(v1[0]) * bflo(pw.z); v1[1] = bfhi(rw.z) + sigmoidf_(v1[1]) * bfhi(pw.z); v1[2] = bflo(rw.w) + sigmoidf_(v1[2]) * bflo(pw.w); v1[3] = bfhi(rw.w) + sigmoidf_(v1[3]) * bfhi(pw.w);
                    *(u32x4*)(XB + o) = pack8v(v0, v1);
                    sq += (v0[0] * v0[0] + v0[1] * v0[1]) + (v0[2] * v0[2] + v0[3] * v0[3]) + (v1[0] * v1[0] + v1[1] * v1[1]) + (v1[2] * v1[2] + v1[3] * v1[3]); }
                sq += shflx(sq, 16, fr + 16 * fq); sq += shflx(sq, 32, fr + 16 * fq); if (fq == 0) ps_write(ai * 128 + wr * 64 + m * 16 + fr, wc, sq); }
        ps_finish(SSO, u, wr, wc, fr, fq);
        return false;
    }
};

constexpr int LDS_MISC = 131072, LDS_PSUM = 132096, LDS_BYTES = 132096 + 4096;
constexpr int PPL = 8;
constexpr int NPHASE = 2 + PPL * NLAYER;

struct Args { const float* in[19]; float* out; unsigned char* ws; int ph_lo, ph_hi; };

__device__ __forceinline__ float wave_sum(float v, int lane) {
#pragma unroll
    for (int o = 1; o < 64; o <<= 1) v += shflx(v, o, lane);
    return v;
}
template <bool F32OUT>
__device__ __forceinline__ void rmsnorm_rows(const float* X, const float* G, bf16_t* OB, float* OF) {
    const int tid_ = opaque_tid(); const int lane = tid_ & 63, gw = blockIdx.x * 8 + (tid_ >> 6), ngw = gridDim.x * 8;
    for (int row = gw; row < TT; row += ngw) {
        const f32x4* xr = (const f32x4*)(X + (size_t)row * DM) + lane;
        f32x4 v[8]; float s = 0.f;
#pragma unroll
        for (int j = 0; j < 8; ++j) { v[j] = xr[64 * j]; s += (v[j][0] * v[j][0] + v[j][1] * v[j][1]) + (v[j][2] * v[j][2] + v[j][3] * v[j][3]); }
        const float rstd = 1.0f / sqrtf(wave_sum(s, lane) * (1.0f / DM) + EPS);
#pragma unroll
        for (int j = 0; j < 8; ++j) { const f32x4 gg = ((const f32x4*)G)[lane + 64 * j]; const f32x4 y = v[j] * rstd * gg;
            if (F32OUT) ((f32x4*)(OF + (size_t)row * DM))[lane + 64 * j] = y;
            else { u32x2 w; w.x = cvt_pk_bf16(y[0], y[1]); w.y = cvt_pk_bf16(y[2], y[3]); ((u32x2*)(OB + (size_t)row * DM))[lane + 64 * j] = w; } }
    }
}

__device__ __forceinline__ void final_norm_rows(const bf16_t* XB, const float* SS, const float* G, float* OF) {
    const int tid_ = opaque_tid(); const int lane = tid_ & 63, gw = blockIdx.x * 8 + (tid_ >> 6), ngw = gridDim.x * 8;
    for (int row = gw; row < TT; row += ngw) {
        const float rstd = rstd_row(SS, row);
#pragma unroll
        for (int j = 0; j < 4; ++j) { const u32x4 w = ((const u32x4*)(XB + (size_t)row * DM))[lane + 64 * j];
            const f32x4 ga = ((const f32x4*)G)[2 * (lane + 64 * j)], gb = ((const f32x4*)G)[2 * (lane + 64 * j) + 1];
            f32x4 y0, y1; y0[0] = bflo(w.x) * rstd * ga[0]; y0[1] = bfhi(w.x) * rstd * ga[1]; y0[2] = bflo(w.y) * rstd * ga[2]; y0[3] = bfhi(w.y) * rstd * ga[3];
            y1[0] = bflo(w.z) * rstd * gb[0]; y1[1] = bfhi(w.z) * rstd * gb[1]; y1[2] = bflo(w.w) * rstd * gb[2]; y1[3] = bfhi(w.w) * rstd * gb[3];
            ((f32x4*)(OF + (size_t)row * DM))[2 * (lane + 64 * j)] = y0; ((f32x4*)(OF + (size_t)row * DM))[2 * (lane + 64 * j) + 1] = y1; }
    }
}
__device__ __forceinline__ void rows_bf16_ss(const float* X, bf16_t* OB, float* SSO) {
    const int tid_ = opaque_tid(); const int lane = tid_ & 63, gw = blockIdx.x * 8 + (tid_ >> 6), ngw = gridDim.x * 8;
    for (int row = gw; row < TT; row += ngw) {
        const f32x4* xr = (const f32x4*)(X + (size_t)row * DM) + lane; float s = 0.f;
#pragma unroll
        for (int j = 0; j < 8; ++j) { const f32x4 v = xr[64 * j]; s += (v[0] * v[0] + v[1] * v[1]) + (v[2] * v[2] + v[3] * v[3]);
            u32x2 w; w.x = cvt_pk_bf16(v[0], v[1]); w.y = cvt_pk_bf16(v[2], v[3]); ((u32x2*)(OB + (size_t)row * DM))[lane + 64 * j] = w; }
        s = wave_sum(s, lane); if (lane == 0) { float z = 0.f; asm volatile("" : "+v"(z)); *(f32x4*)(SSO + (size_t)row * 8) = (f32x4){s, z, z, z}; *(f32x4*)(SSO + (size_t)row * 8 + 4) = (f32x4){z, z, z, z}; }
    }
}
struct TJob { const float* src; const float* gain; bf16_t* dst; int N, ldd, k0, n0, drow0, dk0; };
__device__ __forceinline__ TJob tjob_decode(const Args& a, int it) {
    constexpr int C_IN = 16 * 92, C_BP = 4 * 16, C_BS = 8 * 16, C_BH = 4 * 16, C_OUT = 256, C_GU = 16 * 88, C_DN = 44 * 16, C_PG = 256, C_PP = 2 * 16;
    constexpr int PER_L = C_IN + C_BP + C_BS + C_BH + C_OUT + C_GU + C_DN + C_PG + C_PP;
    const int L = it / PER_L; int r = it - L * PER_L;
    unsigned char* wl = a.ws + WS_W0 + (size_t)L * WL_SIZE;
    TJob J; J.gain = nullptr; J.dk0 = 0; int nkb, gu = 0;
    if (r < C_IN) { J.src = a.in[3] + (size_t)L * DM * INC; J.N = INC; J.dst = (bf16_t*)(wl + WL_IN); J.ldd = DM; nkb = 16; J.gain = a.in[2] + (size_t)L * DM; }
    else if ((r -= C_IN) < C_BP) { J.src = a.in[8] + (size_t)L * 512 * DM; J.N = DM; J.dst = (bf16_t*)(wl + WL_BR); J.ldd = DM; nkb = 4; }
    else if ((r -= C_BP) < C_BS) { J.src = a.in[9] + (size_t)L * 1024 * DM; J.N = DM; J.dst = (bf16_t*)(wl + WL_BR); J.ldd = DM; J.dk0 = 512; nkb = 8; }
    else if ((r -= C_BS) < C_BH) { J.src = a.in[10] + (size_t)L * 512 * DM; J.N = DM; J.dst = (bf16_t*)(wl + WL_BR); J.ldd = DM; J.dk0 = 1536; nkb = 4; }
    else if ((r -= C_BH) < C_OUT) { J.src = a.in[11] + (size_t)L * DM * DM; J.N = DM; J.dst = (bf16_t*)(wl + WL_OUT); J.ldd = DM; nkb = 16; }
    else if ((r -= C_OUT) < C_GU) { J.src = a.in[13] + (size_t)L * DM * 2 * DFF; J.N = 2 * DFF; J.dst = (bf16_t*)(wl + WL_GU); J.ldd = DM; nkb = 16; gu = 1; J.gain = a.in[12] + (size_t)L * DM; }
    else if ((r -= C_GU) < C_DN) { J.src = a.in[14] + (size_t)L * DFF * DM; J.N = DM; J.dst = (bf16_t*)(wl + WL_DN); J.ldd = DFF; nkb = 44; }
    else if ((r -= C_DN) < C_PG) { J.src = a.in[16] + (size_t)L * DM * DM; J.N = DM; J.dst = (bf16_t*)(wl + WL_PG); J.ldd = DM; nkb = 16; J.gain = a.in[15] + (size_t)L * DM; }
    else { r -= C_PG; J.src = a.in[17] + (size_t)L * PLE * DM; J.N = DM; J.dst = (bf16_t*)(wl + WL_PP); J.ldd = PLE; nkb = 2; }
    const int nb = r / nkb, kb = r - nb * nkb;
    J.drow0 = nb * 128; if (gu) J.drow0 = nb < 44 ? 256 * nb : 256 * (nb - 44) + 128;
    J.k0 = kb * 128; J.n0 = nb * 128;
    return J;
}
__device__ __forceinline__ void tjob_load(const TJob& J, int tid, f32x4 (&v)[8]) {
#pragma unroll
    for (int p = 0; p < 8; ++p) { const int k = p * 16 + (tid >> 5), c = (tid & 31) * 4;
        v[p] = *(const f32x4*)(J.src + (size_t)(J.k0 + k) * J.N + J.n0 + c); if (J.gain) v[p] = v[p] * J.gain[J.k0 + k]; }
}
__device__ __forceinline__ void tjob_finish(const TJob& J, int tid, const f32x4 (&v)[8], float* sm) {
#pragma unroll
    for (int p = 0; p < 8; ++p) { const int k = p * 16 + (tid >> 5), c = (tid & 31) * 4; float* s = sm + k * 129 + c; s[0] = v[p][0]; s[1] = v[p][1]; s[2] = v[p][2]; s[3] = v[p][3]; }
    __syncthreads();
#pragma unroll
    for (int i = 0; i < 4; ++i) { const int item = tid + 512 * i, c = item & 15, n = item >> 4; const float* s = sm + (8 * c) * 129 + n;
        u32x4 w; w.x = cvt_pk_bf16(s[0], s[129]); w.y = cvt_pk_bf16(s[2 * 129], s[3 * 129]); w.z = cvt_pk_bf16(s[4 * 129], s[5 * 129]); w.w = cvt_pk_bf16(s[6 * 129], s[7 * 129]);
        *(u32x4*)(J.dst + (size_t)(J.drow0 + n) * J.ldd + J.dk0 + J.k0 + 8 * c) = w; }
    __syncthreads();
}

__device__ __forceinline__ void prologue_phase(const Args& a, unsigned char* lds) {
    float* sm = (float*)lds;
    constexpr int N_ITEMS = NLAYER * (16 * 92 + 4 * 16 + 8 * 16 + 4 * 16 + 256 + 16 * 88 + 44 * 16 + 256 + 2 * 16);
    {   const int tid = opaque_tid();
        int it = blockIdx.x;
        if (it < N_ITEMS) {
            TJob J = tjob_decode(a, it); f32x4 v[8]; tjob_load(J, tid, v);
            for (;;) {
                const int itn = it + gridDim.x; const bool more = itn < N_ITEMS;
                TJob Jn = J; f32x4 vn[8];
#pragma unroll
                for (int p = 0; p < 8; ++p) vn[p] = v[p];
                if (more) { Jn = tjob_decode(a, itn); tjob_load(Jn, tid, vn); }
                tjob_finish(J, tid, v, sm);
                if (!more) break;
                J = Jn; it = itn;
#pragma unroll
                for (int p = 0; p < 8; ++p) v[p] = vn[p];
            }
        }
    }
    { const f32x4* ps = (const f32x4*)a.in[1]; u32x2* pd = (u32x2*)(a.ws + WS_PB); const int n4 = NLAYER * TT * PLE / 4;
      for (int i = blockIdx.x * 512 + opaque_tid(); i < n4; i += gridDim.x * 512) { const f32x4 v = ps[i]; u32x2 w; w.x = cvt_pk_bf16(v[0], v[1]); w.y = cvt_pk_bf16(v[2], v[3]); pd[i] = w; } }
    rows_bf16_ss(a.in[0], (bf16_t*)(a.ws + WS_H), (float*)(a.ws + WS_X));
}

__device__ __forceinline__ void pool_unit(unsigned char* lds, int tile, int gi, int L, const Args& a) {
    float* Wl = (float*)lds; float* uw = Wl + 128 * 128; float* mx = uw + 47 * 128;
    const int tid = opaque_tid();
    const float* U = (const float*)(a.ws + WS_U);
    const float* PW = a.in[4] + ((size_t)L * 4 + gi) * 128 * 128;
    const int t0 = tile * 32, s0 = t0 & (SEQ - 1);
#pragma unroll
    for (int i = 0; i < 8; ++i) ((f32x4*)Wl)[tid + 512 * i] = ((const f32x4*)PW)[tid + 512 * i];
    for (int i = tid; i < 47 * 32; i += 512) { const int rr = i >> 5, c4 = i & 31; const int sp = s0 - 15 + rr;
        f32x4 v = (f32x4){0.f, 0.f, 0.f, 0.f};
        if (sp >= 0) v = *(const f32x4*)(U + (size_t)(t0 - 15 + rr) * 512 + gi * 128 + c4 * 4);
        ((f32x4*)uw)[i] = v; }
    __syncthreads();
    const int w = 2 << gi;
    for (int i = tid; i < 32 * 128; i += 512) { const int tt = i >> 7, c = i & 127; float s = 0.f;
        for (int j = 0; j < w; ++j) s += uw[(15 + tt - j) * 128 + c];
        const int cnt = min(s0 + tt + 1, w);
        mx[i] = s / (float)cnt - uw[(15 + tt) * 128 + c]; }
    __syncthreads();
    const int d = tid & 127, tg = tid >> 7;
    float acc[8];
#pragma unroll
    for (int j = 0; j < 8; ++j) acc[j] = 0.f;
    for (int c = 0; c < 128; c += 4) {
        const float w0 = Wl[c * 128 + d], w1 = Wl[(c + 1) * 128 + d], w2 = Wl[(c + 2) * 128 + d], w3 = Wl[(c + 3) * 128 + d];
#pragma unroll
        for (int j = 0; j < 8; ++j) { const f32x4 mv = *(const f32x4*)(mx + (tg * 8 + j) * 128 + c); acc[j] += mv[0] * w0 + mv[1] * w1 + mv[2] * w2 + mv[3] * w3; }
    }
    const float sc = a.in[5][(size_t)L * 512 + gi * 128 + d];
    bf16_t* Y = (bf16_t*)(a.ws + WS_Y);
#pragma unroll
    for (int j = 0; j < 8; ++j) Y[(size_t)(t0 + tg * 8 + j) * 2048 + gi * 128 + d] = (bf16_t)(cvt_pk_bf16(acc[j] * sc, 0.f) & 0xffff);
    __syncthreads();
}

__device__ __forceinline__ void attn_unit(unsigned char* lds, int b, int h, int qb, const Args& a) {
    const bf16_t* SQ = (const bf16_t*)(a.ws + WS_SQ); const bf16_t* SK = (const bf16_t*)(a.ws + WS_SK); const bf16_t* VT = (const bf16_t*)(a.ws + WS_VT);
    bf16_t* Y = (bf16_t*)(a.ws + WS_Y);
    const int tid = opaque_tid(), lane = tid & 63, wid = tid >> 6, r = lane & 31, hi = lane >> 5;
    const int half = wid >> 2, wq = wid & 3, t256 = tid & 255;
    const int q0 = qb * 128, qw0 = q0 + wq * 32;
    const size_t rowbase = (size_t)b * SEQ;
    constexpr int KBY = 64 * 272, VBY = 128 * 144, BUF = KBY + VBY;
    unsigned char* hb = lds + half * BUF;
    bf16x8 qf[8];
    { const bf16_t* qp = SQ + (rowbase + qw0 + r) * 1024 + h * 128 + hi * 8;
#pragma unroll
      for (int ds = 0; ds < 8; ++ds) qf[ds] = *(const bf16x8*)(qp + ds * 16); }
    f32x16 o[4];
#pragma unroll
    for (int i = 0; i < 4; ++i)
#pragma unroll
        for (int j = 0; j < 16; ++j) o[i][j] = 0.f;
    float R = 1.f;
    const int nst = qb + 1;
    const int jstart = half == 0 ? 2 * qb + 1 : qb;
    u32x4 st[8];
#define ATT_LOAD(jj) do { _Pragma("unroll") for (int i = 0; i < 4; ++i) { const int ch = t256 + 256 * i; \
        st[i] = *(const u32x4*)(SK + (rowbase + 64 * (jj) + (ch >> 4)) * 1024 + h * 128 + (ch & 15) * 8); \
        st[4 + i] = *(const u32x4*)(VT + (((size_t)(b * 8 + h) * 128 + (ch >> 3)) << 11) + 64 * (jj) + (ch & 7) * 8); } } while (0)
#define ATT_STORE() do { _Pragma("unroll") for (int i = 0; i < 4; ++i) { const int ch = t256 + 256 * i; \
        *(u32x4*)(hb + (ch >> 4) * 272 + (ch & 15) * 16) = st[i]; *(u32x4*)(hb + KBY + (ch >> 3) * 144 + (ch & 7) * 16) = st[4 + i]; } } while (0)
    ATT_LOAD(jstart); ATT_STORE();
    __syncthreads();
    for (int sidx = 0; sidx < nst; ++sidx) {
        const int j = jstart - sidx;
        if (sidx + 1 < nst) ATT_LOAD(j - 1);
        if (64 * j <= qw0 + 31) {
            const unsigned char* Kb = hb; const unsigned char* Vb = hb + KBY;
            f32x16 p[2];
#pragma unroll
            for (int hh = 0; hh < 2; ++hh) {
#pragma unroll
                for (int jj = 0; jj < 16; ++jj) p[hh][jj] = 0.f;
#pragma unroll
                for (int ds = 0; ds < 8; ++ds) { const bf16x8 ka = *(const bf16x8*)(Kb + (32 * hh + r) * 272 + (16 * ds + 8 * hi) * 2); p[hh] = MFMA32(ka, qf[ds], p[hh]); }
            }
            const int t = qw0 + r; const int sbase = 64 * j + 4 * hi;
            float G[8];
#define ATT_ELEM(MASKED) \
            _Pragma("unroll") for (int hh = 0; hh < 2; ++hh) \
                _Pragma("unroll") for (int g = 0; g < 4; ++g) { \
                    float mm[4], bb[4]; \
                    _Pragma("unroll") for (int i = 0; i < 4; ++i) { const float uu = __builtin_amdgcn_exp2f(p[hh][4 * g + i]); \
                        const float mi = __builtin_amdgcn_rcpf(1.0f + uu); \
                        if (MASKED) { const int s = sbase + 32 * hh + 8 * g + i; const bool valid = s < t; mm[i] = valid ? mi : 1.0f; bb[i] = valid ? 1.0f - mi : 0.0f; } \
                        else { mm[i] = mi; bb[i] = 1.0f - mi; } } \
                    const float e2 = mm[3], e1 = mm[2] * e2, e0 = mm[1] * e1; \
                    G[hh * 4 + g] = mm[0] * e0; \
                    p[hh][4 * g + 0] = bb[0] * e0; p[hh][4 * g + 1] = bb[1] * e1; p[hh][4 * g + 2] = bb[2] * e2; p[hh][4 * g + 3] = bb[3]; \
                }
            if (64 * j + 63 < qw0) { ATT_ELEM(false) } else { ATT_ELEM(true) }
#undef ATT_ELEM
            float X = 1.0f;
#pragma unroll
            for (int idx = 7; idx >= 0; --idx) { const float gp = shflx(G[idx], 32, lane); const float f = X * (hi == 0 ? gp : 1.0f) * R;
                const int hh = idx >> 2, g = idx & 3;
#pragma unroll
                for (int i = 0; i < 4; ++i) p[hh][4 * g + i] *= f;
                X *= G[idx] * gp; }
            R *= X;
            bf16x8 pa[4];
#pragma unroll
            for (int kb = 0; kb < 4; ++kb) { const int hh = kb >> 1, b8 = (kb & 1) * 8;
                pa[kb] = pack8(p[hh][b8], p[hh][b8 + 1], p[hh][b8 + 2], p[hh][b8 + 3], p[hh][b8 + 4], p[hh][b8 + 5], p[hh][b8 + 6], p[hh][b8 + 7]); }
#pragma unroll
            for (int kb = 0; kb < 4; ++kb)
#pragma unroll
                for (int db = 0; db < 4; ++db) { const unsigned char* vp = Vb + (32 * db + r) * 144 + (16 * kb + 4 * hi) * 2;
                    const s16x4 lo = *(const s16x4*)vp, hi4 = *(const s16x4*)(vp + 16);
                    const bf16x8 vf = (bf16x8){lo[0], lo[1], lo[2], lo[3], hi4[0], hi4[1], hi4[2], hi4[3]};
                    o[db] = MFMA32(pa[kb], vf, o[db]); }
        }
        __syncthreads();
        if (sidx + 1 < nst) ATT_STORE();
        __syncthreads();
    }
#undef ATT_LOAD
#undef ATT_STORE
    float* OF = (float*)lds; float* RB = (float*)(lds + 128 * 132 * 4);
    if (half == 1) {
#pragma unroll
        for (int db = 0; db < 4; ++db)
#pragma unroll
            for (int reg = 0; reg < 16; ++reg) OF[(32 * wq + crow(reg, hi)) * 132 + 32 * db + r] = o[db][reg];
    } else if (hi == 0) RB[32 * wq + r] = R;
    __syncthreads();
    if (half == 0) {
#pragma unroll
        for (int reg = 0; reg < 16; ++reg) { const int q = 32 * wq + crow(reg, hi); const float rr = RB[q];
#pragma unroll
            for (int db = 0; db < 4; ++db) { const float v = o[db][reg] + rr * OF[q * 132 + 32 * db + r];
                Y[(rowbase + q0 + q) * 2048 + 512 + h * 128 + 32 * db + r] = (bf16_t)(cvt_pk_bf16(v, 0.f) & 0xffff); } }
    }
    __syncthreads();
}

__device__ __forceinline__ void hgrn_prep_unit(unsigned char* lds, int bh, int c, int L, const Args& a) {
    const float* ZF = (const float*)(a.ws + WS_ZF); const float* HQ = (const float*)(a.ws + WS_HQ); const bf16_t* HV = (const bf16_t*)(a.ws + WS_HV);
    bf16_t* HQD = (bf16_t*)(a.ws + WS_HQD); bf16_t* HKD = (bf16_t*)(a.ws + WS_HKD); bf16_t* HVT = (bf16_t*)(a.ws + WS_HVT);
    float* HDEC = (float*)(a.ws + WS_HDEC); float* HOI = (float*)(a.ws + WS_HOI);
    const int b = bh >> 2, h = bh & 3;
    const int tid = opaque_tid(), lane = tid & 63, wid = tid >> 6, r = lane & 31, hi = lane >> 5;
    float* TOT = (float*)lds; unsigned char* QD = lds + 2048; unsigned char* KT = QD + 32 * 272; unsigned char* VTl = KT + 32 * 272;
    const int k = tid & 127, tq = tid >> 7;
    float lbA, lbB, oml;
    { const int ch = h * 128 + k; const float h0 = a.in[6][ch], h1 = a.in[6][512 + ch]; const float mxv = fmaxf(h0, h1);
      const float e0 = __expf(h0 - mxv), e1 = __expf(h1 - mxv); float lb = (L == 0) ? 0.f : e1 / (e0 + e1);
      lb = fminf(fmaxf(lb, 0.f), 1.f); lbA = fmaxf(lb, 1e-20f); lbB = 1.0f - fminf(lb, 1.0f - 1e-6f); oml = 1.0f - lb; }
    const size_t row0 = (size_t)b * SEQ + c * 32;
    const size_t gbase = (row0 + tq * 8) * 512 + h * 128 + k;
    const size_t fidx = (size_t)(bh * 64 + c) * 4096 + (size_t)((((k >> 5) * 2 + (tq >> 1)) * 64 + (tq & 1) * 32 + (k & 31)) * 8);
    float kk[8], bl[8], qv[8]; float bs = 0.f;
#pragma unroll
    for (int i = 0; i < 8; ++i) { float zf = ZF[gbase + (size_t)i * 512]; qv[i] = HQ[gbase + (size_t)i * 512];
        zf = fminf(fmaxf(zf, -80.f), 80.f); const float e = __expf(-zf); const float sg = 1.0f / (1.0f + e);
        const float f = lbA + lbB * sg; bs += logf(f); bl[i] = bs; kk[i] = oml * e * sg; }
    TOT[tq * 128 + k] = bs;
    { unsigned short x[8];
#pragma unroll
      for (int i = 0; i < 8; ++i) x[i] = HV[gbase + (size_t)i * 512];
      u32x4 w; w.x = x[0] | ((unsigned)x[1] << 16); w.y = x[2] | ((unsigned)x[3] << 16); w.z = x[4] | ((unsigned)x[5] << 16); w.w = x[6] | ((unsigned)x[7] << 16);
      *(u32x4*)(VTl + k * 80 + tq * 16) = w; *(u32x4*)(HVT + fidx) = w; }
    __syncthreads();
    float off = 0.f, tot = 0.f;
#pragma unroll
    for (int q = 0; q < 4; ++q) { const float v = TOT[q * 128 + k]; tot += v; if (q < tq) off += v; }
    float kd[8];
#pragma unroll
    for (int i = 0; i < 8; ++i) { const float bt = off + bl[i]; const int t = tq * 8 + i;
        *(bf16_t*)(QD + t * 272 + k * 2) = (bf16_t)(cvt_pk_bf16(qv[i] * __expf(bt), 0.f) & 0xffff);
        *(bf16_t*)(KT + t * 272 + k * 2) = (bf16_t)(cvt_pk_bf16(kk[i] * __expf(fminf(-bt, 80.f)), 0.f) & 0xffff);
        kd[i] = kk[i] * __expf(tot - bt); }
    *(bf16x8*)(HKD + fidx) = pack8(kd[0], kd[1], kd[2], kd[3], kd[4], kd[5], kd[6], kd[7]);
    if (tq == 0) HDEC[(size_t)(bh * 64 + c) * 128 + k] = __expf(tot);
    __syncthreads();
    { const int k0 = 32 * (wid >> 1) + 16 * (wid & 1) + 4 * hi; const unsigned char* p = QD + r * 272 + k0 * 2;
      const s16x4 lo = *(const s16x4*)p, hi4 = *(const s16x4*)(p + 16);
      *(bf16x8*)(HQD + (size_t)(bh * 64 + c) * 4096 + (wid * 64 + lane) * 8) = (bf16x8){lo[0], lo[1], lo[2], lo[3], hi4[0], hi4[1], hi4[2], hi4[3]}; }
    if (wid < 4) {
        const int w = wid;
        f32x16 pt;
#pragma unroll
        for (int j = 0; j < 16; ++j) pt[j] = 0.f;
#pragma unroll
        for (int ks = 0; ks < 8; ++ks) { const bf16x8 ka = *(const bf16x8*)(KT + r * 272 + (16 * ks + 8 * hi) * 2); const bf16x8 qa = *(const bf16x8*)(QD + r * 272 + (16 * ks + 8 * hi) * 2);
            pt = MFMA32(ka, qa, pt); }
#pragma unroll
        for (int reg = 0; reg < 16; ++reg) { if (crow(reg, hi) > r) pt[reg] = 0.f; }
        const bf16x8 pa0 = pack8(pt[0], pt[1], pt[2], pt[3], pt[4], pt[5], pt[6], pt[7]);
        const bf16x8 pa1 = pack8(pt[8], pt[9], pt[10], pt[11], pt[12], pt[13], pt[14], pt[15]);
        f32x16 o;
#pragma unroll
        for (int j = 0; j < 16; ++j) o[j] = 0.f;
#pragma unroll
        for (int s16 = 0; s16 < 2; ++s16) { const unsigned char* vp = VTl + (32 * w + r) * 80 + (16 * s16 + 4 * hi) * 2;
            const s16x4 lo = *(const s16x4*)vp, hi4 = *(const s16x4*)(vp + 16);
            const bf16x8 vf = (bf16x8){lo[0], lo[1], lo[2], lo[3], hi4[0], hi4[1], hi4[2], hi4[3]};
            o = MFMA32(s16 ? pa1 : pa0, vf, o); }
#pragma unroll
        for (int reg = 0; reg < 16; ++reg) HOI[(row0 + crow(reg, hi)) * 512 + h * 128 + 32 * w + r] = o[reg];
    }
    __syncthreads();
}

__device__ __forceinline__ float dpp_sum16(float v) {
    v += __int_as_float(__builtin_amdgcn_update_dpp(0, __float_as_int(v), 0xB1, 0xF, 0xF, true));
    v += __int_as_float(__builtin_amdgcn_update_dpp(0, __float_as_int(v), 0x4E, 0xF, 0xF, true));
    v += __int_as_float(__builtin_amdgcn_update_dpp(0, __float_as_int(v), 0x141, 0xF, 0xF, true));
    v += __int_as_float(__builtin_amdgcn_update_dpp(0, __float_as_int(v), 0x140, 0xF, 0xF, true));
    return v;
}
__device__ __forceinline__ void hgrn_chain_unit(unsigned char* lds, int bh, int L, const Args& a) {
    const bf16_t* HQD = (const bf16_t*)(a.ws + WS_HQD); const bf16_t* HKD = (const bf16_t*)(a.ws + WS_HKD); const bf16_t* HVT = (const bf16_t*)(a.ws + WS_HVT);
    const float* HDEC = (const float*)(a.ws + WS_HDEC); const float* HOI = (const float*)(a.ws + WS_HOI);
    const bf16_t* OG = (const bf16_t*)(a.ws + WS_OG); bf16_t* Y = (bf16_t*)(a.ws + WS_Y);
    const int b = bh >> 2, h = bh & 3;
    const int tid = opaque_tid(), lane = tid & 63, wid = tid >> 6, r = lane & 31, hi = lane >> 5;
    constexpr int BUFB = 25088;
    float* OB = (float*)(lds + 3 * BUFB);
    f32x16 Sacc[4];
#pragma unroll
    for (int i = 0; i < 4; ++i)
#pragma unroll
        for (int j = 0; j < 16; ++j) Sacc[i][j] = 0.f;
    const size_t cb = (size_t)bh * 64;
    const size_t rowb = (size_t)b * SEQ;
    u32x4 stA[3], stB[3]; f32x4 sdA = (f32x4){0.f, 0.f, 0.f, 0.f}, sdB = sdA;
#define HG_LOAD(cc, st, sd) do { const int cc_ = (cc) < 63 ? (cc) : 63; const size_t e_ = (cb + cc_) * 4096 + (size_t)tid * 8; st[0] = *(const u32x4*)(HQD + e_); st[1] = *(const u32x4*)(HKD + e_); st[2] = *(const u32x4*)(HVT + e_); \
        sd = *(const f32x4*)(HDEC + (cb + cc_) * 128 + (tid & 31) * 4); } while (0)
#define HG_STORE(bi, st, sd) do { unsigned char* B_ = lds + (bi) * BUFB; *(u32x4*)(B_ + tid * 16) = st[0]; *(u32x4*)(B_ + 8192 + tid * 16) = st[1]; *(u32x4*)(B_ + 16384 + tid * 16) = st[2]; \
        if (tid < 32) *(f32x4*)(B_ + 24576 + tid * 16) = sd; } while (0)
    HG_LOAD(0, stA, sdA); HG_STORE(0, stA, sdA); HG_LOAD(1, stA, sdA); HG_STORE(1, stA, sdA);
    HG_LOAD(2, stB, sdB);
    const int pt_ = tid >> 4, seg = tid & 15; const int ch = h * 128 + seg * 8;
    const float* gn = a.in[7] + (size_t)L * 512 + ch; const f32x4 g0 = *(const f32x4*)gn, g1 = *(const f32x4*)(gn + 4);
    f32x4 oiA0, oiA1, oiB0, oiB1; u32x4 ogA, ogB;
#define HG_PLOAD(cc, o0, o1, og_) do { const int cp_ = (cc) < 63 ? (cc) : 63; const size_t row_ = rowb + cp_ * 32 + pt_; o0 = *(const f32x4*)(HOI + row_ * 512 + ch); o1 = *(const f32x4*)(HOI + row_ * 512 + ch + 4); og_ = *(const u32x4*)(OG + row_ * 512 + ch); } while (0)
    HG_PLOAD(0, oiA0, oiA1, ogA);
    __syncthreads();
#define HG_ITER(c, stX, sdX, stY, sdY, oiC0, oiC1, ogC, oiN0, oiN1, ogN) do { \
        const int bi = (c) % 3; \
        HG_LOAD((c) + 3, stX, sdX); \
        HG_PLOAD((c) + 1, oiN0, oiN1, ogN); \
        if (wid < 4) { \
            const int w = wid; const unsigned char* B = lds + bi * BUFB; \
            f32x16 o, o2; \
            _Pragma("unroll") for (int j = 0; j < 16; ++j) { o[j] = 0.f; o2[j] = 0.f; } \
            _Pragma("unroll") for (int kb = 0; kb < 4; ++kb) \
                _Pragma("unroll") for (int s16 = 0; s16 < 2; ++s16) { const bf16x8 aq = *(const bf16x8*)(B + ((kb * 2 + s16) * 64 + lane) * 16); const int b8 = 8 * s16; \
                    const bf16x8 bsv = pack8(Sacc[kb][b8], Sacc[kb][b8 + 1], Sacc[kb][b8 + 2], Sacc[kb][b8 + 3], Sacc[kb][b8 + 4], Sacc[kb][b8 + 5], Sacc[kb][b8 + 6], Sacc[kb][b8 + 7]); \
                    if (kb < 2) o = MFMA32(aq, bsv, o); else o2 = MFMA32(aq, bsv, o2); } \
            _Pragma("unroll") for (int kb = 0; kb < 4; ++kb) { \
                _Pragma("unroll") for (int g = 0; g < 4; ++g) { const f32x4 dd = *(const f32x4*)(B + 24576 + (32 * kb + 8 * g + 4 * hi) * 4); \
                    _Pragma("unroll") for (int i = 0; i < 4; ++i) Sacc[kb][4 * g + i] *= dd[i]; } \
                _Pragma("unroll") for (int s16 = 0; s16 < 2; ++s16) { const bf16x8 ka = *(const bf16x8*)(B + 8192 + ((kb * 2 + s16) * 64 + lane) * 16); \
                    const bf16x8 va = *(const bf16x8*)(B + 16384 + ((w * 2 + s16) * 64 + lane) * 16); \
                    Sacc[kb] = MFMA32(ka, va, Sacc[kb]); } \
            } \
            _Pragma("unroll") for (int reg = 0; reg < 16; ++reg) OB[crow(reg, hi) * 132 + 32 * w + r] = o[reg] + o2[reg]; \
        } \
        __syncthreads(); \
        { const size_t row = rowb + (c) * 32 + pt_; const float* op = OB + pt_ * 132 + seg * 8; \
          const f32x4 x0 = *(const f32x4*)op + oiC0, x1 = *(const f32x4*)(op + 4) + oiC1; \
          float ss = (x0[0] * x0[0] + x0[1] * x0[1]) + (x0[2] * x0[2] + x0[3] * x0[3]) + (x1[0] * x1[0] + x1[1] * x1[1]) + (x1[2] * x1[2] + x1[3] * x1[3]); \
          ss = dpp_sum16(ss); \
          const float rstd = 1.0f / sqrtf(ss * (1.0f / 128.0f) + EPS); \
          f32x4 y0, y1; \
          y0[0] = x0[0] * rstd * g0[0] * bflo(ogC.x); y0[1] = x0[1] * rstd * g0[1] * bfhi(ogC.x); y0[2] = x0[2] * rstd * g0[2] * bflo(ogC.y); y0[3] = x0[3] * rstd * g0[3] * bfhi(ogC.y); \
          y1[0] = x1[0] * rstd * g1[0] * bflo(ogC.z); y1[1] = x1[1] * rstd * g1[1] * bfhi(ogC.z); y1[2] = x1[2] * rstd * g1[2] * bflo(ogC.w); y1[3] = x1[3] * rstd * g1[3] * bfhi(ogC.w); \
          *(u32x4*)(Y + row * 2048 + 1536 + ch) = pack8v(y0, y1); } \
        HG_STORE(((c) + 2) % 3, stY, sdY); \
        __syncthreads(); \
    } while (0)
    for (int c = 0; c < 64; c += 2) {
        HG_ITER(c, stA, sdA, stB, sdB, oiA0, oiA1, ogA, oiB0, oiB1, ogB);
        HG_ITER(c + 1, stB, sdB, stA, sdA, oiB0, oiB1, ogB, oiA0, oiA1, ogA);
    }
#undef HG_ITER
#undef HG_PLOAD
#undef HG_LOAD
#undef HG_STORE
}

#define WQ_NEXT(cw) ({ if (threadIdx.x == 0) sh[0] = atomicAdd((cw), 1u); __syncthreads(); const int u_ = (int)sh[0]; __syncthreads(); u_; })
constexpr int INP_MAIN_COLT = 40;
__device__ __forceinline__ void mixer_phase(const Args& a, unsigned char* lds, int L, int mp, int rep) {
    unsigned* ctr = (unsigned*)(a.ws + WS_CTL) + 64 * (L * 4 + mp * 2 + rep);
    volatile unsigned* sh = (volatile unsigned*)(lds + LDS_MISC);
    if (mp == 0) {
        for (;;) { const int u = WQ_NEXT(ctr); if (u >= 2048) break;
            if (u < 1024) hgrn_prep_unit(lds, u >> 6, u & 63, L, a);
            else { const int x = u - 1024; pool_unit(lds, x >> 2, x & 3, L, a); } }
    } else {
        { const int u = WQ_NEXT(ctr); if (u < 16) { hgrn_chain_unit(lds, u, L, a); if (CHAIN_TWICE) { __syncthreads(); hgrn_chain_unit(lds, u, L, a); } } }
        for (;;) { const int x = WQ_NEXT(ctr + 8); if (x >= 32 * (46 - INP_MAIN_COLT)) break;
            pg8::Gemm g{(const bf16_t*)(a.ws + WS_H), (const bf16_t*)(a.ws + WS_W0 + (size_t)L * WL_SIZE + WL_IN), TT, INC, DM, DM, 1, 0, 0, 0, DM / 64, 0, 0};
            pg8::OneUnit S1{x / (46 - INP_MAIN_COLT), INP_MAIN_COLT + x % (46 - INP_MAIN_COLT)};
            EpiIn E{a.ws, 3 * L * TT};
            pg8::gemm_phase((PG8_LAS unsigned char*)lds, g, S1, E); }
        for (;;) { const int x = WQ_NEXT(ctr + 16); if (x >= 512) break;
            attn_unit(lds, (x & 31) >> 3, x & 7, 15 - (x >> 5), a); }
        for (;;) { const int x = WQ_NEXT(ctr + 24); if (x >= 256) break;
            pg8::Gemm g{(const bf16_t*)(a.ws + WS_PB) + (size_t)L * TT * PLE, (const bf16_t*)(a.ws + WS_W0 + (size_t)L * WL_SIZE + WL_PP), TT, DM, PLE, PLE, 1, 0, 0, 0, PLE / 64, 0, 0};
            pg8::OneUnit S1{x >> 3, x & 7};
            EpiBf16 E{a.ws};
            pg8::gemm_phase((PG8_LAS unsigned char*)lds, g, S1, E); }
    }
}

#define LAS __attribute__((address_space(3)))
#define XB_TMO      128
#define XB_XCNT(j)  (256  + 64 * (j))
#define XB_XSUB(j)  (1280 + 64 * (j))
#define XB_XGEN(j)  (2304 + 64 * (j))
#define XB_TOP      3328
#define XB_TOPGEN   3392
#define XCD_BAR_WORDS 3456
#define XB_SPIN_CAP (1u << 20)
__device__ __forceinline__ unsigned xb_ld(unsigned* p)              { return __hip_atomic_load(p, __ATOMIC_RELAXED, __HIP_MEMORY_SCOPE_AGENT); }
__device__ __forceinline__ unsigned xb_add(unsigned* p, unsigned v) { return __hip_atomic_fetch_add(p, v, __ATOMIC_RELAXED, __HIP_MEMORY_SCOPE_AGENT); }
__device__ __forceinline__ unsigned xb_xcc_id() { return (unsigned)__builtin_amdgcn_s_getreg((3 << 11) | 20) & 0xFu; }
#define XB_SPIN(cond, bar) do { unsigned _sp = 0; while (cond) { __builtin_amdgcn_s_sleep(1); \
    if ((++_sp & 255u) == 0u) { if (xb_ld(&(bar)[XB_TMO])) break; if (_sp > XB_SPIN_CAP) { atomicAdd(&(bar)[XB_TMO], 1u); break; } } } } while (0)
struct XcdBarrier { unsigned* bar; unsigned x; volatile LAS unsigned* st; };
__device__ __forceinline__ XcdBarrier xcd_barrier_post(unsigned* bar, volatile LAS unsigned* st) {
    XcdBarrier b; b.bar = bar; b.x = xb_xcc_id(); b.st = st;
    if (threadIdx.x == 0) (void)xb_add(&bar[XB_XCNT(b.x)], 1u);
    return b;
}
__device__ __forceinline__ void xcd_barrier_complete(unsigned* bar, unsigned x, unsigned& nloc, unsigned& nx) {
    const unsigned G = gridDim.x * gridDim.y * gridDim.z;
    unsigned sum, cnt, mine, sp = 0u;
    for (;;) {
        sum = 0u; cnt = 0u; mine = 0u;
#pragma nounroll
        for (unsigned j = 0; j < 16; ++j) { const unsigned c = xb_ld(&bar[XB_XCNT(j)]); sum += c; cnt += (c > 0u) ? 1u : 0u; mine = (j == x) ? c : mine; }
        if (sum == G) break;
        __builtin_amdgcn_s_sleep(1);
        if ((++sp & 255u) == 0u) { if (xb_ld(&bar[XB_TMO])) break; if (sp > XB_SPIN_CAP) { atomicAdd(&bar[XB_TMO], 1u); break; } }
    }
    nloc = mine > 0u ? mine : 1u; nx = cnt > 0u ? cnt : 1u;
}
__device__ __forceinline__ void xcd_barrier(const XcdBarrier& b) {
    asm volatile("s_waitcnt vmcnt(0)" ::: "memory");
    __syncthreads();
    if (threadIdx.x == 0) {
        unsigned* bar = b.bar; asm volatile("" : "+s"(bar));
        __builtin_amdgcn_s_waitcnt(0);
        unsigned nloc = b.st[0], nx = b.st[1];
        if (nloc == 0u) { xcd_barrier_complete(bar, b.x, nloc, nx); b.st[0] = nloc; b.st[1] = nx; }
        const unsigned old = xb_add(&bar[XB_XSUB(b.x)], 1u);
        const unsigned gen = old / nloc;
        if (old + 1u == (gen + 1u) * nloc) {
            __builtin_amdgcn_fence(__ATOMIC_RELEASE, "agent");
            asm volatile("s_waitcnt vmcnt(0)" ::: "memory");
            const unsigned og = xb_add(&bar[XB_TOP], 1u);
            const unsigned tg = og / nx;
            if (og + 1u == (tg + 1u) * nx) xb_add(&bar[XB_TOPGEN], 1u);
            else XB_SPIN(xb_ld(&bar[XB_TOPGEN]) == tg, bar);
            __builtin_amdgcn_fence(__ATOMIC_ACQUIRE, "agent");
            xb_add(&bar[XB_XGEN(b.x)], 1u);
            asm volatile("s_waitcnt vmcnt(0)" ::: "memory");
        } else {
            XB_SPIN(xb_ld(&bar[XB_XGEN(b.x)]) == gen, bar);
            __builtin_amdgcn_fence(__ATOMIC_ACQUIRE, "agent");
            asm volatile("s_waitcnt vmcnt(0)" ::: "memory");
        }
    }
    __syncthreads();
}

typedef const Args __attribute__((address_space(4)))* KArgP;
#define LOAD_ARGS KArgP ap = (KArgP)__builtin_amdgcn_kernarg_segment_ptr(); asm volatile("" : "+s"(ap)); Args A; \
    _Pragma("unroll") for (int i_ = 0; i_ < 19; ++i_) A.in[i_] = ap->in[i_]; A.out = ap->out; A.ws = ap->ws; A.ph_lo = 0; A.ph_hi = 0;
__global__ void __launch_bounds__(512, 2) mega(Args a) {
    extern __shared__ __attribute__((aligned(16))) unsigned char lds[];
    cg::grid_group grid = cg::this_grid();
    PG8_LAS unsigned char* lds3 = (PG8_LAS unsigned char*)lds;
    const int G = gridDim.x, bx = blockIdx.x;
    if (threadIdx.x == 0) { ((volatile LAS unsigned*)((LAS unsigned char*)lds + LDS_MISC))[8] = 0u; ((volatile LAS unsigned*)((LAS unsigned char*)lds + LDS_MISC))[9] = 0u; }
    __syncthreads();
    XcdBarrier xbar = xcd_barrier_post((unsigned*)(a.ws + WS_CTL) + 1024, (volatile LAS unsigned*)((LAS unsigned char*)lds + LDS_MISC) + 8);
    constexpr int ph_hi_ = NPHASE;
#pragma nounroll
    for (int ph = 0; ph < ph_hi_; ++ph) {
      const int nrep = 1 + ((ph == 0 ? (REP_MASK >> 15) : (ph == NPHASE - 1 ? 0 : (REP_MASK >> ((ph - 1) % PPL)))) & 1);
      for (int rep = 0; rep < nrep; ++rep) {
        if (ph == 0) { if (PHMASK & 0x8000) { LOAD_ARGS prologue_phase(A, lds); } }
        else if (ph == NPHASE - 1) { if (PHMASK & 0x4000) { LOAD_ARGS final_norm_rows((const bf16_t*)(A.ws + WS_H), (const float*)(A.ws + WS_X) + (size_t)(3 * NLAYER) * TT * 8, A.in[18], A.out); } }
        else {
            const int L = (ph - 1) / PPL, s = (ph - 1) % PPL;
            if (s == 0) { if (PHMASK & (1 << 0)) {
                LOAD_ARGS unsigned char* wl = A.ws + WS_W0 + (size_t)L * WL_SIZE;
                pg8::Gemm g{(const bf16_t*)(A.ws + WS_H), (const bf16_t*)(wl + WL_IN), TT, INC, DM, DM, 1, 0, 0, 0, DM / 64, 0, 0};
                pg8::StaticOrder S; S.init(TT, INP_MAIN_COLT * 256, G, bx, 1);
                EpiIn E{A.ws, 3 * L * TT};
                pg8::gemm_phase(lds3, g, S, E);
            }} else if (s == 1) { if (PHMASK & (1 << 1)) {
                LOAD_ARGS mixer_phase(A, lds, L, 0, rep);
            }} else if (s == 2) { if (PHMASK & (1 << 2)) {
                LOAD_ARGS mixer_phase(A, lds, L, 1, rep);
            }} else if (s == 3) { if (PHMASK & (1 << 3)) {
                LOAD_ARGS unsigned char* wl = A.ws + WS_W0 + (size_t)L * WL_SIZE;
                pg8::Gemm g{(const bf16_t*)(A.ws + WS_Y), (const bf16_t*)(wl + WL_BR), TT, DM, DM, DM, 3, 0, 512, 1536, 8, 16, 8};
                pg8::StaticOrder S; S.init(TT, DM, G, bx, 3);
                EpiBranch E{A.ws};
                pg8::gemm_phase(lds3, g, S, E);
            }} else if (s == 4) { if (PHMASK & (1 << 4)) {
                LOAD_ARGS unsigned char* wl = A.ws + WS_W0 + (size_t)L * WL_SIZE;
                pg8::Gemm g{(const bf16_t*)(A.ws + WS_MIX), (const bf16_t*)(wl + WL_OUT), TT, DM, DM, DM, 1, 0, 0, 0, DM / 64, 0, 0};
                pg8::StaticOrder S; S.init(TT, DM, G, bx, 1);
                EpiResid E{A.ws, 0, 0, (3 * L + 1) * TT};
                pg8::gemm_phase(lds3, g, S, E);
            }} else if (s == 5) { if (PHMASK & (1 << 5)) {
                LOAD_ARGS unsigned char* wl = A.ws + WS_W0 + (size_t)L * WL_SIZE;
                pg8::Gemm g{(const bf16_t*)(A.ws + WS_H), (const bf16_t*)(wl + WL_GU), TT, 2 * DFF, DM, DM, 1, 0, 0, 0, DM / 64, 0, 0};
                pg8::StaticOrder S; S.init(TT, 2 * DFF, G, bx, 1);
                EpiSwiglu E{A.ws, (3 * L + 1) * TT};
                pg8::gemm_phase(lds3, g, S, E);
            }} else if (s == 6) { if (PHMASK & (1 << 6)) {
                LOAD_ARGS unsigned char* wl = A.ws + WS_W0 + (size_t)L * WL_SIZE;
                pg8::Gemm g{(const bf16_t*)(A.ws + WS_ACT), (const bf16_t*)(wl + WL_DN), TT, DM, DFF, DFF, 1, 0, 0, 0, DFF / 64, 0, 0};
                pg8::StaticOrder S; S.init(TT, DM, G, bx, 1);
                EpiResid E{A.ws, 0, (int)(WS_HB - WS_H), (3 * L + 2) * TT};
                pg8::gemm_phase(lds3, g, S, E);
            }} else { if (PHMASK & (1 << 7)) {
                LOAD_ARGS unsigned char* wl = A.ws + WS_W0 + (size_t)L * WL_SIZE;
                pg8::Gemm g{(const bf16_t*)(A.ws + WS_HB), (const bf16_t*)(wl + WL_PG), TT, DM, DM, DM, 1, 0, 0, 0, DM / 64, 0, 0};
                pg8::StaticOrder S; S.init(TT, DM, G, bx, 1);
                EpiPle E{A.ws, (3 * L + 2) * TT};
                pg8::gemm_phase(lds3, g, S, E);
            }}
        }
        if (ph + 1 < ph_hi_ || rep + 1 < nrep) { if (ph == 0) grid.sync(); else xcd_barrier(xbar); }
      }
    }
    for (int i = 0; i < EXTRA_SYNCS; ++i) xcd_barrier(xbar);
}

extern "C" void kernel_launch(void* const* d_in, const int* in_sizes, int n_in, void* d_out, int out_size, void* d_ws, size_t ws_size, hipStream_t stream) {
    static int grid = 0;
    if (grid == 0) {
        if (n_in != 19 || out_size != TT * DM || ws_size < WS_END) { fprintf(stderr, "kernel_launch: unexpected problem (n_in %d out %d ws %zu need %zu)\n", n_in, out_size, ws_size, (size_t)WS_END); grid = -1; return; }
        int dev = 0, cus = 0, per_cu = 0;
        hipGetDevice(&dev); hipDeviceGetAttribute(&cus, hipDeviceAttributeMultiprocessorCount, dev);
        if (hipFuncSetAttribute((const void*)mega, hipFuncAttributeMaxDynamicSharedMemorySize, LDS_BYTES) != hipSuccess) { fprintf(stderr, "kernel_launch: hipFuncSetAttribute failed\n"); grid = -1; return; }
        if (hipOccupancyMaxActiveBlocksPerMultiprocessor(&per_cu, (const void*)mega, 512, LDS_BYTES) != hipSuccess || per_cu < 1) { fprintf(stderr, "kernel_launch: occupancy query gave %d\n", per_cu); per_cu = 1; }
        (void)hipGetLastError();
        grid = cus * per_cu;
        fprintf(stderr, "kernel_launch: grid %d (cus %d x %d)\n", grid, cus, per_cu);
    }
    if (grid < 0) return;
    (void)hipMemsetAsync((char*)d_ws + WS_CTL, 0, CTL_ZERO, stream);
    Args a{};
    for (int i = 0; i < 19; ++i) a.in[i] = (const float*)d_in[i];
    a.out = (float*)d_out; a.ws = (unsigned char*)d_ws;
#if MK_MULTI
    for (int ph = 0; ph < NPHASE; ++ph) { a.ph_lo = ph; a.ph_hi = ph + 1; hipLaunchKernelGGL(mega, dim3(grid), dim3(512), LDS_BYTES, stream, a); }
#else
    a.ph_lo = 0; a.ph_hi = NPHASE;
    void* args[] = {&a};
    hipError_t e = hipLaunchCooperativeKernel((const void*)mega, dim3(grid), dim3(512), args, LDS_BYTES, stream);
    if (e != hipSuccess) fprintf(stderr, "kernel_launch: cooperative launch failed: %s (grid %d)\n", hipGetErrorString(e), grid);
#endif
}
```

```cpp
#include <hip/hip_runtime.h>
#include <hip/hip_cooperative_groups.h>
#include <cstdio>
#include <cstdint>
namespace cg = cooperative_groups;

#ifndef PHMASK
#define PHMASK 0xFFFF
#endif
#ifndef REP_MASK
#define REP_MASK 0
#endif
#ifndef EXTRA_SYNCS
#define EXTRA_SYNCS 0
#endif
#ifndef CHAIN_TWICE
#define CHAIN_TWICE 0
#endif
#ifndef MK_MULTI
#define MK_MULTI 0
#endif

typedef unsigned short bf16_t;
typedef short bf16x8 __attribute__((ext_vector_type(8)));
typedef short s16x4 __attribute__((ext_vector_type(4)));
typedef float f32x4 __attribute__((ext_vector_type(4)));
typedef float f32x16 __attribute__((ext_vector_type(16)));
typedef unsigned u32x4 __attribute__((ext_vector_type(4)));
typedef unsigned u32x2 __attribute__((ext_vector_type(2)));

constexpr int TT = 8192, DM = 2048, SEQ = 2048, INC = 11776, DFF = 5632, PLE = 256, NLAYER = 2;
constexpr float EPS = 1e-6f;

typedef float f32x2_t __attribute__((ext_vector_type(2))); typedef __bf16 bf16x2_t __attribute__((ext_vector_type(2)));
__device__ __forceinline__ unsigned cvt_pk_bf16(float lo, float hi) { const f32x2_t v = {lo, hi}; const bf16x2_t b = __builtin_convertvector(v, bf16x2_t); return __builtin_bit_cast(unsigned, b); }
__device__ __forceinline__ float bf2f(unsigned short b) { return __uint_as_float(((unsigned)b) << 16); }
__device__ __forceinline__ float bflo(unsigned w) { return __uint_as_float(w << 16); }
__device__ __forceinline__ float bfhi(unsigned w) { return __uint_as_float(w & 0xffff0000u); }
__device__ __forceinline__ float sigmoidf_(float x) { return __builtin_amdgcn_rcpf(1.0f + __builtin_amdgcn_exp2f(x * -1.4426950408889634f)); }
__device__ __forceinline__ bf16x8 pack8(float a0, float a1, float a2, float a3, float a4, float a5, float a6, float a7) {
    u32x4 w; w.x = cvt_pk_bf16(a0, a1); w.y = cvt_pk_bf16(a2, a3); w.z = cvt_pk_bf16(a4, a5); w.w = cvt_pk_bf16(a6, a7);
    return __builtin_bit_cast(bf16x8, w);
}
__device__ __forceinline__ int crow(int r, int hi) { return (r & 3) + 8 * (r >> 2) + 4 * hi; }
__device__ __forceinline__ int opaque_tid() { int t = threadIdx.x; asm volatile("" : "+v"(t)); return t; }
__device__ __forceinline__ float shflx(float v, int m, int lane) { return __int_as_float(__builtin_amdgcn_ds_bpermute((lane ^ m) << 2, __float_as_int(v))); }
#define MFMA32(a, b, c) __builtin_amdgcn_mfma_f32_32x32x16_bf16((a), (b), (c), 0, 0, 0)

namespace pg8 {
#define PG8_LAS __attribute__((address_space(3)))
constexpr int BM = 256, BK = 64, HALF = 128, HTB = HALF * BK * 2, STAGE_BYTES = 8 * HTB, NXCD = 8, WGM = 8;
__host__ __device__ __forceinline__ int lds_byte(int r, int c) { const int st = (r >> 4) * 2 + (c >> 5), rr = r & 15, cc = c & 31, ob = rr * 64 + cc * 2; return st * 1024 + (ob ^ (((ob >> 9) & 1) << 5)); }
__host__ __device__ __forceinline__ void stage_rc(int b, int& R, int& C) { const int st = b / 1024, sb = b % 1024, swz = sb ^ (((sb >> 9) & 1) << 5); R = (st >> 1) * 16 + swz / 64; C = (st & 1) * 32 + (swz % 64) / 2; }
__host__ __device__ __forceinline__ int perm32(int rho) { const int n = rho >> 4, i = rho & 15; return 8 * (i >> 2) + 4 * n + (i & 3); }

struct Unit { int pm, pn, kind; };
struct Gemm { const bf16_t* A; const bf16_t* Bt; int M, N, lda, ldb; int nseg; int kofs0, kofs1, kofs2; int nt0, nt1, nt2; };

struct StaticOrder {
    int nM, nN, nwg, G, c, nseg;
    __device__ void init(int M, int N, int G_, int c_, int nseg_) { nM = M / BM; nN = N / BM; nwg = nM * nN; G = G_; c = c_; nseg = nseg_; }
    __device__ bool next(int i, Unit& u) const {
        int j = i, kd = 0; if (nseg == 3) { j = i / 3; kd = i - 3 * j; }
        u.kind = kd;
        const long L = (long)j * G + c; if (L >= nwg) return false;
        int wgid = (int)L; { const int q = nwg / NXCD, r = nwg % NXCD, xcd = wgid % NXCD, off = wgid / NXCD; wgid = (xcd < r ? xcd * (q + 1) : r * (q + 1) + (xcd - r) * q) + off; }
        const int nig = WGM * nN, gid = wgid / nig, fm = gid * WGM, gsz = (nM - fm) < WGM ? (nM - fm) : WGM;
        u.pm = fm + ((wgid % nig) % gsz); u.pn = (wgid % nig) / gsz; return true;
    }
};

struct OneUnit { int pm, pn; __device__ bool next(int i, Unit& u) const { u.pm = pm; u.pn = pn; u.kind = 0; return i == 0; } };
template <class Epi, class Sched>
__device__ __forceinline__ void gemm_phase(PG8_LAS unsigned char* lds, const Gemm g, const Sched& S, const Epi& E) {
    const int tid = opaque_tid(), wid = __builtin_amdgcn_readfirstlane(tid >> 6), lane = tid & 63, wr = wid >> 2, wc = wid & 3, fr = lane & 15, fq = lane >> 4;
    unsigned voffA, voffB;
    { int R, C; stage_rc(tid * 16, R, C); const int Rb = (R & ~31) + perm32(R & 31);
      voffA = (unsigned)(R * g.lda + C) * 2u; voffB = (unsigned)(Rb * g.ldb + C) * 2u; }
    const size_t qstepoffA = (size_t)64 * g.lda * 2, qstepoffB = (size_t)64 * g.ldb * 2;
    const size_t kstep = (size_t)(BK * 2);
    const size_t hstepA = (size_t)HALF * g.lda * 2, hstepB = (size_t)HALF * g.ldb * 2;
    const size_t tstepA = 2 * hstepA, tstepB = 2 * hstepB;
    const unsigned ldsw = (unsigned)wid * 1024u;
    const int aoff = lds_byte(wr * 64 + fr, fq * 8), boff = lds_byte(wc * 32 + fr, fq * 8);
#define PG8_SA(b, h) (((b) * 2 + (h)) * HTB)
#define PG8_SB(b, h) ((4 + (b) * 2 + (h)) * HTB)
#define PG8_STAGE(bufoff, gbase, voff) do { _Pragma("unroll") for (int _i = 0; _i < 2; ++_i) \
        __builtin_amdgcn_global_load_lds((const unsigned*)((const char*)(gbase) + (size_t)_i * qstep##voff + v##voff), (PG8_LAS unsigned*)(lds + (bufoff) + ldsw + _i * 8192), 16, 0, 0); } while (0)
#define PG8_LDA(dst, b, h) do { _Pragma("unroll") for (int m = 0; m < 4; ++m) _Pragma("unroll") for (int k = 0; k < 2; ++k) dst[m][k] = *(const PG8_LAS bf16x8*)(lds + PG8_SA(b, h) + aoff + m * 2048 + k * 1024); } while (0)
#define PG8_LDB(dst, b, h) do { _Pragma("unroll") for (int n = 0; n < 2; ++n) _Pragma("unroll") for (int k = 0; k < 2; ++k) dst[n][k] = *(const PG8_LAS bf16x8*)(lds + PG8_SB(b, h) + boff + n * 2048 + k * 1024); } while (0)
#define PG8_MMA(ai, bj, At, Bt) do { __builtin_amdgcn_s_setprio(1); _Pragma("unroll") for (int m = 0; m < 4; ++m) _Pragma("unroll") for (int n = 0; n < 2; ++n) _Pragma("unroll") for (int k = 0; k < 2; ++k) \
        acc[ai][bj][m][n] = __builtin_amdgcn_mfma_f32_16x16x32_bf16(Bt[n][k], At[m][k], acc[ai][bj][m][n], 0, 0, 0); __builtin_amdgcn_s_setprio(0); } while (0)
#define PG8_WAIT_V(n) asm volatile("s_waitcnt vmcnt(" #n ")" ::: "memory")
#define PG8_WAIT_L(n) asm volatile("s_waitcnt lgkmcnt(" #n ")" ::: "memory")
#define PG8_BAR __builtin_amdgcn_s_barrier()
#define PG8_SCHED __builtin_amdgcn_sched_barrier(0)
#define PG8_KOFS(u) ((u).kind == 0 ? g.kofs0 : ((u).kind == 1 ? g.kofs1 : g.kofs2))
#define PG8_NT(u) ((u).kind == 0 ? g.nt0 : ((u).kind == 1 ? g.nt1 : g.nt2))
    Unit cur, nxt; int ui = 0;
    if (!S.next(0, cur)) return;
    f32x4 acc[2][2][4][2];
#pragma unroll
    for (int a = 0; a < 2; ++a)
#pragma unroll
        for (int b = 0; b < 2; ++b)
#pragma unroll
            for (int m = 0; m < 4; ++m)
#pragma unroll
                for (int n = 0; n < 2; ++n) acc[a][b][m][n] = (f32x4){0.f, 0.f, 0.f, 0.f};
    bf16x8 At[4][2], B0[2][2], B1[2][2];
    const char* cA = (const char*)g.A + (size_t)cur.pm * tstepA + (size_t)PG8_KOFS(cur) * 2; const char* cB = (const char*)g.Bt + (size_t)cur.pn * tstepB + (size_t)PG8_KOFS(cur) * 2;
    PG8_STAGE(PG8_SB(0, 0), cB, offB); PG8_STAGE(PG8_SB(0, 1), cB + hstepB, offB); PG8_STAGE(PG8_SA(0, 0), cA, offA); PG8_STAGE(PG8_SA(0, 1), cA + hstepA, offA);
    if (wr == 1) PG8_BAR;
    PG8_WAIT_V(2); PG8_BAR;
    PG8_STAGE(PG8_SB(1, 0), cB + kstep, offB); PG8_STAGE(PG8_SA(1, 0), cA + kstep, offA); PG8_STAGE(PG8_SB(1, 1), cB + hstepB + kstep, offB);
    PG8_WAIT_V(6); PG8_BAR;
    for (;;) {
        const bool has_next = S.next(ui + 1, nxt);
        const char* nA = has_next ? (const char*)g.A + (size_t)nxt.pm * tstepA + (size_t)PG8_KOFS(nxt) * 2 : cA;
        const char* nB = has_next ? (const char*)g.Bt + (size_t)nxt.pn * tstepB + (size_t)PG8_KOFS(nxt) * 2 : cB;
        const int nt = PG8_NT(cur);
        for (int t = 0; t < nt; t += 2) {
            const bool last = (t == nt - 2);
            const char* a1 = cA + (size_t)(t + 1) * kstep;
            const char* a2 = last ? nA : cA + (size_t)(t + 2) * kstep; const char* b2 = last ? nB : cB + (size_t)(t + 2) * kstep;
            const char* a3 = a2 + kstep; const char* b3 = b2 + kstep;
            PG8_LDB(B0, 0, 0); PG8_LDB(B1, 0, 1); PG8_SCHED; PG8_LDA(At, 0, 0); PG8_STAGE(PG8_SA(1, 1), a1 + hstepA, offA);
            PG8_WAIT_V(8); PG8_WAIT_L(0); PG8_BAR; PG8_MMA(0, 0, At, B0); PG8_MMA(0, 1, At, B1); PG8_BAR; PG8_SCHED;
            PG8_LDA(At, 0, 1); PG8_STAGE(PG8_SB(0, 0), b2, offB); PG8_STAGE(PG8_SB(0, 1), b2 + hstepB, offB); PG8_STAGE(PG8_SA(0, 0), a2, offA);
            PG8_WAIT_V(8); PG8_WAIT_L(0); PG8_BAR; PG8_MMA(1, 0, At, B0); PG8_MMA(1, 1, At, B1); PG8_BAR; PG8_SCHED;
            PG8_LDB(B0, 1, 0); PG8_LDB(B1, 1, 1); PG8_SCHED; PG8_LDA(At, 1, 0); PG8_STAGE(PG8_SA(0, 1), a2 + hstepA, offA);
            PG8_WAIT_V(8); PG8_WAIT_L(0); PG8_BAR; PG8_MMA(0, 0, At, B0); PG8_MMA(0, 1, At, B1); PG8_BAR; PG8_SCHED;
            PG8_LDA(At, 1, 1); PG8_STAGE(PG8_SB(1, 0), b3, offB); PG8_STAGE(PG8_SB(1, 1), b3 + hstepB, offB); PG8_STAGE(PG8_SA(1, 0), a3, offA);
            PG8_WAIT_V(8); PG8_WAIT_L(0); PG8_BAR; PG8_MMA(1, 0, At, B0); PG8_MMA(1, 1, At, B1); PG8_BAR; PG8_SCHED;
        }
        if (wr == 0) PG8_BAR;
        const bool keep = E(acc, cur, wr, wc, fr, fq);
        if (!has_next) break;
        if (!keep) {
#pragma unroll
        for (int a = 0; a < 2; ++a)
#pragma unroll
            for (int b = 0; b < 2; ++b)
#pragma unroll
                for (int m = 0; m < 4; ++m)
#pragma unroll
                    for (int n = 0; n < 2; ++n) acc[a][b][m][n] = (f32x4){0.f, 0.f, 0.f, 0.f};
        }
        cur = nxt; cA = nA; cB = nB; ++ui;
        if (wr == 1) PG8_BAR;
    }
    PG8_WAIT_V(0);
    PG8_BAR;
#undef PG8_SA
#undef PG8_SB
#undef PG8_STAGE
#undef PG8_LDA
#undef PG8_LDB
#undef PG8_MMA
#undef PG8_WAIT_V
#undef PG8_WAIT_L
#undef PG8_BAR
#undef PG8_SCHED
#undef PG8_KOFS
#undef PG8_NT
}
}

constexpr size_t MiB = 1u << 20;
constexpr size_t WS_CTL = 0;
constexpr size_t WS_W0 = 1 * MiB;
constexpr size_t WL_IN = 0, WL_BR = 46 * MiB, WL_OUT = 54 * MiB, WL_GU = 62 * MiB, WL_DN = 106 * MiB, WL_PG = 128 * MiB, WL_PP = 136 * MiB, WL_SIZE = 137 * MiB;
constexpr size_t WS_H = WS_W0 + 2 * WL_SIZE;
constexpr size_t WS_X = WS_H + 32 * MiB;
constexpr size_t WS_U = WS_X + 64 * MiB;
constexpr size_t WS_SQ = WS_U + 16 * MiB;
constexpr size_t WS_SK = WS_SQ + 16 * MiB;
constexpr size_t WS_VT = WS_SK + 16 * MiB;
constexpr size_t WS_ZF = WS_VT + 16 * MiB;
constexpr size_t WS_HV = WS_ZF + 16 * MiB;
constexpr size_t WS_HQ = WS_HV + 8 * MiB;
constexpr size_t WS_OG = WS_HQ + 16 * MiB;
constexpr size_t WS_GT = WS_OG + 8 * MiB;
constexpr size_t WS_ACT = WS_GT;
constexpr size_t WS_Y = WS_GT + 96 * MiB;
constexpr size_t WS_MIX = WS_Y + 32 * MiB;
constexpr size_t WS_PB = WS_MIX + 32 * MiB;
constexpr size_t WS_HVT = WS_PB + 8 * MiB;
constexpr size_t WS_HDEC = WS_HVT + 8 * MiB;
constexpr size_t WS_HB = WS_HDEC + 1 * MiB;
constexpr size_t WS_PPB = WS_HB + 32 * MiB;
constexpr size_t WS_END = WS_PPB + 32 * MiB;
constexpr size_t WS_HOI = WS_MIX;
constexpr size_t WS_HQD = WS_MIX + 16 * MiB;
constexpr size_t WS_HKD = WS_MIX + 24 * MiB;
constexpr size_t CTL_SS = 65536;
constexpr size_t CTL_ZERO = CTL_SS + 7 * TT * 4;

constexpr int LDS_PSUM_OFF = 132096;
typedef f32x4 AccT[2][2][4][2];
#define EPI_LOOP_BEGIN  const int row0_ = u.pm * 256 + wr * 64 + fr; \
    _Pragma("unroll") for (int ai = 0; ai < 2; ++ai) _Pragma("unroll") for (int m = 0; m < 4; ++m) { const int row = row0_ + ai * 128 + m * 16; \
    _Pragma("unroll") for (int bj = 0; bj < 2; ++bj) { const int col = u.pn * 256 + bj * 128 + wc * 32 + 8 * fq; f32x4 v0 = acc[ai][bj][m][0], v1 = acc[ai][bj][m][1];
#define EPI_LOOP_END }}
__device__ __forceinline__ float rstd_of(float ss) { return __builtin_amdgcn_rsqf(ss * (1.0f / DM) + EPS); }
__device__ __forceinline__ float rstd_row(const float* SSP, int row) { const f32x4 a = *(const f32x4*)(SSP + (size_t)row * 8), b = *(const f32x4*)(SSP + (size_t)row * 8 + 4);
    return rstd_of(((a[0] + a[1]) + (a[2] + a[3])) + ((b[0] + b[1]) + (b[2] + b[3]))); }
__device__ __forceinline__ void ps_write(int rit, int wc, float sq) {
    extern __shared__ __attribute__((aligned(16))) unsigned char lds_e_[];
    ((float*)(lds_e_ + LDS_PSUM_OFF))[rit * 4 + wc] = sq;
}
__device__ __forceinline__ void ps_finish(float* SSP, const pg8::Unit& u, int wr, int wc, int fr, int fq) {
    extern __shared__ __attribute__((aligned(16))) unsigned char lds_e_[];
    const float* PS = (const float*)(lds_e_ + LDS_PSUM_OFF);
    asm volatile("s_waitcnt lgkmcnt(0)" ::: "memory"); __builtin_amdgcn_s_barrier(); asm volatile("" ::: "memory");
    const int t_ = (wr * 4 + wc) * 64 + fq * 16 + fr;
    if (t_ < 256) { const f32x4 p = *(const f32x4*)(PS + t_ * 4); SSP[(size_t)(u.pm * 256 + t_) * 8 + u.pn] = (p[0] + p[1]) + (p[2] + p[3]); }
}
#define EPI_LOOP_BEGIN_R(SSP)  const int row0_ = u.pm * 256 + wr * 64 + fr; \
    _Pragma("unroll") for (int ai = 0; ai < 2; ++ai) _Pragma("unroll") for (int m = 0; m < 4; ++m) { const int row = row0_ + ai * 128 + m * 16; const float rs_ = rstd_row((SSP), row); \
    _Pragma("unroll") for (int bj = 0; bj < 2; ++bj) { const int col = u.pn * 256 + bj * 128 + wc * 32 + 8 * fq; f32x4 v0 = acc[ai][bj][m][0] * rs_, v1 = acc[ai][bj][m][1] * rs_;

__device__ __forceinline__ u32x4 pack8v(f32x4 v0, f32x4 v1) { u32x4 w; w.x = cvt_pk_bf16(v0[0], v0[1]); w.y = cvt_pk_bf16(v0[2], v0[3]); w.z = cvt_pk_bf16(v1[0], v1[1]); w.w = cvt_pk_bf16(v1[2], v1[3]); return w; }

struct EpiIn {
    unsigned char* ws; int ssofs;
    __device__ __forceinline__ bool operator()(AccT& acc, const pg8::Unit& u, int wr, int wc, int fr, int fq) const {
        float* U = (float*)(ws + WS_U); bf16_t* SQ = (bf16_t*)(ws + WS_SQ); bf16_t* SK = (bf16_t*)(ws + WS_SK); bf16_t* VT = (bf16_t*)(ws + WS_VT); float* ZF = (float*)(ws + WS_ZF);
        bf16_t* HV = (bf16_t*)(ws + WS_HV); float* HQ = (float*)(ws + WS_HQ); bf16_t* OG = (bf16_t*)(ws + WS_OG); bf16_t* GT = (bf16_t*)(ws + WS_GT);
        const float* SS = (const float*)(ws + WS_X) + (size_t)ssofs * 8; const float qscale = 0.08838834764831845f * 1.4426950408889634f;
        const int colt = u.pn * 256;
        if (colt < 512) {
            EPI_LOOP_BEGIN_R(SS) float* p = U + (size_t)row * 512 + col; *(f32x4*)p = v0; *(f32x4*)(p + 4) = v1; EPI_LOOP_END
        } else if (colt < 1536) {
            const float s = qscale;
            EPI_LOOP_BEGIN_R(SS) *(u32x4*)(SQ + (size_t)row * 1024 + (col - 512)) = pack8v(v0 * s, v1 * s); EPI_LOOP_END
        } else if (colt < 2560) {
            EPI_LOOP_BEGIN_R(SS) *(u32x4*)(SK + (size_t)row * 1024 + (col - 1536)) = pack8v(v0, v1); EPI_LOOP_END
        } else if (colt < 3584) {
            EPI_LOOP_BEGIN_R(SS) const int cc = col - 2560, hh = cc >> 7, d = cc & 127, b = row >> 11, s = row & 2047;
                bf16_t* p = VT + (((size_t)(b * 8 + hh) * 128 + d) << 11) + s; const u32x4 w = pack8v(v0, v1);
                p[0] = (bf16_t)(w.x & 0xffff); p[2048] = (bf16_t)(w.x >> 16); p[2 * 2048] = (bf16_t)(w.y & 0xffff); p[3 * 2048] = (bf16_t)(w.y >> 16);
                p[4 * 2048] = (bf16_t)(w.z & 0xffff); p[5 * 2048] = (bf16_t)(w.z >> 16); p[6 * 2048] = (bf16_t)(w.w & 0xffff); p[7 * 2048] = (bf16_t)(w.w >> 16); EPI_LOOP_END
        } else if (colt < 4096) {
            EPI_LOOP_BEGIN_R(SS) float* p = ZF + (size_t)row * 512 + (col - 3584); *(f32x4*)p = v0; *(f32x4*)(p + 4) = v1; EPI_LOOP_END
        } else if (colt < 4608) {
            EPI_LOOP_BEGIN_R(SS) *(u32x4*)(HV + (size_t)row * 512 + (col - 4096)) = pack8v(v0, v1); EPI_LOOP_END
        } else if (colt < 5120) {
            EPI_LOOP_BEGIN_R(SS)
#pragma unroll
                for (int j = 0; j < 4; ++j) { v0[j] = v0[j] * sigmoidf_(v0[j]); v1[j] = v1[j] * sigmoidf_(v1[j]); }
                float* p = HQ + (size_t)row * 512 + (col - 4608); *(f32x4*)p = v0; *(f32x4*)(p + 4) = v1; EPI_LOOP_END
        } else if (colt < 5632) {
            EPI_LOOP_BEGIN_R(SS)
#pragma unroll
                for (int j = 0; j < 4; ++j) { v0[j] = v0[j] * sigmoidf_(v0[j]); v1[j] = v1[j] * sigmoidf_(v1[j]); }
                *(u32x4*)(OG + (size_t)row * 512 + (col - 5120)) = pack8v(v0, v1); EPI_LOOP_END
        } else {
            EPI_LOOP_BEGIN_R(SS)
#pragma unroll
                for (int j = 0; j < 4; ++j) { v0[j] = sigmoidf_(v0[j]); v1[j] = sigmoidf_(v1[j]); }
                *(u32x4*)(GT + (size_t)row * 6144 + (col - 5632)) = pack8v(v0, v1); EPI_LOOP_END
        }
        return false;
    }
};
struct EpiBranch {
    unsigned char* ws;
    __device__ __forceinline__ bool operator()(AccT& acc, const pg8::Unit& u, int wr, int wc, int fr, int fq) const {
        const bf16_t* GT = (const bf16_t*)(ws + WS_GT); bf16_t* MIX = (bf16_t*)(ws + WS_MIX);
        const int kind = u.kind;
        const int row0_ = u.pm * 256 + wr * 64 + fr;
#pragma unroll
        for (int ai = 0; ai < 2; ++ai)
#pragma unroll
            for (int m = 0; m < 4; ++m) { const int row = row0_ + ai * 128 + m * 16;
#pragma unroll
                for (int bj = 0; bj < 2; ++bj) { const int col = u.pn * 256 + bj * 128 + wc * 32 + 8 * fq;
                    const u32x4 ga = *(const u32x4*)(GT + (size_t)row * 6144 + kind * 2048 + col);
                    float a[8] = {bflo(ga.x), bfhi(ga.x), bflo(ga.y), bfhi(ga.y), bflo(ga.z), bfhi(ga.z), bflo(ga.w), bfhi(ga.w)};
#pragma unroll
                    for (int j = 0; j < 8; ++j) a[j] = fmaxf(a[j], 1e-30f);
                    if (kind < 2) {
                        const u32x4 gb = *(const u32x4*)(GT + (size_t)row * 6144 + (kind + 1) * 2048 + col);
                        float b[8] = {bflo(gb.x), bfhi(gb.x), bflo(gb.y), bfhi(gb.y), bflo(gb.z), bfhi(gb.z), bflo(gb.w), bfhi(gb.w)};
#pragma unroll
                        for (int j = 0; j < 8; ++j) { const float rr = a[j] * __builtin_amdgcn_rcpf(fmaxf(b[j], 1e-30f)); if (j < 4) acc[ai][bj][m][0][j] *= rr; else acc[ai][bj][m][1][j - 4] *= rr; }
                    } else {
                        f32x4 v0 = acc[ai][bj][m][0], v1 = acc[ai][bj][m][1];
#pragma unroll
                        for (int j = 0; j < 4; ++j) { v0[j] *= a[j]; v1[j] *= a[j + 4]; }
                        *(u32x4*)(MIX + (size_t)row * 2048 + col) = pack8v(v0, v1);
                    }
                } }
        return kind < 2;
    }
};
struct EpiResid {
    unsigned char* ws; int rboff, xboff, ssofs;
    __device__ __forceinline__ bool operator()(AccT& acc, const pg8::Unit& u, int wr, int wc, int fr, int fq) const {
        const bf16_t* RB = (const bf16_t*)(ws + WS_H + (size_t)rboff); bf16_t* XB = (bf16_t*)(ws + WS_H + (size_t)xboff); float* SSO = (float*)(ws + WS_X) + (size_t)ssofs * 8;
        const int row0_ = u.pm * 256 + wr * 64 + fr;
#pragma unroll
        for (int ai = 0; ai < 2; ++ai)
#pragma unroll
            for (int m = 0; m < 4; ++m) { const int row = row0_ + ai * 128 + m * 16; float sq = 0.f;
#pragma unroll
                for (int bj = 0; bj < 2; ++bj) { const int col = u.pn * 256 + bj * 128 + wc * 32 + 8 * fq; const size_t o = (size_t)row * 2048 + col;
                    const u32x4 rw = *(const u32x4*)(RB + o); f32x4 v0 = acc[ai][bj][m][0], v1 = acc[ai][bj][m][1];
                    v0[0] += bflo(rw.x); v0[1] += bfhi(rw.x); v0[2] += bflo(rw.y); v0[3] += bfhi(rw.y); v1[0] += bflo(rw.z); v1[1] += bfhi(rw.z); v1[2] += bflo(rw.w); v1[3] += bfhi(rw.w);
                    *(u32x4*)(XB + o) = pack8v(v0, v1);
                    sq += (v0[0] * v0[0] + v0[1] * v0[1]) + (v0[2] * v0[2] + v0[3] * v0[3]) + (v1[0] * v1[0] + v1[1] * v1[1]) + (v1[2] * v1[2] + v1[3] * v1[3]); }
                sq += shflx(sq, 16, fr + 16 * fq); sq += shflx(sq, 32, fr + 16 * fq); if (fq == 0) ps_write(ai * 128 + wr * 64 + m * 16 + fr, wc, sq); }
        ps_finish(SSO, u, wr, wc, fr, fq);
        return false;
    }
};
struct EpiSwiglu {
    unsigned char* ws; int ssofs;
    __device__ __forceinline__ bool operator()(AccT& acc, const pg8::Unit& u, int wr, int wc, int fr, int fq) const {
        bf16_t* ACT = (bf16_t*)(ws + WS_ACT); const float* SS = (const float*)(ws + WS_X) + (size_t)ssofs * 8;
        const int row0_ = u.pm * 256 + wr * 64 + fr;
#pragma unroll
        for (int ai = 0; ai < 2; ++ai)
#pragma unroll
            for (int m = 0; m < 4; ++m) { const int row = row0_ + ai * 128 + m * 16; const int col = u.pn * 128 + wc * 32 + 8 * fq; const float rs_ = rstd_row(SS, row);
                f32x4 g0 = acc[ai][0][m][0] * rs_, g1 = acc[ai][0][m][1] * rs_; const f32x4 u0 = acc[ai][1][m][0] * rs_, u1 = acc[ai][1][m][1] * rs_;
#pragma unroll
                for (int j = 0; j < 4; ++j) { g0[j] = g0[j] * sigmoidf_(g0[j]) * u0[j]; g1[j] = g1[j] * sigmoidf_(g1[j]) * u1[j]; }
                *(u32x4*)(ACT + (size_t)row * DFF + col) = pack8v(g0, g1); }
        return false;
    }
};
struct EpiBf16 {
    unsigned char* ws;
    __device__ __forceinline__ bool operator()(AccT& acc, const pg8::Unit& u, int wr, int wc, int fr, int fq) const {
        bf16_t* OUT = (bf16_t*)(ws + WS_PPB);
        EPI_LOOP_BEGIN *(u32x4*)(OUT + (size_t)row * 2048 + col) = pack8v(v0, v1); EPI_LOOP_END
        return false;
    }
};
struct EpiPle {
    unsigned char* ws; int ssofs;
    __device__ __forceinline__ bool operator()(AccT& acc, const pg8::Unit& u, int wr, int wc, int fr, int fq) const {
        const bf16_t* RB = (const bf16_t*)(ws + WS_HB); const bf16_t* PP = (const bf16_t*)(ws + WS_PPB); bf16_t* XB = (bf16_t*)(ws + WS_H);
        const float* SS = (const float*)(ws + WS_X) + (size_t)ssofs * 8; float* SSO = (float*)(ws + WS_X) + (size_t)(ssofs + TT) * 8;
        const int row0_ = u.pm * 256 + wr * 64 + fr;
#pragma unroll
        for (int ai = 0; ai < 2; ++ai)
#pragma unroll
            for (int m = 0; m < 4; ++m) { const int row = row0_ + ai * 128 + m * 16; const float rs_ = rstd_row(SS, row); float sq = 0.f;
#pragma unroll
                for (int bj = 0; bj < 2; ++bj) { const int col = u.pn * 256 + bj * 128 + wc * 32 + 8 * fq; const size_t o = (size_t)row * 2048 + col;
                    const u32x4 rw = *(const u32x4*)(RB + o); const u32x4 pw = *(const u32x4*)(PP + o);
                    f32x4 v0 = acc[ai][bj][m][0] * rs_, v1 = acc[ai][bj][m][1] * rs_;
                    v0[0] = bflo(rw.x) + sigmoidf_(v0[0]) * bflo(pw.x); v0[1] = bfhi(rw.x) + sigmoidf_(v0[1]) * bfhi(pw.x); v0[2] = bflo(rw.y) + sigmoidf_(v0[2]) * bflo(pw.y); v0[3] = bfhi(rw.y) + sigmoidf_(v0[3]) * bfhi(pw.y);
                    v1[0] = bflo(rw.z) + sigmoidf_(v1[0]) * bflo(pw.z); v1[1] = bfhi(rw.z) + sigmoidf_(v1[1]) * bfhi(pw.z); v1[2] = bflo(rw.w) + sigmoidf_(v1[2]) * bflo(pw.w); v1[3] = bfhi(rw.w) + sigmoidf_(v1[3]) * bfhi(pw.w);
                    *(u32x4*)(XB + o) = pack8v(v0, v1);
                    sq += (v0[0] * v0[0] + v0[1] * v0[1]) + (v0[2] * v0[2] + v0[3] * v0[3]) + (v1[0] * v1[0] + v1[1] * v1[1]) + (v1[2] * v1[2] + v1[3] * v1[3]); }
                sq += shflx(sq, 16, fr + 16 * fq); sq += shflx(sq, 32, fr + 16 * fq); if (fq == 0) ps_write(ai * 128 + wr * 64 + m * 16 + fr, wc, sq); }
        ps_finish(SSO, u, wr, wc, fr, fq);
        return false;
    }
};

constexpr int LDS_MISC = 131072, LDS_PSUM = 132096, LDS_BYTES = 132096 + 4096;
constexpr int PPL = 8;
constexpr int NPHASE = 2 + PPL * NLAYER;

struct Args { const float* in[19]; float* out; unsigned char* ws; int ph_lo, ph_hi; };

__device__ __forceinline__ float wave_sum(float v, int lane) {
#pragma unroll
    for (int o = 1; o < 64; o <<= 1) v += shflx(v, o, lane);
    return v;
}
template <bool F32OUT>
__device__ __forceinline__ void rmsnorm_rows(const float* X, const float* G, bf16_t* OB, float* OF) {
    const int tid_ = opaque_tid(); const int lane = tid_ & 63, gw = blockIdx.x * 8 + (tid_ >> 6), ngw = gridDim.x * 8;
    for (int row = gw; row < TT; row += ngw) {
        const f32x4* xr = (const f32x4*)(X + (size_t)row * DM) + lane;
        f32x4 v[8]; float s = 0.f;
#pragma unroll
        for (int j = 0; j < 8; ++j) { v[j] = xr[64 * j]; s += (v[j][0] * v[j][0] + v[j][1] * v[j][1]) + (v[j][2] * v[j][2] + v[j][3] * v[j][3]); }
        const float rstd = 1.0f / sqrtf(wave_sum(s, lane) * (1.0f / DM) + EPS);
#pragma unroll
        for (int j = 0; j < 8; ++j) { const f32x4 gg = ((const f32x4*)G)[lane + 64 * j]; const f32x4 y = v[j] * rstd * gg;
            if (F32OUT) ((f32x4*)(OF + (size_t)row * DM))[lane + 64 * j] = y;
            else { u32x2 w; w.x = cvt_pk_bf16(y[0], y[1]); w.y = cvt_pk_bf16(y[2], y[3]); ((u32x2*)(OB + (size_t)row * DM))[lane + 64 * j] = w; } }
    }
}

__device__ __forceinline__ void final_norm_rows(const bf16_t* XB, const float* SS, const float* G, float* OF) {
    const int tid_ = opaque_tid(); const int lane = tid_ & 63, gw = blockIdx.x * 8 + (tid_ >> 6), ngw = gridDim.x * 8;
    for (int row = gw; row < TT; row += ngw) {
        const float rstd = rstd_row(SS, row);
#pragma unroll
        for (int j = 0; j < 4; ++j) { const u32x4 w = ((const u32x4*)(XB + (size_t)row * DM))[lane + 64 * j];
            const f32x4 ga = ((const f32x4*)G)[2 * (lane + 64 * j)], gb = ((const f32x4*)G)[2 * (lane + 64 * j) + 1];
            f32x4 y0, y1; y0[0] = bflo(w.x) * rstd * ga[0]; y0[1] = bfhi(w.x) * rstd * ga[1]; y0[2] = bflo(w.y) * rstd * ga[2]; y0[3] = bfhi(w.y) * rstd * ga[3];
            y1[0] = bflo(w.z) * rstd * gb[0]; y1[1] = bfhi(w.z) * rstd * gb[1]; y1[2] = bflo(w.w) * rstd * gb[2]; y1[3] = bfhi(w.w) * rstd * gb[3];
            ((f32x4*)(OF + (size_t)row * DM))[2 * (lane + 64 * j)] = y0; ((f32x4*)(OF + (size_t)row * DM))[2 * (lane + 64 * j) + 1] = y1; }
    }
}
__device__ __forceinline__ void rows_bf16_ss(const float* X, bf16_t* OB, float* SSO) {
    const int tid_ = opaque_tid(); const int lane = tid_ & 63, gw = blockIdx.x * 8 + (tid_ >> 6), ngw = gridDim.x * 8;
    for (int row = gw; row < TT; row += ngw) {
        const f32x4* xr = (const f32x4*)(X + (size_t)row * DM) + lane; float s = 0.f;
#pragma unroll
        for (int j = 0; j < 8; ++j) { const f32x4 v = xr[64 * j]; s += (v[0] * v[0] + v[1] * v[1]) + (v[2] * v[2] + v[3] * v[3]);
            u32x2 w; w.x = cvt_pk_bf16(v[0], v[1]); w.y = cvt_pk_bf16(v[2], v[3]); ((u32x2*)(OB + (size_t)row * DM))[lane + 64 * j] = w; }
        s = wave_sum(s, lane); if (lane == 0) { float z = 0.f; asm volatile("" : "+v"(z)); *(f32x4*)(SSO + (size_t)row * 8) = (f32x4){s, z, z, z}; *(f32x4*)(SSO + (size_t)row * 8 + 4) = (f32x4){z, z, z, z}; }
    }
}
struct TJob { const float* src; const float* gain; bf16_t* dst; int N, ldd, k0, n0, drow0, dk0; };
__device__ __forceinline__ TJob tjob_decode(const Args& a, int it) {
    constexpr int C_IN = 16 * 92, C_BP = 4 * 16, C_BS = 8 * 16, C_BH = 4 * 16, C_OUT = 256, C_GU = 16 * 88, C_DN = 44 * 16, C_PG = 256, C_PP = 2 * 16;
    constexpr int PER_L = C_IN + C_BP + C_BS + C_BH + C_OUT + C_GU + C_DN + C_PG + C_PP;
    const int L = it / PER_L; int r = it - L * PER_L;
    unsigned char* wl = a.ws + WS_W0 + (size_t)L * WL_SIZE;
    TJob J; J.gain = nullptr; J.dk0 = 0; int nkb, gu = 0;
    if (r < C_IN) { J.src = a.in[3] + (size_t)L * DM * INC; J.N = INC; J.dst = (bf16_t*)(wl + WL_IN); J.ldd = DM; nkb = 16; J.gain = a.in[2] + (size_t)L * DM; }
    else if ((r -= C_IN) < C_BP) { J.src = a.in[8] + (size_t)L * 512 * DM; J.N = DM; J.dst = (bf16_t*)(wl + WL_BR); J.ldd = DM; nkb = 4; }
    else if ((r -= C_BP) < C_BS) { J.src = a.in[9] + (size_t)L * 1024 * DM; J.N = DM; J.dst = (bf16_t*)(wl + WL_BR); J.ldd = DM; J.dk0 = 512; nkb = 8; }
    else if ((r -= C_BS) < C_BH) { J.src = a.in[10] + (size_t)L * 512 * DM; J.N = DM; J.dst = (bf16_t*)(wl + WL_BR); J.ldd = DM; J.dk0 = 1536; nkb = 4; }
    else if ((r -= C_BH) < C_OUT) { J.src = a.in[11] + (size_t)L * DM * DM; J.N = DM; J.dst = (bf16_t*)(wl + WL_OUT); J.ldd = DM; nkb = 16; }
    else if ((r -= C_OUT) < C_GU) { J.src = a.in[13] + (size_t)L * DM * 2 * DFF; J.N = 2 * DFF; J.dst = (bf16_t*)(wl + WL_GU); J.ldd = DM; nkb = 16; gu = 1; J.gain = a.in[12] + (size_t)L * DM; }
    else if ((r -= C_GU) < C_DN) { J.src = a.in[14] + (size_t)L * DFF * DM; J.N = DM; J.dst = (bf16_t*)(wl + WL_DN); J.ldd = DFF; nkb = 44; }
    else if ((r -= C_DN) < C_PG) { J.src = a.in[16] + (size_t)L * DM * DM; J.N = DM; J.dst = (bf16_t*)(wl + WL_PG); J.ldd = DM; nkb = 16; J.gain = a.in[15] + (size_t)L * DM; }
    else { r -= C_PG; J.src = a.in[17] + (size_t)L * PLE * DM; J.N = DM; J.dst = (bf16_t*)(wl + WL_PP); J.ldd = PLE; nkb = 2; }
    const int nb = r / nkb, kb = r - nb * nkb;
    J.drow0 = nb * 128; if (gu) J.drow0 = nb < 44 ? 256 * nb : 256 * (nb - 44) + 128;
    J.k0 = kb * 128; J.n0 = nb * 128;
    return J;
}
__device__ __forceinline__ void tjob_load(const TJob& J, int tid, f32x4 (&v)[8]) {
#pragma unroll
    for (int p = 0; p < 8; ++p) { const int k = p * 16 + (tid >> 5), c = (tid & 31) * 4;
        v[p] = *(const f32x4*)(J.src + (size_t)(J.k0 + k) * J.N + J.n0 + c); if (J.gain) v[p] = v[p] * J.gain[J.k0 + k]; }
}
__device__ __forceinline__ void tjob_finish(const TJob& J, int tid, const f32x4 (&v)[8], float* sm) {
#pragma unroll
    for (int p = 0; p < 8; ++p) { const int k = p * 16 + (tid >> 5), c = (tid & 31) * 4; float* s = sm + k * 129 + c; s[0] = v[p][0]; s[1] = v[p][1]; s[2] = v[p][2]; s[3] = v[p][3]; }
    __syncthreads();
#pragma unroll
    for (int i = 0; i < 4; ++i) { const int item = tid + 512 * i, c = item & 15, n = item >> 4; const float* s = sm + (8 * c) * 129 + n;
        u32x4 w; w.x = cvt_pk_bf16(s[0], s[129]); w.y = cvt_pk_bf16(s[2 * 129], s[3 * 129]); w.z = cvt_pk_bf16(s[4 * 129], s[5 * 129]); w.w = cvt_pk_bf16(s[6 * 129], s[7 * 129]);
        *(u32x4*)(J.dst + (size_t)(J.drow0 + n) * J.ldd + J.dk0 + J.k0 + 8 * c) = w; }
    __syncthreads();
}

__device__ __forceinline__ void prologue_phase(const Args& a, unsigned char* lds) {
    float* sm = (float*)lds;
    constexpr int N_ITEMS = NLAYER * (16 * 92 + 4 * 16 + 8 * 16 + 4 * 16 + 256 + 16 * 88 + 44 * 16 + 256 + 2 * 16);
    {   const int tid = opaque_tid();
        int it = blockIdx.x;
        if (it < N_ITEMS) {
            TJob J = tjob_decode(a, it); f32x4 v[8]; tjob_load(J, tid, v);
            for (;;) {
                const int itn = it + gridDim.x; const bool more = itn < N_ITEMS;
                TJob Jn = J; f32x4 vn[8];
#pragma unroll
                for (int p = 0; p < 8; ++p) vn[p] = v[p];
                if (more) { Jn = tjob_decode(a, itn); tjob_load(Jn, tid, vn); }
                tjob_finish(J, tid, v, sm);
                if (!more) break;
                J = Jn; it = itn;
#pragma unroll
                for (int p = 0; p < 8; ++p) v[p] = vn[p];
            }
        }
    }
    { const f32x4* ps = (const f32x4*)a.in[1]; u32x2* pd = (u32x2*)(a.ws + WS_PB); const int n4 = NLAYER * TT * PLE / 4;
      for (int i = blockIdx.x * 512 + opaque_tid(); i < n4; i += gridDim.x * 512) { const f32x4 v = ps[i]; u32x2 w; w.x = cvt_pk_bf16(v[0], v[1]); w.y = cvt_pk_bf16(v[2], v[3]); pd[i] = w; } }
    rows_bf16_ss(a.in[0], (bf16_t*)(a.ws + WS_H), (float*)(a.ws + WS_X));
}

__device__ __forceinline__ void pool_unit(unsigned char* lds, int tile, int gi, int L, const Args& a) {
    float* Wl = (float*)lds; float* uw = Wl + 128 * 128; float* mx = uw + 47 * 128;
    const int tid = opaque_tid();
    const float* U = (const float*)(a.ws + WS_U);
    const float* PW = a.in[4] + ((size_t)L * 4 + gi) * 128 * 128;
    const int t0 = tile * 32, s0 = t0 & (SEQ - 1);
#pragma unroll
    for (int i = 0; i < 8; ++i) ((f32x4*)Wl)[tid + 512 * i] = ((const f32x4*)PW)[tid + 512 * i];
    for (int i = tid; i < 47 * 32; i += 512) { const int rr = i >> 5, c4 = i & 31; const int sp = s0 - 15 + rr;
        f32x4 v = (f32x4){0.f, 0.f, 0.f, 0.f};
        if (sp >= 0) v = *(const f32x4*)(U + (size_t)(t0 - 15 + rr) * 512 + gi * 128 + c4 * 4);
        ((f32x4*)uw)[i] = v; }
    __syncthreads();
    const int w = 2 << gi;
    for (int i = tid; i < 32 * 128; i += 512) { const int tt = i >> 7, c = i & 127; float s = 0.f;
        for (int j = 0; j < w; ++j) s += uw[(15 + tt - j) * 128 + c];
        const int cnt = min(s0 + tt + 1, w);
        mx[i] = s / (float)cnt - uw[(15 + tt) * 128 + c]; }
    __syncthreads();
    const int d = tid & 127, tg = tid >> 7;
    float acc[8];
#pragma unroll
    for (int j = 0; j < 8; ++j) acc[j] = 0.f;
    for (int c = 0; c < 128; c += 4) {
        const float w0 = Wl[c * 128 + d], w1 = Wl[(c + 1) * 128 + d], w2 = Wl[(c + 2) * 128 + d], w3 = Wl[(c + 3) * 128 + d];
#pragma unroll
        for (int j = 0; j < 8; ++j) { const f32x4 mv = *(const f32x4*)(mx + (tg * 8 + j) * 128 + c); acc[j] += mv[0] * w0 + mv[1] * w1 + mv[2] * w2 + mv[3] * w3; }
    }
    const float sc = a.in[5][(size_t)L * 512 + gi * 128 + d];
    bf16_t* Y = (bf16_t*)(a.ws + WS_Y);
#pragma unroll
    for (int j = 0; j < 8; ++j) Y[(size_t)(t0 + tg * 8 + j) * 2048 + gi * 128 + d] = (bf16_t)(cvt_pk_bf16(acc[j] * sc, 0.f) & 0xffff);
    __syncthreads();
}

__device__ __forceinline__ void attn_unit(unsigned char* lds, int b, int h, int qb, const Args& a) {
    const bf16_t* SQ = (const bf16_t*)(a.ws + WS_SQ); const bf16_t* SK = (const bf16_t*)(a.ws + WS_SK); const bf16_t* VT = (const bf16_t*)(a.ws + WS_VT);
    bf16_t* Y = (bf16_t*)(a.ws + WS_Y);
    const int tid = opaque_tid(), lane = tid & 63, wid = tid >> 6, r = lane & 31, hi = lane >> 5;
    const int half = wid >> 2, wq = wid & 3, t256 = tid & 255;
    const int q0 = qb * 128, qw0 = q0 + wq * 32;
    const size_t rowbase = (size_t)b * SEQ;
    constexpr int KBY = 64 * 272, VBY = 128 * 144, BUF = KBY + VBY;
    unsigned char* hb = lds + half * BUF;
    bf16x8 qf[8];
    { const bf16_t* qp = SQ + (rowbase + qw0 + r) * 1024 + h * 128 + hi * 8;
#pragma unroll
      for (int ds = 0; ds < 8; ++ds) qf[ds] = *(const bf16x8*)(qp + ds * 16); }
    f32x16 o[4];
#pragma unroll
    for (int i = 0; i < 4; ++i)
#pragma unroll
        for (int j = 0; j < 16; ++j) o[i][j] = 0.f;
    float R = 1.f;
    const int nst = qb + 1;
    const int jstart = half == 0 ? 2 * qb + 1 : qb;
    u32x4 st[8];
#define ATT_LOAD(jj) do { _Pragma("unroll") for (int i = 0; i < 4; ++i) { const int ch = t256 + 256 * i; \
        st[i] = *(const u32x4*)(SK + (rowbase + 64 * (jj) + (ch >> 4)) * 1024 + h * 128 + (ch & 15) * 8); \
        st[4 + i] = *(const u32x4*)(VT + (((size_t)(b * 8 + h) * 128 + (ch >> 3)) << 11) + 64 * (jj) + (ch & 7) * 8); } } while (0)
#define ATT_STORE() do { _Pragma("unroll") for (int i = 0; i < 4; ++i) { const int ch = t256 + 256 * i; \
        *(u32x4*)(hb + (ch >> 4) * 272 + (ch & 15) * 16) = st[i]; *(u32x4*)(hb + KBY + (ch >> 3) * 144 + (ch & 7) * 16) = st[4 + i]; } } while (0)
    ATT_LOAD(jstart); ATT_STORE();
    __syncthreads();
    for (int sidx = 0; sidx < nst; ++sidx) {
        const int j = jstart - sidx;
        if (sidx + 1 < nst) ATT_LOAD(j - 1);
        if (64 * j <= qw0 + 31) {
            const unsigned char* Kb = hb; const unsigned char* Vb = hb + KBY;
            f32x16 p[2];
#pragma unroll
            for (int hh = 0; hh < 2; ++hh) {
#pragma unroll
                for (int jj = 0; jj < 16; ++jj) p[hh][jj] = 0.f;
#pragma unroll
                for (int ds = 0; ds < 8; ++ds) { const bf16x8 ka = *(const bf16x8*)(Kb + (32 * hh + r) * 272 + (16 * ds + 8 * hi) * 2); p[hh] = MFMA32(ka, qf[ds], p[hh]); }
            }
            const int t = qw0 + r; const int sbase = 64 * j + 4 * hi;
            float G[8];
#define ATT_ELEM(MASKED) \
            _Pragma("unroll") for (int hh = 0; hh < 2; ++hh) \
                _Pragma("unroll") for (int g = 0; g < 4; ++g) { \
                    float mm[4], bb[4]; \
                    _Pragma("unroll") for (int i = 0; i < 4; ++i) { const float uu = __builtin_amdgcn_exp2f(p[hh][4 * g + i]); \
                        const float mi = __builtin_amdgcn_rcpf(1.0f + uu); \
                        if (MASKED) { const int s = sbase + 32 * hh + 8 * g + i; const bool valid = s < t; mm[i] = valid ? mi : 1.0f; bb[i] = valid ? 1.0f - mi : 0.0f; } \
                        else { mm[i] = mi; bb[i] = 1.0f - mi; } } \
                    const float e2 = mm[3], e1 = mm[2] * e2, e0 = mm[1] * e1; \
                    G[hh * 4 + g] = mm[0] * e0; \
                    p[hh][4 * g + 0] = bb[0] * e0; p[hh][4 * g + 1] = bb[1] * e1; p[hh][4 * g + 2] = bb[2] * e2; p[hh][4 * g + 3] = bb[3]; \
                }
            if (64 * j + 63 < qw0) { ATT_ELEM(false) } else { ATT_ELEM(true) }
#undef ATT_ELEM
            float X = 1.0f;
#pragma unroll
            for (int idx = 7; idx >= 0; --idx) { const float gp = shflx(G[idx], 32, lane); const float f = X * (hi == 0 ? gp : 1.0f) * R;
                const int hh = idx >> 2, g = idx & 3;
#pragma unroll
                for (int i = 0; i < 4; ++i) p[hh][4 * g + i] *= f;
                X *= G[idx] * gp; }
            R *= X;
            bf16x8 pa[4];
#pragma unroll
            for (int kb = 0; kb < 4; ++kb) { const int hh = kb >> 1, b8 = (kb & 1) * 8;
                pa[kb] = pack8(p[hh][b8], p[hh][b8 + 1], p[hh][b8 + 2], p[hh][b8 + 3], p[hh][b8 + 4], p[hh][b8 + 5], p[hh][b8 + 6], p[hh][b8 + 7]); }
#pragma unroll
            for (int kb = 0; kb < 4; ++kb)
#pragma unroll
                for (int db = 0; db < 4; ++db) { const unsigned char* vp = Vb + (32 * db + r) * 144 + (16 * kb + 4 * hi) * 2;
                    const s16x4 lo = *(const s16x4*)vp, hi4 = *(const s16x4*)(vp + 16);
                    const bf16x8 vf = (bf16x8){lo[0], lo[1], lo[2], lo[3], hi4[0], hi4[1], hi4[2], hi4[3]};
                    o[db] = MFMA32(pa[kb], vf, o[db]); }
        }
        __syncthreads();
        if (sidx + 1 < nst) ATT_STORE();
        __syncthreads();
    }
#undef ATT_LOAD
#undef ATT_STORE
    float* OF = (float*)lds; float* RB = (float*)(lds + 128 * 132 * 4);
    if (half == 1) {
#pragma unroll
        for (int db = 0; db < 4; ++db)
#pragma unroll
            for (int reg = 0; reg < 16; ++reg) OF[(32 * wq + crow(reg, hi)) * 132 + 32 * db + r] = o[db][reg];
    } else if (hi == 0) RB[32 * wq + r] = R;
    __syncthreads();
    if (half == 0) {
#pragma unroll
        for (int reg = 0; reg < 16; ++reg) { const int q = 32 * wq + crow(reg, hi); const float rr = RB[q];
#pragma unroll
            for (int db = 0; db < 4; ++db) { const float v = o[db][reg] + rr * OF[q * 132 + 32 * db + r];
                Y[(rowbase + q0 + q) * 2048 + 512 + h * 128 + 32 * db + r] = (bf16_t)(cvt_pk_bf16(v, 0.f) & 0xffff); } }
    }
    __syncthreads();
}

__device__ __forceinline__ void hgrn_prep_unit(unsigned char* lds, int bh, int c, int L, const Args& a) {
    const float* ZF = (const float*)(a.ws + WS_ZF); const float* HQ = (const float*)(a.ws + WS_HQ); const bf16_t* HV = (const bf16_t*)(a.ws + WS_HV);
    bf16_t* HQD = (bf16_t*)(a.ws + WS_HQD); bf16_t* HKD = (bf16_t*)(a.ws + WS_HKD); bf16_t* HVT = (bf16_t*)(a.ws + WS_HVT);
    float* HDEC = (float*)(a.ws + WS_HDEC); float* HOI = (float*)(a.ws + WS_HOI);
    const int b = bh >> 2, h = bh & 3;
    const int tid = opaque_tid(), lane = tid & 63, wid = tid >> 6, r = lane & 31, hi = lane >> 5;
    float* TOT = (float*)lds; unsigned char* QD = lds + 2048; unsigned char* KT = QD + 32 * 272; unsigned char* VTl = KT + 32 * 272;
    const int k = tid & 127, tq = tid >> 7;
    float lbA, lbB, oml;
    { const int ch = h * 128 + k; const float h0 = a.in[6][ch], h1 = a.in[6][512 + ch]; const float mxv = fmaxf(h0, h1);
      const float e0 = __expf(h0 - mxv), e1 = __expf(h1 - mxv); float lb = (L == 0) ? 0.f : e1 / (e0 + e1);
      lb = fminf(fmaxf(lb, 0.f), 1.f); lbA = fmaxf(lb, 1e-20f); lbB = 1.0f - fminf(lb, 1.0f - 1e-6f); oml = 1.0f - lb; }
    const size_t row0 = (size_t)b * SEQ + c * 32;
    const size_t gbase = (row0 + tq * 8) * 512 + h * 128 + k;
    const size_t fidx = (size_t)(bh * 64 + c) * 4096 + (size_t)((((k >> 5) * 2 + (tq >> 1)) * 64 + (tq & 1) * 32 + (k & 31)) * 8);
    float kk[8], bl[8], qv[8]; float bs = 0.f;
#pragma unroll
    for (int i = 0; i < 8; ++i) { float zf = ZF[gbase + (size_t)i * 512]; qv[i] = HQ[gbase + (size_t)i * 512];
        zf = fminf(fmaxf(zf, -80.f), 80.f); const float e = __expf(-zf); const float sg = 1.0f / (1.0f + e);
        const float f = lbA + lbB * sg; bs += logf(f); bl[i] = bs; kk[i] = oml * e * sg; }
    TOT[tq * 128 + k] = bs;
    { unsigned short x[8];
#pragma unroll
      for (int i = 0; i < 8; ++i) x[i] = HV[gbase + (size_t)i * 512];
      u32x4 w; w.x = x[0] | ((unsigned)x[1] << 16); w.y = x[2] | ((unsigned)x[3] << 16); w.z = x[4] | ((unsigned)x[5] << 16); w.w = x[6] | ((unsigned)x[7] << 16);
      *(u32x4*)(VTl + k * 80 + tq * 16) = w; *(u32x4*)(HVT + fidx) = w; }
    __syncthreads();
    float off = 0.f, tot = 0.f;
#pragma unroll
    for (int q = 0; q < 4; ++q) { const float v = TOT[q * 128 + k]; tot += v; if (q < tq) off += v; }
    float kd[8];
#pragma unroll
    for (int i = 0; i < 8; ++i) { const float bt = off + bl[i]; const int t = tq * 8 + i;
        *(bf16_t*)(QD + t * 272 + k * 2) = (bf16_t)(cvt_pk_bf16(qv[i] * __expf(bt), 0.f) & 0xffff);
        *(bf16_t*)(KT + t * 272 + k * 2) = (bf16_t)(cvt_pk_bf16(kk[i] * __expf(fminf(-bt, 80.f)), 0.f) & 0xffff);
        kd[i] = kk[i] * __expf(tot - bt); }
    *(bf16x8*)(HKD + fidx) = pack8(kd[0], kd[1], kd[2], kd[3], kd[4], kd[5], kd[6], kd[7]);
    if (tq == 0) HDEC[(size_t)(bh * 64 + c) * 128 + k] = __expf(tot);
    __syncthreads();
    { const int k0 = 32 * (wid >> 1) + 16 * (wid & 1) + 4 * hi; const unsigned char* p = QD + r * 272 + k0 * 2;
      const s16x4 lo = *(const s16x4*)p, hi4 = *(const s16x4*)(p + 16);
      *(bf16x8*)(HQD + (size_t)(bh * 64 + c) * 4096 + (wid * 64 + lane) * 8) = (bf16x8){lo[0], lo[1], lo[2], lo[3], hi4[0], hi4[1], hi4[2], hi4[3]}; }
    if (wid < 4) {
        const int w = wid;
        f32x16 pt;
#pragma unroll
        for (int j = 0; j < 16; ++j) pt[j] = 0.f;
#pragma unroll
        for (int ks = 0; ks < 8; ++ks) { const bf16x8 ka = *(const bf16x8*)(KT + r * 272 + (16 * ks + 8 * hi) * 2); const bf16x8 qa = *(const bf16x8*)(QD + r * 272 + (16 * ks + 8 * hi) * 2);
            pt = MFMA32(ka, qa, pt); }
#pragma unroll
        for (int reg = 0; reg < 16; ++reg) { if (crow(reg, hi) > r) pt[reg] = 0.f; }
        const bf16x8 pa0 = pack8(pt[0], pt[1], pt[2], pt[3], pt[4], pt[5], pt[6], pt[7]);
        const bf16x8 pa1 = pack8(pt[8], pt[9], pt[10], pt[11], pt[12], pt[13], pt[14], pt[15]);
        f32x16 o;
#pragma unroll
        for (int j = 0; j < 16; ++j) o[j] = 0.f;
#pragma unroll
        for (int s16 = 0; s16 < 2; ++s16) { const unsigned char* vp = VTl + (32 * w + r) * 80 + (16 * s16 + 4 * hi) * 2;
            const s16x4 lo = *(const s16x4*)vp, hi4 = *(const s16x4*)(vp + 16);
            const bf16x8 vf = (bf16x8){lo[0], lo[1], lo[2], lo[3], hi4[0], hi4[1], hi4[2], hi4[3]};
            o = MFMA32(s16 ? pa1 : pa0, vf, o); }
#pragma unroll
        for (int reg = 0; reg < 16; ++reg) HOI[(row0 + crow(reg, hi)) * 512 + h * 128 + 32 * w + r] = o[reg];
    }
    __syncthreads();
}

__device__ __forceinline__ float dpp_sum16(float v) {
    v += __int_as_float(__builtin_amdgcn_update_dpp(0, __float_as_int(v), 0xB1, 0xF, 0xF, true));
    v += __int_as_float(__builtin_amdgcn_update_dpp(0, __float_as_int(v), 0x4E, 0xF, 0xF, true));
    v += __int_as_float(__builtin_amdgcn_update_dpp(0, __float_as_int(v), 0x141, 0xF, 0xF, true));
    v += __int_as_float(__builtin_amdgcn_update_dpp(0, __float_as_int(v), 0x140, 0xF, 0xF, true));
    return v;
}
__device__ __forceinline__ void hgrn_chain_unit(unsigned char* lds, int bh, int L, const Args& a) {
    const bf16_t* HQD = (const bf16_t*)(a.ws + WS_HQD); const bf16_t* HKD = (const bf16_t*)(a.ws + WS_HKD); const bf16_t* HVT = (const bf16_t*)(a.ws + WS_HVT);
    const float* HDEC = (const float*)(a.ws + WS_HDEC); const float* HOI = (const float*)(a.ws + WS_HOI);
    const bf16_t* OG = (const bf16_t*)(a.ws + WS_OG); bf16_t* Y = (bf16_t*)(a.ws + WS_Y);
    const int b = bh >> 2, h = bh & 3;
    const int tid = opaque_tid(), lane = tid & 63, wid = tid >> 6, r = lane & 31, hi = lane >> 5;
    constexpr int BUFB = 25088;
    float* OB = (float*)(lds + 3 * BUFB);
    f32x16 Sacc[4];
#pragma unroll
    for (int i = 0; i < 4; ++i)
#pragma unroll
        for (int j = 0; j < 16; ++j) Sacc[i][j] = 0.f;
    const size_t cb = (size_t)bh * 64;
    const size_t rowb = (size_t)b * SEQ;
    u32x4 stA[3], stB[3]; f32x4 sdA = (f32x4){0.f, 0.f, 0.f, 0.f}, sdB = sdA;
#define HG_LOAD(cc, st, sd) do { const int cc_ = (cc) < 63 ? (cc) : 63; const size_t e_ = (cb + cc_) * 4096 + (size_t)tid * 8; st[0] = *(const u32x4*)(HQD + e_); st[1] = *(const u32x4*)(HKD + e_); st[2] = *(const u32x4*)(HVT + e_); \
        sd = *(const f32x4*)(HDEC + (cb + cc_) * 128 + (tid & 31) * 4); } while (0)
#define HG_STORE(bi, st, sd) do { unsigned char* B_ = lds + (bi) * BUFB; *(u32x4*)(B_ + tid * 16) = st[0]; *(u32x4*)(B_ + 8192 + tid * 16) = st[1]; *(u32x4*)(B_ + 16384 + tid * 16) = st[2]; \
        if (tid < 32) *(f32x4*)(B_ + 24576 + tid * 16) = sd; } while (0)
    HG_LOAD(0, stA, sdA); HG_STORE(0, stA, sdA); HG_LOAD(1, stA, sdA); HG_STORE(1, stA, sdA);
    HG_LOAD(2, stB, sdB);
    const int pt_ = tid >> 4, seg = tid & 15; const int ch = h * 128 + seg * 8;
    const float* gn = a.in[7] + (size_t)L * 512 + ch; const f32x4 g0 = *(const f32x4*)gn, g1 = *(const f32x4*)(gn + 4);
    f32x4 oiA0, oiA1, oiB0, oiB1; u32x4 ogA, ogB;
#define HG_PLOAD(cc, o0, o1, og_) do { const int cp_ = (cc) < 63 ? (cc) : 63; const size_t row_ = rowb + cp_ * 32 + pt_; o0 = *(const f32x4*)(HOI + row_ * 512 + ch); o1 = *(const f32x4*)(HOI + row_ * 512 + ch + 4); og_ = *(const u32x4*)(OG + row_ * 512 + ch); } while (0)
    HG_PLOAD(0, oiA0, oiA1, ogA);
    __syncthreads();
#define HG_ITER(c, stX, sdX, stY, sdY, oiC0, oiC1, ogC, oiN0, oiN1, ogN) do { \
        const int bi = (c) % 3; \
        HG_LOAD((c) + 3, stX, sdX); \
        HG_PLOAD((c) + 1, oiN0, oiN1, ogN); \
        if (wid < 4) { \
            const int w = wid; const unsigned char* B = lds + bi * BUFB; \
            f32x16 o, o2; \
            _Pragma("unroll") for (int j = 0; j < 16; ++j) { o[j] = 0.f; o2[j] = 0.f; } \
            _Pragma("unroll") for (int kb = 0; kb < 4; ++kb) \
                _Pragma("unroll") for (int s16 = 0; s16 < 2; ++s16) { const bf16x8 aq = *(const bf16x8*)(B + ((kb * 2 + s16) * 64 + lane) * 16); const int b8 = 8 * s16; \
                    const bf16x8 bsv = pack8(Sacc[kb][b8], Sacc[kb][b8 + 1], Sacc[kb][b8 + 2], Sacc[kb][b8 + 3], Sacc[kb][b8 + 4], Sacc[kb][b8 + 5], Sacc[kb][b8 + 6], Sacc[kb][b8 + 7]); \
                    if (kb < 2) o = MFMA32(aq, bsv, o); else o2 = MFMA32(aq, bsv, o2); } \
            _Pragma("unroll") for (int kb = 0; kb < 4; ++kb) { \
                _Pragma("unroll") for (int g = 0; g < 4; ++g) { const f32x4 dd = *(const f32x4*)(B + 24576 + (32 * kb + 8 * g + 4 * hi) * 4); \
                    _Pragma("unroll") for (int i = 0; i < 4; ++i) Sacc[kb][4 * g + i] *= dd[i]; } \
                _Pragma("unroll") for (int s16 = 0; s16 < 2; ++s16) { const bf16x8 ka = *(const bf16x8*)(B + 8192 + ((kb * 2 + s16) * 64 + lane) * 16); \
                    const bf16x8 va = *(const bf16x8*)(B + 16384 + ((w * 2 + s16) * 64 + lane) * 16); \
                    Sacc[kb] = MFMA32(ka, va, Sacc[kb]); } \
            } \
            _Pragma("unroll") for (int reg = 0; reg < 16; ++reg) OB[crow(reg, hi) * 132 + 32 * w + r] = o[reg] + o2[reg]; \
        } \
        __syncthreads(); \
        { const size_t row = rowb + (c) * 32 + pt_; const float* op = OB + pt_ * 132 + seg * 8; \
          const f32x4 x0 = *(const f32x4*)op + oiC0, x1 = *(const f32x4*)(op + 4) + oiC1; \
          float ss = (x0[0] * x0[0] + x0[1] * x0[1]) + (x0[2] * x0[2] + x0[3] * x0[3]) + (x1[0] * x1[0] + x1[1] * x1[1]) + (x1[2] * x1[2] + x1[3] * x1[3]); \
          ss = dpp_sum16(ss); \
          const float rstd = 1.0f / sqrtf(ss * (1.0f / 128.0f) + EPS); \
          f32x4 y0, y1; \
          y0[0] = x0[0] * rstd * g0[0] * bflo(ogC.x); y0[1] = x0[1] * rstd * g0[1] * bfhi(ogC.x); y0[2] = x0[2] * rstd * g0[2] * bflo(ogC.y); y0[3] = x0[3] * rstd * g0[3] * bfhi(ogC.y); \
          y1[0] = x1[0] * rstd * g1[0] * bflo(ogC.z); y1[1] = x1[1] * rstd * g1[1] * bfhi(ogC.z); y1[2] = x1[2] * rstd * g1[2] * bflo(ogC.w); y1[3] = x1[3] * rstd * g1[3] * bfhi(ogC.w); \
          *(u32x4*)(Y + row * 2048 + 1536 + ch) = pack8v(y0, y1); } \
        HG_STORE(((c) + 2) % 3, stY, sdY); \
        __syncthreads(); \
    } while (0)
    for (int c = 0; c < 64; c += 2) {
        HG_ITER(c, stA, sdA, stB, sdB, oiA0, oiA1, ogA, oiB0, oiB1, ogB);
        HG_ITER(c + 1, stB, sdB, stA, sdA, oiB0, oiB1, ogB, oiA0, oiA1, ogA);
    }
#undef HG_ITER
#undef HG_PLOAD
#undef HG_LOAD
#undef HG_STORE
}

#define WQ_NEXT(cw) ({ if (threadIdx.x == 0) sh[0] = atomicAdd((cw), 1u); __syncthreads(); const int u_ = (int)sh[0]; __syncthreads(); u_; })
constexpr int INP_MAIN_COLT = 40;
__device__ __forceinline__ void mixer_phase(const Args& a, unsigned char* lds, int L, int mp, int rep) {
    unsigned* ctr = (unsigned*)(a.ws + WS_CTL) + 64 * (L * 4 + mp * 2 + rep);
    volatile unsigned* sh = (volatile unsigned*)(lds + LDS_MISC);
    if (mp == 0) {
        for (;;) { const int u = WQ_NEXT(ctr); if (u >= 2048) break;
            if (u < 1024) hgrn_prep_unit(lds, u >> 6, u & 63, L, a);
            else { const int x = u - 1024; pool_unit(lds, x >> 2, x & 3, L, a); } }
    } else {
        { const int u = WQ_NEXT(ctr); if (u < 16) { hgrn_chain_unit(lds, u, L, a); if (CHAIN_TWICE) { __syncthreads(); hgrn_chain_unit(lds, u, L, a); } } }
        for (;;) { const int x = WQ_NEXT(ctr + 8); if (x >= 32 * (46 - INP_MAIN_COLT)) break;
            pg8::Gemm g{(const bf16_t*)(a.ws + WS_H), (const bf16_t*)(a.ws + WS_W0 + (size_t)L * WL_SIZE + WL_IN), TT, INC, DM, DM, 1, 0, 0, 0, DM / 64, 0, 0};
            pg8::OneUnit S1{x / (46 - INP_MAIN_COLT), INP_MAIN_COLT + x % (46 - INP_MAIN_COLT)};
            EpiIn E{a.ws, 3 * L * TT};
            pg8::gemm_phase((PG8_LAS unsigned char*)lds, g, S1, E); }
        for (;;) { const int x = WQ_NEXT(ctr + 16); if (x >= 512) break;
            attn_unit(lds, (x & 31) >> 3, x & 7, 15 - (x >> 5), a); }
        for (;;) { const int x = WQ_NEXT(ctr + 24); if (x >= 256) break;
            pg8::Gemm g{(const bf16_t*)(a.ws + WS_PB) + (size_t)L * TT * PLE, (const bf16_t*)(a.ws + WS_W0 + (size_t)L * WL_SIZE + WL_PP), TT, DM, PLE, PLE, 1, 0, 0, 0, PLE / 64, 0, 0};
            pg8::OneUnit S1{x >> 3, x & 7};
            EpiBf16 E{a.ws};
            pg8::gemm_phase((PG8_LAS unsigned char*)lds, g, S1, E); }
    }
}

#define LAS __attribute__((address_space(3)))
#define XB_TMO      128
#define XB_XCNT(j)  (256  + 64 * (j))
#define XB_XSUB(j)  (1280 + 64 * (j))
#define XB_XGEN(j)  (2304 + 64 * (j))
#define XB_TOP      3328
#define XB_TOPGEN   3392
#define XCD_BAR_WORDS 3456
#define XB_SPIN_CAP (1u << 20)
__device__ __forceinline__ unsigned xb_ld(unsigned* p)              { return __hip_atomic_load(p, __ATOMIC_RELAXED, __HIP_MEMORY_SCOPE_AGENT); }
__device__ __forceinline__ unsigned xb_add(unsigned* p, unsigned v) { return __hip_atomic_fetch_add(p, v, __ATOMIC_RELAXED, __HIP_MEMORY_SCOPE_AGENT); }
__device__ __forceinline__ unsigned xb_xcc_id() { return (unsigned)__builtin_amdgcn_s_getreg((3 << 11) | 20) & 0xFu; }
#define XB_SPIN(cond, bar) do { unsigned _sp = 0; while (cond) { __builtin_amdgcn_s_sleep(1); \
    if ((++_sp & 255u) == 0u) { if (xb_ld(&(bar)[XB_TMO])) break; if (_sp > XB_SPIN_CAP) { atomicAdd(&(bar)[XB_TMO], 1u); break; } } } } while (0)
struct XcdBarrier { unsigned* bar; unsigned x; volatile LAS unsigned* st; };
__device__ __forceinline__ XcdBarrier xcd_barrier_post(unsigned* bar, volatile LAS unsigned* st) {
    XcdBarrier b; b.bar = bar; b.x = xb_xcc_id(); b.st = st;
    if (threadIdx.x == 0) (void)xb_add(&bar[XB_XCNT(b.x)], 1u);
    return b;
}
__device__ __forceinline__ void xcd_barrier_complete(unsigned* bar, unsigned x, unsigned& nloc, unsigned& nx) {
    const unsigned G = gridDim.x * gridDim.y * gridDim.z;
    unsigned sum, cnt, mine, sp = 0u;
    for (;;) {
        sum = 0u; cnt = 0u; mine = 0u;
#pragma nounroll
        for (unsigned j = 0; j < 16; ++j) { const unsigned c = xb_ld(&bar[XB_XCNT(j)]); sum += c; cnt += (c > 0u) ? 1u : 0u; mine = (j == x) ? c : mine; }
        if (sum == G) break;
        __builtin_amdgcn_s_sleep(1);
        if ((++sp & 255u) == 0u) { if (xb_ld(&bar[XB_TMO])) break; if (sp > XB_SPIN_CAP) { atomicAdd(&bar[XB_TMO], 1u); break; } }
    }
    nloc = mine > 0u ? mine : 1u; nx = cnt > 0u ? cnt : 1u;
}
__device__ __forceinline__ void xcd_barrier(const XcdBarrier& b) {
    asm volatile("s_waitcnt vmcnt(0)" ::: "memory");
    __syncthreads();
    if (threadIdx.x == 0) {
        unsigned* bar = b.bar; asm volatile("" : "+s"(bar));
        __builtin_amdgcn_s_waitcnt(0);
        unsigned nloc = b.st[0], nx = b.st[1];
        if (nloc == 0u) { xcd_barrier_complete(bar, b.x, nloc, nx); b.st[0] = nloc; b.st[1] = nx; }
        const unsigned old = xb_add(&bar[XB_XSUB(b.x)], 1u);
        const unsigned gen = old / nloc;
        if (old + 1u == (gen + 1u) * nloc) {
            __builtin_amdgcn_fence(__ATOMIC_RELEASE, "agent");
            asm volatile("s_waitcnt vmcnt(0)" ::: "memory");
            const unsigned og = xb_add(&bar[XB_TOP], 1u);
            const unsigned tg = og / nx;
            if (og + 1u == (tg + 1u) * nx) xb_add(&bar[XB_TOPGEN], 1u);
            else XB_SPIN(xb_ld(&bar[XB_TOPGEN]) == tg, bar);
            __builtin_amdgcn_fence(__ATOMIC_ACQUIRE, "agent");
            xb_add(&bar[XB_XGEN(b.x)], 1u);
            asm volatile("s_waitcnt vmcnt(0)" ::: "memory");
        } else {
            XB_SPIN(xb_ld(&bar[XB_XGEN(b.x)]) == gen, bar);
            __builtin_amdgcn_fence(__ATOMIC_ACQUIRE, "agent");
            asm volatile("s_waitcnt vmcnt(0)" ::: "memory");
        }
    }
    __syncthreads();
}

typedef const Args __attribute__((address_space(4)))* KArgP;
#define LOAD_ARGS KArgP ap = (KArgP)__builtin_amdgcn_kernarg_segment_ptr(); asm volatile("" : "+s"(ap)); Args A; \
    _Pragma("unroll") for (int i_ = 0; i_ < 19; ++i_) A.in[i_] = ap->in[i_]; A.out = ap->out; A.ws = ap->ws; A.ph_lo = 0; A.ph_hi = 0;
__global__ void __launch_bounds__(512, 2) mega(Args a) {
    extern __shared__ __attribute__((aligned(16))) unsigned char lds[];
    cg::grid_group grid = cg::this_grid();
    PG8_LAS unsigned char* lds3 = (PG8_LAS unsigned char*)lds;
    const int G = gridDim.x, bx = blockIdx.x;
    if (threadIdx.x == 0) { ((volatile LAS unsigned*)((LAS unsigned char*)lds + LDS_MISC))[8] = 0u; ((volatile LAS unsigned*)((LAS unsigned char*)lds + LDS_MISC))[9] = 0u; }
    __syncthreads();
    XcdBarrier xbar = xcd_barrier_post((unsigned*)(a.ws + WS_CTL) + 1024, (volatile LAS unsigned*)((LAS unsigned char*)lds + LDS_MISC) + 8);
    constexpr int ph_hi_ = NPHASE;
#pragma nounroll
    for (int ph = 0; ph < ph_hi_; ++ph) {
      const int nrep = 1 + ((ph == 0 ? (REP_MASK >> 15) : (ph == NPHASE - 1 ? 0 : (REP_MASK >> ((ph - 1) % PPL)))) & 1);
      for (int rep = 0; rep < nrep; ++rep) {
        if (ph == 0) { if (PHMASK & 0x8000) { LOAD_ARGS prologue_phase(A, lds); } }
        else if (ph == NPHASE - 1) { if (PHMASK & 0x4000) { LOAD_ARGS final_norm_rows((const bf16_t*)(A.ws + WS_H), (const float*)(A.ws + WS_X) + (size_t)(3 * NLAYER) * TT * 8, A.in[18], A.out); } }
        else {
            const int L = (ph - 1) / PPL, s = (ph - 1) % PPL;
            if (s == 0) { if (PHMASK & (1 << 0)) {
                LOAD_ARGS unsigned char* wl = A.ws + WS_W0 + (size_t)L * WL_SIZE;
                pg8::Gemm g{(const bf16_t*)(A.ws + WS_H), (const bf16_t*)(wl + WL_IN), TT, INC, DM, DM, 1, 0, 0, 0, DM / 64, 0, 0};
                pg8::StaticOrder S; S.init(TT, INP_MAIN_COLT * 256, G, bx, 1);
                EpiIn E{A.ws, 3 * L * TT};
                pg8::gemm_phase(lds3, g, S, E);
            }} else if (s == 1) { if (PHMASK & (1 << 1)) {
                LOAD_ARGS mixer_phase(A, lds, L, 0, rep);
            }} else if (s == 2) { if (PHMASK & (1 << 2)) {
                LOAD_ARGS mixer_phase(A, lds, L, 1, rep);
            }} else if (s == 3) { if (PHMASK & (1 << 3)) {
                LOAD_ARGS unsigned char* wl = A.ws + WS_W0 + (size_t)L * WL_SIZE;
                pg8::Gemm g{(const bf16_t*)(A.ws + WS_Y), (const bf16_t*)(wl + WL_BR), TT, DM, DM, DM, 3, 0, 512, 1536, 8, 16, 8};
                pg8::StaticOrder S; S.init(TT, DM, G, bx, 3);
                EpiBranch E{A.ws};
                pg8::gemm_phase(lds3, g, S, E);
            }} else if (s == 4) { if (PHMASK & (1 << 4)) {
                LOAD_ARGS unsigned char* wl = A.ws + WS_W0 + (size_t)L * WL_SIZE;
                pg8::Gemm g{(const bf16_t*)(A.ws + WS_MIX), (const bf16_t*)(wl + WL_OUT), TT, DM, DM, DM, 1, 0, 0, 0, DM / 64, 0, 0};
                pg8::StaticOrder S; S.init(TT, DM, G, bx, 1);
                EpiResid E{A.ws, 0, 0, (3 * L + 1) * TT};
                pg8::gemm_phase(lds3, g, S, E);
            }} else if (s == 5) { if (PHMASK & (1 << 5)) {
                LOAD_ARGS unsigned char* wl = A.ws + WS_W0 + (size_t)L * WL_SIZE;
                pg8::Gemm g{(const bf16_t*)(A.ws + WS_H), (const bf16_t*)(wl + WL_GU), TT, 2 * DFF, DM, DM, 1, 0, 0, 0, DM / 64, 0, 0};
                pg8::StaticOrder S; S.init(TT, 2 * DFF, G, bx, 1);
                EpiSwiglu E{A.ws, (3 * L + 1) * TT};
                pg8::gemm_phase(lds3, g, S, E);
            }} else if (s == 6) { if (PHMASK & (1 << 6)) {
                LOAD_ARGS unsigned char* wl = A.ws + WS_W0 + (size_t)L * WL_SIZE;
                pg8::Gemm g{(const bf16_t*)(A.ws + WS_ACT), (const bf16_t*)(wl + WL_DN), TT, DM, DFF, DFF, 1, 0, 0, 0, DFF / 64, 0, 0};
                pg8::StaticOrder S; S.init(TT, DM, G, bx, 1);
                EpiResid E{A.ws, 0, (int)(WS_HB - WS_H), (3 * L + 2) * TT};
                pg8::gemm_phase(lds3, g, S, E);
            }} else { if (PHMASK & (1 << 7)) {
                LOAD_ARGS unsigned char* wl = A.ws + WS_W0 + (size_t)L * WL_SIZE;
                pg8::Gemm g{(const bf16_t*)(A.ws + WS_HB), (const bf16_t*)(wl + WL_PG), TT, DM, DM, DM, 1, 0, 0, 0, DM / 64, 0, 0};
                pg8::StaticOrder S; S.init(TT, DM, G, bx, 1);
                EpiPle E{A.ws, (3 * L + 2) * TT};
                pg8::gemm_phase(lds3, g, S, E);
            }}
        }
        if (ph + 1 < ph_hi_ || rep + 1 < nrep) { if (ph == 0) grid.sync(); else xcd_barrier(xbar); }
      }
    }
    for (int i = 0; i < EXTRA_SYNCS; ++i) xcd_barrier(xbar);
}

extern "C" void kernel_launch(void* const* d_in, const int* in_sizes, int n_in, void* d_out, int out_size, void* d_ws, size_t ws_size, hipStream_t stream) {
    static int grid = 0;
    if (grid == 0) {
        if (n_in != 19 || out_size != TT * DM || ws_size < WS_END) { fprintf(stderr, "kernel_launch: unexpected problem (n_in %d out %d ws %zu need %zu)\n", n_in, out_size, ws_size, (size_t)WS_END); grid = -1; return; }
        int dev = 0, cus = 0, per_cu = 0;
        hipGetDevice(&dev); hipDeviceGetAttribute(&cus, hipDeviceAttributeMultiprocessorCount, dev);
        if (hipFuncSetAttribute((const void*)mega, hipFuncAttributeMaxDynamicSharedMemorySize, LDS_BYTES) != hipSuccess) { fprintf(stderr, "kernel_launch: hipFuncSetAttribute failed\n"); grid = -1; return; }
        if (hipOccupancyMaxActiveBlocksPerMultiprocessor(&per_cu, (const void*)mega, 512, LDS_BYTES) != hipSuccess || per_cu < 1) { fprintf(stderr, "kernel_launch: occupancy query gave %d\n", per_cu); per_cu = 1; }
        (void)hipGetLastError();
        grid = cus * per_cu;
        fprintf(stderr, "kernel_launch: grid %d (cus %d x %d)\n", grid, cus, per_cu);
    }
    if (grid < 0) return;
    (void)hipMemsetAsync((char*)d_ws + WS_CTL, 0, CTL_ZERO, stream);
    Args a{};
    for (int i = 0; i < 19; ++i) a.in[i] = (const float*)d_in[i];
    a.out = (float*)d_out; a.ws = (unsigned char*)d_ws;
#if MK_MULTI
    for (int ph = 0; ph < NPHASE; ++ph) { a.ph_lo = ph; a.ph_hi = ph + 1; hipLaunchKernelGGL(mega, dim3(grid), dim3(512), LDS_BYTES, stream, a); }
#else
    a.ph_lo = 0; a.ph_hi = NPHASE;
    void* args[] = {&a};
    hipError_t e = hipLaunchCooperativeKernel((const void*)mega, dim3(grid), dim3(512), args, LDS_BYTES, stream);
    if (e != hipSuccess) fprintf(stderr, "kernel_launch: cooperative launch failed: %s (grid %d)\n", hipGetErrorString(e), grid);
#endif
}
```

```cpp
#include <hip/hip_runtime.h>
#include <hip/hip_cooperative_groups.h>
#include <cstdio>
#include <cstdint>
namespace cg = cooperative_groups;

#ifndef PHMASK
#define PHMASK 0xFFFF
#endif
#ifndef REP_MASK
#define REP_MASK 0
#endif
#ifndef EXTRA_SYNCS
#define EXTRA_SYNCS 0
#endif
#ifndef CHAIN_TWICE
#define CHAIN_TWICE 0
#endif
#ifndef MK_MULTI
#define MK_MULTI 0
#endif

typedef unsigned short bf16_t;
typedef short bf16x8 __attribute__((ext_vector_type(8)));
typedef short s16x4 __attribute__((ext_vector_type(4)));
typedef float f32x4 __attribute__((ext_vector_type(4)));
typedef float f32x16 __attribute__((ext_vector_type(16)));
typedef unsigned u32x4 __attribute__((ext_vector_type(4)));
typedef unsigned u32x2 __attribute__((ext_vector_type(2)));

constexpr int TT = 8192, DM = 2048, SEQ = 2048, INC = 11776, DFF = 5632, PLE = 256, NLAYER = 2;
constexpr float EPS = 1e-6f;

typedef float f32x2_t __attribute__((ext_vector_type(2))); typedef __bf16 bf16x2_t __attribute__((ext_vector_type(2)));
__device__ __forceinline__ unsigned cvt_pk_bf16(float lo, float hi) { const f32x2_t v = {lo, hi}; const bf16x2_t b = __builtin_convertvector(v, bf16x2_t); return __builtin_bit_cast(unsigned, b); }
__device__ __forceinline__ float bf2f(unsigned short b) { return __uint_as_float(((unsigned)b) << 16); }
__device__ __forceinline__ float bflo(unsigned w) { return __uint_as_float(w << 16); }
__device__ __forceinline__ float bfhi(unsigned w) { return __uint_as_float(w & 0xffff0000u); }
__device__ __forceinline__ float sigmoidf_(float x) { return __builtin_amdgcn_rcpf(1.0f + __builtin_amdgcn_exp2f(x * -1.4426950408889634f)); }
__device__ __forceinline__ bf16x8 pack8(float a0, float a1, float a2, float a3, float a4, float a5, float a6, float a7) {
    u32x4 w; w.x = cvt_pk_bf16(a0, a1); w.y = cvt_pk_bf16(a2, a3); w.z = cvt_pk_bf16(a4, a5); w.w = cvt_pk_bf16(a6, a7);
    return __builtin_bit_cast(bf16x8, w);
}
__device__ __forceinline__ int crow(int r, int hi) { return (r & 3) + 8 * (r >> 2) + 4 * hi; }
__device__ __forceinline__ int opaque_tid() { int t = threadIdx.x; asm volatile("" : "+v"(t)); return t; }
__device__ __forceinline__ float shflx(float v, int m, int lane) { return __int_as_float(__builtin_amdgcn_ds_bpermute((lane ^ m) << 2, __float_as_int(v))); }
#define MFMA32(a, b, c) __builtin_amdgcn_mfma_f32_32x32x16_bf16((a), (b), (c), 0, 0, 0)

namespace pg8 {
#define PG8_LAS __attribute__((address_space(3)))
constexpr int BM = 256, BK = 64, HALF = 128, HTB = HALF * BK * 2, STAGE_BYTES = 8 * HTB, NXCD = 8, WGM = 8;
__host__ __device__ __forceinline__ int lds_byte(int r, int c) { const int st = (r >> 4) * 2 + (c >> 5), rr = r & 15, cc = c & 31, ob = rr * 64 + cc * 2; return st * 1024 + (ob ^ (((ob >> 9) & 1) << 5)); }
__host__ __device__ __forceinline__ void stage_rc(int b, int& R, int& C) { const int st = b / 1024, sb = b % 1024, swz = sb ^ (((sb >> 9) & 1) << 5); R = (st >> 1) * 16 + swz / 64; C = (st & 1) * 32 + (swz % 64) / 2; }
__host__ __device__ __forceinline__ int perm32(int rho) { const int n = rho >> 4, i = rho & 15; return 8 * (i >> 2) + 4 * n + (i & 3); }

struct Unit { int pm, pn, kind; };
struct Gemm { const bf16_t* A; const bf16_t* Bt; int M, N, lda, ldb; int nseg; int kofs0, kofs1, kofs2; int nt0, nt1, nt2; };

struct StaticOrder {
    int nM, nN, nwg, G, c, nseg;
    __device__ void init(int M, int N, int G_, int c_, int nseg_) { nM = M / BM; nN = N / BM; nwg = nM * nN; G = G_; c = c_; nseg = nseg_; }
    __device__ bool next(int i, Unit& u) const {
        int j = i, kd = 0; if (nseg == 3) { j = i / 3; kd = i - 3 * j; }
        u.kind = kd;
        const long L = (long)j * G + c; if (L >= nwg) return false;
        int wgid = (int)L; { const int q = nwg / NXCD, r = nwg % NXCD, xcd = wgid % NXCD, off = wgid / NXCD; wgid = (xcd < r ? xcd * (q + 1) : r * (q + 1) + (xcd - r) * q) + off; }
        const int nig = WGM * nN, gid = wgid / nig, fm = gid * WGM, gsz = (nM - fm) < WGM ? (nM - fm) : WGM;
        u.pm = fm + ((wgid % nig) % gsz); u.pn = (wgid % nig) / gsz; return true;
    }
};

struct OneUnit { int pm, pn; __device__ bool next(int i, Unit& u) const { u.pm = pm; u.pn = pn; u.kind = 0; return i == 0; } };
template <class Epi, class Sched>
__device__ __forceinline__ void gemm_phase(PG8_LAS unsigned char* lds, const Gemm g, const Sched& S, const Epi& E) {
    const int tid = opaque_tid(), wid = __builtin_amdgcn_readfirstlane(tid >> 6), lane = tid & 63, wr = wid >> 2, wc = wid & 3, fr = lane & 15, fq = lane >> 4;
    unsigned voffA, voffB;
    { int R, C; stage_rc(tid * 16, R, C); const int Rb = (R & ~31) + perm32(R & 31);
      voffA = (unsigned)(R * g.lda + C) * 2u; voffB = (unsigned)(Rb * g.ldb + C) * 2u; }
    const size_t qstepoffA = (size_t)64 * g.lda * 2, qstepoffB = (size_t)64 * g.ldb * 2;
    const size_t kstep = (size_t)(BK * 2);
    const size_t hstepA = (size_t)HALF * g.lda * 2, hstepB = (size_t)HALF * g.ldb * 2;
    const size_t tstepA = 2 * hstepA, tstepB = 2 * hstepB;
    const unsigned ldsw = (unsigned)wid * 1024u;
    const int aoff = lds_byte(wr * 64 + fr, fq * 8), boff = lds_byte(wc * 32 + fr, fq * 8);
#define PG8_SA(b, h) (((b) * 2 + (h)) * HTB)
#define PG8_SB(b, h) ((4 + (b) * 2 + (h)) * HTB)
#define PG8_STAGE(bufoff, gbase, voff) do { _Pragma("unroll") for (int _i = 0; _i < 2; ++_i) \
        __builtin_amdgcn_global_load_lds((const unsigned*)((const char*)(gbase) + (size_t)_i * qstep##voff + v##voff), (PG8_LAS unsigned*)(lds + (bufoff) + ldsw + _i * 8192), 16, 0, 0); } while (0)
#define PG8_LDA(dst, b, h) do { _Pragma("unroll") for (int m = 0; m < 4; ++m) _Pragma("unroll") for (int k = 0; k < 2; ++k) dst[m][k] = *(const PG8_LAS bf16x8*)(lds + PG8_SA(b, h) + aoff + m * 2048 + k * 1024); } while (0)
#define PG8_LDB(dst, b, h) do { _Pragma("unroll") for (int n = 0; n < 2; ++n) _Pragma("unroll") for (int k = 0; k < 2; ++k) dst[n][k] = *(const PG8_LAS bf16x8*)(lds + PG8_SB(b, h) + boff + n * 2048 + k * 1024); } while (0)
#define PG8_MMA(ai, bj, At, Bt) do { __builtin_amdgcn_s_setprio(1); _Pragma("unroll") for (int m = 0; m < 4; ++m) _Pragma("unroll") for (int n = 0; n < 2; ++n) _Pragma("unroll") for (int k = 0; k < 2; ++k) \
        acc[ai][bj][m][n] = __builtin_amdgcn_mfma_f32_16x16x32_bf16(Bt[n][k], At[m][k], acc[ai][bj][m][n], 0, 0, 0); __builtin_amdgcn_s_setprio(0); } while (0)
#define PG8_WAIT_V(n) asm volatile("s_waitcnt vmcnt(" #n ")" ::: "memory")
#define PG8_WAIT_L(n) asm volatile("s_waitcnt lgkmcnt(" #n ")" ::: "memory")
#define PG8_BAR __builtin_amdgcn_s_barrier()
#define PG8_SCHED __builtin_amdgcn_sched_barrier(0)
#define PG8_KOFS(u) ((u).kind == 0 ? g.kofs0 : ((u).kind == 1 ? g.kofs1 : g.kofs2))
#define PG8_NT(u) ((u).kind == 0 ? g.nt0 : ((u).kind == 1 ? g.nt1 : g.nt2))
    Unit cur, nxt; int ui = 0;
    if (!S.next(0, cur)) return;
    f32x4 acc[2][2][4][2];
#pragma unroll
    for (int a = 0; a < 2; ++a)
#pragma unroll
        for (int b = 0; b < 2; ++b)
#pragma unroll
            for (int m = 0; m < 4; ++m)
#pragma unroll
                for (int n = 0; n < 2; ++n) acc[a][b][m][n] = (f32x4){0.f, 0.f, 0.f, 0.f};
    bf16x8 At[4][2], B0[2][2], B1[2][2];
    const char* cA = (const char*)g.A + (size_t)cur.pm * tstepA + (size_t)PG8_KOFS(cur) * 2; const char* cB = (const char*)g.Bt + (size_t)cur.pn * tstepB + (size_t)PG8_KOFS(cur) * 2;
    PG8_STAGE(PG8_SB(0, 0), cB, offB); PG8_STAGE(PG8_SB(0, 1), cB + hstepB, offB); PG8_STAGE(PG8_SA(0, 0), cA, offA); PG8_STAGE(PG8_SA(0, 1), cA + hstepA, offA);
    if (wr == 1) PG8_BAR;
    PG8_WAIT_V(2); PG8_BAR;
    PG8_STAGE(PG8_SB(1, 0), cB + kstep, offB); PG8_STAGE(PG8_SA(1, 0), cA + kstep, offA); PG8_STAGE(PG8_SB(1, 1), cB + hstepB + kstep, offB);
    PG8_WAIT_V(6); PG8_BAR;
    for (;;) {
        const bool has_next = S.next(ui + 1, nxt);
        const char* nA = has_next ? (const char*)g.A + (size_t)nxt.pm * tstepA + (size_t)PG8_KOFS(nxt) * 2 : cA;
        const char* nB = has_next ? (const char*)g.Bt + (size_t)nxt.pn * tstepB + (size_t)PG8_KOFS(nxt) * 2 : cB;
        const int nt = PG8_NT(cur);
        for (int t = 0; t < nt; t += 2) {
            const bool last = (t == nt - 2);
            const char* a1 = cA + (size_t)(t + 1) * kstep;
            const char* a2 = last ? nA : cA + (size_t)(t + 2) * kstep; const char* b2 = last ? nB : cB + (size_t)(t + 2) * kstep;
            const char* a3 = a2 + kstep; const char* b3 = b2 + kstep;
            PG8_LDB(B0, 0, 0); PG8_LDB(B1, 0, 1); PG8_SCHED; PG8_LDA(At, 0, 0); PG8_STAGE(PG8_SA(1, 1), a1 + hstepA, offA);
            PG8_WAIT_V(8); PG8_WAIT_L(0); PG8_BAR; PG8_MMA(0, 0, At, B0); PG8_MMA(0, 1, At, B1); PG8_BAR; PG8_SCHED;
            PG8_LDA(At, 0, 1); PG8_STAGE(PG8_SB(0, 0), b2, offB); PG8_STAGE(PG8_SB(0, 1), b2 + hstepB, offB); PG8_STAGE(PG8_SA(0, 0), a2, offA);
            PG8_WAIT_V(8); PG8_WAIT_L(0); PG8_BAR; PG8_MMA(1, 0, At, B0); PG8_MMA(1, 1, At, B1); PG8_BAR; PG8_SCHED;
            PG8_LDB(B0, 1, 0); PG8_LDB(B1, 1, 1); PG8_SCHED; PG8_LDA(At, 1, 0); PG8_STAGE(PG8_SA(0, 1), a2 + hstepA, offA);
            PG8_WAIT_V(8); PG8_WAIT_L(0); PG8_BAR; PG8_MMA(0, 0, At, B0); PG8_MMA(0, 1, At, B1); PG8_BAR; PG8_SCHED;
            PG8_LDA(At, 1, 1); PG8_STAGE(PG8_SB(1, 0), b3, offB); PG8_STAGE(PG8_SB(1, 1), b3 + hstepB, offB); PG8_STAGE(PG8_SA(1, 0), a3, offA);
            PG8_WAIT_V(8); PG8_WAIT_L(0); PG8_BAR; PG8_MMA(1, 0, At, B0); PG8_MMA(1, 1, At, B1); PG8_BAR; PG8_SCHED;
        }
        if (wr == 0) PG8_BAR;
        const bool keep = E(acc, cur, wr, wc, fr, fq);
        if (!has_next) break;
        if (!keep) {
#pragma unroll
        for (int a = 0; a < 2; ++a)
#pragma unroll
            for (int b = 0; b < 2; ++b)
#pragma unroll
                for (int m = 0; m < 4; ++m)
#pragma unroll
                    for (int n = 0; n < 2; ++n) acc[a][b][m][n] = (f32x4){0.f, 0.f, 0.f, 0.f};
        }
        cur = nxt; cA = nA; cB = nB; ++ui;
        if (wr == 1) PG8_BAR;
    }
    PG8_WAIT_V(0);
    PG8_BAR;
#undef PG8_SA
#undef PG8_SB
#undef PG8_STAGE
#undef PG8_LDA
#undef PG8_LDB
#undef PG8_MMA
#undef PG8_WAIT_V
#undef PG8_WAIT_L
#undef PG8_BAR
#undef PG8_SCHED
#undef PG8_KOFS
#undef PG8_NT
}
}

constexpr size_t MiB = 1u << 20;
constexpr size_t WS_CTL = 0;
constexpr size_t WS_W0 = 1 * MiB;
constexpr size_t WL_IN = 0, WL_BR = 46 * MiB, WL_OUT = 54 * MiB, WL_GU = 62 * MiB, WL_DN = 106 * MiB, WL_PG = 128 * MiB, WL_PP = 136 * MiB, WL_SIZE = 137 * MiB;
constexpr size_t WS_H = WS_W0 + 2 * WL_SIZE;
constexpr size_t WS_X = WS_H + 32 * MiB;
constexpr size_t WS_U = WS_X + 64 * MiB;
constexpr size_t WS_SQ = WS_U + 16 * MiB;
constexpr size_t WS_SK = WS_SQ + 16 * MiB;
constexpr size_t WS_VT = WS_SK + 16 * MiB;
constexpr size_t WS_ZF = WS_VT + 16 * MiB;
constexpr size_t WS_HV = WS_ZF + 16 * MiB;
constexpr size_t WS_HQ = WS_HV + 8 * MiB;
constexpr size_t WS_OG = WS_HQ + 16 * MiB;
constexpr size_t WS_GT = WS_OG + 8 * MiB;
constexpr size_t WS_ACT = WS_GT;
constexpr size_t WS_Y = WS_GT + 96 * MiB;
constexpr size_t WS_MIX = WS_Y + 32 * MiB;
constexpr size_t WS_PB = WS_MIX + 32 * MiB;
constexpr size_t WS_HVT = WS_PB + 8 * MiB;
constexpr size_t WS_HDEC = WS_HVT + 8 * MiB;
constexpr size_t WS_HB = WS_HDEC + 1 * MiB;
constexpr size_t WS_PPB = WS_HB + 32 * MiB;
constexpr size_t WS_END = WS_PPB + 32 * MiB;
constexpr size_t WS_HOI = WS_MIX;
constexpr size_t WS_HQD = WS_MIX + 16 * MiB;
constexpr size_t WS_HKD = WS_MIX + 24 * MiB;
constexpr size_t CTL_SS = 65536;
constexpr size_t CTL_ZERO = CTL_SS + 7 * TT * 4;

constexpr int LDS_PSUM_OFF = 132096;
typedef f32x4 AccT[2][2][4][2];
#define EPI_LOOP_BEGIN  const int row0_ = u.pm * 256 + wr * 64 + fr; \
    _Pragma("unroll") for (int ai = 0; ai < 2; ++ai) _Pragma("unroll") for (int m = 0; m < 4; ++m) { const int row = row0_ + ai * 128 + m * 16; \
    _Pragma("unroll") for (int bj = 0; bj < 2; ++bj) { const int col = u.pn * 256 + bj * 128 + wc * 32 + 8 * fq; f32x4 v0 = acc[ai][bj][m][0], v1 = acc[ai][bj][m][1];
#define EPI_LOOP_END }}
__device__ __forceinline__ float rstd_of(float ss) { return __builtin_amdgcn_rsqf(ss * (1.0f / DM) + EPS); }
__device__ __forceinline__ float rstd_row(const float* SSP, int row) { const f32x4 a = *(const f32x4*)(SSP + (size_t)row * 8), b = *(const f32x4*)(SSP + (size_t)row * 8 + 4);
    return rstd_of(((a[0] + a[1]) + (a[2] + a[3])) + ((b[0] + b[1]) + (b[2] + b[3]))); }
__device__ __forceinline__ void ps_write(int rit, int wc, float sq) {
    extern __shared__ __attribute__((aligned(16))) unsigned char lds_e_[];
    ((float*)(lds_e_ + LDS_PSUM_OFF))[rit * 4 + wc] = sq;
}
__device__ __forceinline__ void ps_finish(float* SSP, const pg8::Unit& u, int wr, int wc, int fr, int fq) {
    extern __shared__ __attribute__((aligned(16))) unsigned char lds_e_[];
    const float* PS = (const float*)(lds_e_ + LDS_PSUM_OFF);
    asm volatile("s_waitcnt lgkmcnt(0)" ::: "memory"); __builtin_amdgcn_s_barrier(); asm volatile("" ::: "memory");
    const int t_ = (wr * 4 + wc) * 64 + fq * 16 + fr;
    if (t_ < 256) { const f32x4 p = *(const f32x4*)(PS + t_ * 4); SSP[(size_t)(u.pm * 256 + t_) * 8 + u.pn] = (p[0] + p[1]) + (p[2] + p[3]); }
}
#define EPI_LOOP_BEGIN_R(SSP)  const int row0_ = u.pm * 256 + wr * 64 + fr; \
    _Pragma("unroll") for (int ai = 0; ai < 2; ++ai) _Pragma("unroll") for (int m = 0; m < 4; ++m) { const int row = row0_ + ai * 128 + m * 16; const float rs_ = rstd_row((SSP), row); \
    _Pragma("unroll") for (int bj = 0; bj < 2; ++bj) { const int col = u.pn * 256 + bj * 128 + wc * 32 + 8 * fq; f32x4 v0 = acc[ai][bj][m][0] * rs_, v1 = acc[ai][bj][m][1] * rs_;

__device__ __forceinline__ u32x4 pack8v(f32x4 v0, f32x4 v1) { u32x4 w; w.x = cvt_pk_bf16(v0[0], v0[1]); w.y = cvt_pk_bf16(v0[2], v0[3]); w.z = cvt_pk_bf16(v1[0], v1[1]); w.w = cvt_pk_bf16(v1[2], v1[3]); return w; }

struct EpiIn {
    unsigned char* ws; int ssofs;
    __device__ __forceinline__ bool operator()(AccT& acc, const pg8::Unit& u, int wr, int wc, int fr, int fq) const {
        float* U = (float*)(ws + WS_U); bf16_t* SQ = (bf16_t*)(ws + WS_SQ); bf16_t* SK = (bf16_t*)(ws + WS_SK); bf16_t* VT = (bf16_t*)(ws + WS_VT); float* ZF = (float*)(ws + WS_ZF);
        bf16_t* HV = (bf16_t*)(ws + WS_HV); float* HQ = (float*)(ws + WS_HQ); bf16_t* OG = (bf16_t*)(ws + WS_OG); bf16_t* GT = (bf16_t*)(ws + WS_GT);
        const float* SS = (const float*)(ws + WS_X) + (size_t)ssofs * 8; const float qscale = 0.08838834764831845f * 1.4426950408889634f;
        const int colt = u.pn * 256;
        if (colt < 512) {
            EPI_LOOP_BEGIN_R(SS) float* p = U + (size_t)row * 512 + col; *(f32x4*)p = v0; *(f32x4*)(p + 4) = v1; EPI_LOOP_END
        } else if (colt < 1536) {
            const float s = qscale;
            EPI_LOOP_BEGIN_R(SS) *(u32x4*)(SQ + (size_t)row * 1024 + (col - 512)) = pack8v(v0 * s, v1 * s); EPI_LOOP_END
        } else if (colt < 2560) {
            EPI_LOOP_BEGIN_R(SS) *(u32x4*)(SK + (size_t)row * 1024 + (col - 1536)) = pack8v(v0, v1); EPI_LOOP_END
        } else if (colt < 3584) {
            EPI_LOOP_BEGIN_R(SS) const int cc = col - 2560, hh = cc >> 7, d = cc & 127, b = row >> 11, s = row & 2047;
                bf16_t* p = VT + (((size_t)(b * 8 + hh) * 128 + d) << 11) + s; const u32x4 w = pack8v(v0, v1);
                p[0] = (bf16_t)(w.x & 0xffff); p[2048] = (bf16_t)(w.x >> 16); p[2 * 2048] = (bf16_t)(w.y & 0xffff); p[3 * 2048] = (bf16_t)(w.y >> 16);
                p[4 * 2048] = (bf16_t)(w.z & 0xffff); p[5 * 2048] = (bf16_t)(w.z >> 16); p[6 * 2048] = (bf16_t)(w.w & 0xffff); p[7 * 2048] = (bf16_t)(w.w >> 16); EPI_LOOP_END
        } else if (colt < 4096) {
            EPI_LOOP_BEGIN_R(SS) float* p = ZF + (size_t)row * 512 + (col - 3584); *(f32x4*)p = v0; *(f32x4*)(p + 4) = v1; EPI_LOOP_END
        } else if (colt < 4608) {
            EPI_LOOP_BEGIN_R(SS) *(u32x4*)(HV + (size_t)row * 512 + (col - 4096)) = pack8v(v0, v1); EPI_LOOP_END
        } else if (colt < 5120) {
            EPI_LOOP_BEGIN_R(SS)
#pragma unroll
                for (int j = 0; j < 4; ++j) { v0[j] = v0[j] * sigmoidf_(v0[j]); v1[j] = v1[j] * sigmoidf_(v1[j]); }
                float* p = HQ + (size_t)row * 512 + (col - 4608); *(f32x4*)p = v0; *(f32x4*)(p + 4) = v1; EPI_LOOP_END
        } else if (colt < 5632) {
            EPI_LOOP_BEGIN_R(SS)
#pragma unroll
                for (int j = 0; j < 4; ++j) { v0[j] = v0[j] * sigmoidf_(v0[j]); v1[j] = v1[j] * sigmoidf_(v1[j]); }
                *(u32x4*)(OG + (size_t)row * 512 + (col - 5120)) = pack8v(v0, v1); EPI_LOOP_END
        } else {
            EPI_LOOP_BEGIN_R(SS)
#pragma unroll
                for (int j = 0; j < 4; ++j) { v0[j] = sigmoidf_(v0[j]); v1[j] = sigmoidf_(v1[j]); }
                *(u32x4*)(GT + (size_t)row * 6144 + (col - 5632)) = pack8v(v0, v1); EPI_LOOP_END
        }
        return false;
    }
};
struct EpiBranch {
    unsigned char* ws;
    __device__ __forceinline__ bool operator()(AccT& acc, const pg8::Unit& u, int wr, int wc, int fr, int fq) const {
        const bf16_t* GT = (const bf16_t*)(ws + WS_GT); bf16_t* MIX = (bf16_t*)(ws + WS_MIX);
        const int kind = u.kind;
        const int row0_ = u.pm * 256 + wr * 64 + fr;
#pragma unroll
        for (int ai = 0; ai < 2; ++ai)
#pragma unroll
            for (int m = 0; m < 4; ++m) { const int row = row0_ + ai * 128 + m * 16;
#pragma unroll
                for (int bj = 0; bj < 2; ++bj) { const int col = u.pn * 256 + bj * 128 + wc * 32 + 8 * fq;
                    const u32x4 ga = *(const u32x4*)(GT + (size_t)row * 6144 + kind * 2048 + col);
                    float a[8] = {bflo(ga.x), bfhi(ga.x), bflo(ga.y), bfhi(ga.y), bflo(ga.z), bfhi(ga.z), bflo(ga.w), bfhi(ga.w)};
#pragma unroll
                    for (int j = 0; j < 8; ++j) a[j] = fmaxf(a[j], 1e-30f);
                    if (kind < 2) {
                        const u32x4 gb = *(const u32x4*)(GT + (size_t)row * 6144 + (kind + 1) * 2048 + col);
                        float b[8] = {bflo(gb.x), bfhi(gb.x), bflo(gb.y), bfhi(gb.y), bflo(gb.z), bfhi(gb.z), bflo(gb.w), bfhi(gb.w)};
#pragma unroll
                        for (int j = 0; j < 8; ++j) { const float rr = a[j] * __builtin_amdgcn_rcpf(fmaxf(b[j], 1e-30f)); if (j < 4) acc[ai][bj][m][0][j] *= rr; else acc[ai][bj][m][1][j - 4] *= rr; }
                    } else {
                        f32x4 v0 = acc[ai][bj][m][0], v1 = acc[ai][bj][m][1];
#pragma unroll
                        for (int j = 0; j < 4; ++j) { v0[j] *= a[j]; v1[j] *= a[j + 4]; }
                        *(u32x4*)(MIX + (size_t)row * 2048 + col) = pack8v(v0, v1);
                    }
                } }
        return kind < 2;
    }
};
struct EpiResid {
    unsigned char* ws; int rboff, xboff, ssofs;
    __device__ __forceinline__ bool operator()(AccT& acc, const pg8::Unit& u, int wr, int wc, int fr, int fq) const {
        const bf16_t* RB = (const bf16_t*)(ws + WS_H + (size_t)rboff); bf16_t* XB = (bf16_t*)(ws + WS_H + (size_t)xboff); float* SSO = (float*)(ws + WS_X) + (size_t)ssofs * 8;
        const int row0_ = u.pm * 256 + wr * 64 + fr;
#pragma unroll
        for (int ai = 0; ai < 2; ++ai)
#pragma unroll
            for (int m = 0; m < 4; ++m) { const int row = row0_ + ai * 128 + m * 16; float sq = 0.f;
#pragma unroll
                for (int bj = 0; bj < 2; ++bj) { const int col = u.pn * 256 + bj * 128 + wc * 32 + 8 * fq; const size_t o = (size_t)row * 2048 + col;
                    const u32x4 rw = *(const u32x4*)(RB + o); f32x4 v0 = acc[ai][bj][m][0], v1 = acc[ai][bj][m][1];
                    v0[0] += bflo(rw.x); v0[1] += bfhi(rw.x); v0[2] += bflo(rw.y); v0[3] += bfhi(rw.y); v1[0] += bflo(rw.z); v1[1] += bfhi(rw.z); v1[2] += bflo(rw.w); v1[3] += bfhi(rw.w);
                    *(u32x4*)(XB + o) = pack8v(v0, v1);
                    sq += (v0[0] * v0[0] + v0[1] * v0[1]) + (v0[2] * v0[2] + v0[3] * v0[3]) + (v1[0] * v1[0] + v1[1] * v1[1]) + (v1[2] * v1[2] + v1[3] * v1[3]); }
                sq += shflx(sq, 16, fr + 16 * fq); sq += shflx(sq, 32, fr + 16 * fq); if (fq == 0) ps_write(ai * 128 + wr * 64 + m * 16 + fr, wc, sq); }
        ps_finish(SSO, u, wr, wc, fr, fq);
        return false;
    }
};
struct EpiSwiglu {
    unsigned char* ws; int ssofs;
    __device__ __forceinline__ bool operator()(AccT& acc, const pg8::Unit& u, int wr, int wc, int fr, int fq) const {
        bf16_t* ACT = (bf16_t*)(ws + WS_ACT); const float* SS = (const float*)(ws + WS_X) + (size_t)ssofs * 8;
        const int row0_ = u.pm * 256 + wr * 64 + fr;
#pragma unroll
        for (int ai = 0; ai < 2; ++ai)
#pragma unroll
            for (int m = 0; m < 4; ++m) { const int row = row0_ + ai * 128 + m * 16; const int col = u.pn * 128 + wc * 32 + 8 * fq; const float rs_ = rstd_row(SS, row);
                f32x4 g0 = acc[ai][0][m][0] * rs_, g1 = acc[ai][0][m][1] * rs_; const f32x4 u0 = acc[ai][1][m][0] * rs_, u1 = acc[ai][1][m][1] * rs_;
#pragma unroll
                for (int j = 0; j < 4; ++j) { g0[j] = g0[j] * sigmoidf_(g0[j]) * u0[j]; g1[j] = g1[j] * sigmoidf_(g1[j]) * u1[j]; }
                *(u32x4*)(ACT + (size_t)row * DFF + col) = pack8v(g0, g1); }
        return false;
    }
};
struct EpiBf16 {
    unsigned char* ws;
    __device__ __forceinline__ bool operator()(AccT& acc, const pg8::Unit& u, int wr, int wc, int fr, int fq) const {
        bf16_t* OUT = (bf16_t*)(ws + WS_PPB);
        EPI_LOOP_BEGIN *(u32x4*)(OUT + (size_t)row * 2048 + col) = pack8v(v0, v1); EPI_LOOP_END
        return false;
    }
};
struct EpiPle {
    unsigned char* ws; int ssofs;
    __device__ __forceinline__ bool operator()(AccT& acc, const pg8::Unit& u, int wr, int wc, int fr, int fq) const {
        const bf16_t* RB = (const bf16_t*)(ws + WS_HB); const bf16_t* PP = (const bf16_t*)(ws + WS_PPB); bf16_t* XB = (bf16_t*)(ws + WS_H);
        const float* SS = (const float*)(ws + WS_X) + (size_t)ssofs * 8; float* SSO = (float*)(ws + WS_X) + (size_t)(ssofs + TT) * 8;
        const int row0_ = u.pm * 256 + wr * 64 + fr;
#pragma unroll
        for (int ai = 0; ai < 2; ++ai)
#pragma unroll
            for (int m = 0; m < 4; ++m) { const int row = row0_ + ai * 128 + m * 16; const float rs_ = rstd_row(SS, row); float sq = 0.f;
#pragma unroll
                for (int bj = 0; bj < 2; ++bj) { const int col = u.pn * 256 + bj * 128 + wc * 32 + 8 * fq; const size_t o = (size_t)row * 2048 + col;
                    const u32x4 rw = *(const u32x4*)(RB + o); const u32x4 pw = *(const u32x4*)(PP + o);
                    f32x4 v0 = acc[ai][bj][m][0] * rs_, v1 = acc[ai][bj][m][1] * rs_;
                    v0[0] = bflo(rw.x) + sigmoidf_(v0[0]) * bflo(pw.x); v0[1] = bfhi(rw.x) + sigmoidf_(v0[1]) * bfhi(pw.x); v0[2] = bflo(rw.y) + sigmoidf_(v0[2]) * bflo(pw.y); v0[3] = bfhi(rw.y) + sigmoidf_(v0[3]) * bfhi(pw.y);
                    v1[0] = bflo(rw.z) + sigmoidf_(v1[0]) * bflo(pw.z); v1[1] = bfhi(rw.z) + sigmoidf_(v1[1]) * bfhi(pw.z); v1[2] = bflo(rw.w) + sigmoidf_(v1[2]) * bflo(pw.w); v1[3] = bfhi(rw.w) + sigmoidf_(v1[3]) * bfhi(pw.w);
                    *(u32x4*)(XB + o) = pack8v(v0, v1);
                    sq += (v0[0] * v0[0] + v0[1] * v0[1]) + (v0[2] * v0[2] + v0[3] * v0[3]) + (v1[0] * v1[0] + v1[1] * v1[1]) + (v1[2] * v1[2] + v1[3] * v1[3]); }
                sq += shflx(sq, 16, fr + 16 * fq); sq += shflx(sq, 32, fr + 16 * fq); if (fq == 0) ps_write(ai * 128 + wr * 64 + m * 16 + fr, wc, sq); }
        ps_finish(SSO, u, wr, wc, fr, fq);
        return false;
    }
};

constexpr int LDS_MISC = 131072, LDS_PSUM = 132096, LDS_BYTES = 132096 + 4096;
constexpr int PPL = 8;
constexpr int NPHASE = 2 + PPL * NLAYER;

struct Args { const float* in[19]; float* out; unsigned char* ws; int ph_lo, ph_hi; };

__device__ __forceinline__ float wave_sum(float v, int lane) {
#pragma unroll
    for (int o = 1; o < 64; o <<= 1) v += shflx(v, o, lane);
    return v;
}
template <bool F32OUT>
__device__ __forceinline__ void rmsnorm_rows(const float* X, const float* G, bf16_t* OB, float* OF) {
    const int tid_ = opaque_tid(); const int lane = tid_ & 63, gw = blockIdx.x * 8 + (tid_ >> 6), ngw = gridDim.x * 8;
    for (int row = gw; row < TT; row += ngw) {
        const f32x4* xr = (const f32x4*)(X + (size_t)row * DM) + lane;
        f32x4 v[8]; float s = 0.f;
#pragma unroll
        for (int j = 0; j < 8; ++j) { v[j] = xr[64 * j]; s += (v[j][0] * v[j][0] + v[j][1] * v[j][1]) + (v[j][2] * v[j][2] + v[j][3] * v[j][3]); }
        const float rstd = 1.0f / sqrtf(wave_sum(s, lane) * (1.0f / DM) + EPS);
#pragma unroll
        for (int j = 0; j < 8; ++j) { const f32x4 gg = ((const f32x4*)G)[lane + 64 * j]; const f32x4 y = v[j] * rstd * gg;
            if (F32OUT) ((f32x4*)(OF + (size_t)row * DM))[lane + 64 * j] = y;
            else { u32x2 w; w.x = cvt_pk_bf16(y[0], y[1]); w.y = cvt_pk_bf16(y[2], y[3]); ((u32x2*)(OB + (size_t)row * DM))[lane + 64 * j] = w; } }
    }
}

__device__ __forceinline__ void final_norm_rows(const bf16_t* XB, const float* SS, const float* G, float* OF) {
    const int tid_ = opaque_tid(); const int lane = tid_ & 63, gw = blockIdx.x * 8 + (tid_ >> 6), ngw = gridDim.x * 8;
    for (int row = gw; row < TT; row += ngw) {
        const float rstd = rstd_row(SS, row);
#pragma unroll
        for (int j = 0; j < 4; ++j) { const u32x4 w = ((const u32x4*)(XB + (size_t)row * DM))[lane + 64 * j];
            const f32x4 ga = ((const f32x4*)G)[2 * (lane + 64 * j)], gb = ((const f32x4*)G)[2 * (lane + 64 * j) + 1];
            f32x4 y0, y1; y0[0] = bflo(w.x) * rstd * ga[0]; y0[1] = bfhi(w.x) * rstd * ga[1]; y0[2] = bflo(w.y) * rstd * ga[2]; y0[3] = bfhi(w.y) * rstd * ga[3];
            y1[0] = bflo(w.z) * rstd * gb[0]; y1[1] = bfhi(w.z) * rstd * gb[1]; y1[2] = bflo(w.w) * rstd * gb[2]; y1[3] = bfhi(w.w) * rstd * gb[3];
            ((f32x4*)(OF + (size_t)row * DM))[2 * (lane + 64 * j)] = y0; ((f32x4*)(OF + (size_t)row * DM))[2 * (lane + 64 * j) + 1] = y1; }
    }
}
__device__ __forceinline__ void rows_bf16_ss(const float* X, bf16_t* OB, float* SSO) {
    const int tid_ = opaque_tid(); const int lane = tid_ & 63, gw = blockIdx.x * 8 + (tid_ >> 6), ngw = gridDim.x * 8;
    for (int row = gw; row < TT; row += ngw) {
        const f32x4* xr = (const f32x4*)(X + (size_t)row * DM) + lane; float s = 0.f;
#pragma unroll
        for (int j = 0; j < 8; ++j) { const f32x4 v = xr[64 * j]; s += (v[0] * v[0] + v[1] * v[1]) + (v[2] * v[2] + v[3] * v[3]);
            u32x2 w; w.x = cvt_pk_bf16(v[0], v[1]); w.y = cvt_pk_bf16(v[2], v[3]); ((u32x2*)(OB + (size_t)row * DM))[lane + 64 * j] = w; }
        s = wave_sum(s, lane); if (lane == 0) { float z = 0.f; asm volatile("" : "+v"(z)); *(f32x4*)(SSO + (size_t)row * 8) = (f32x4){s, z, z, z}; *(f32x4*)(SSO + (size_t)row * 8 + 4) = (f32x4){z, z, z, z}; }
    }
}
struct TJob { const float* src; const float* gain; bf16_t* dst; int N, ldd, k0, n0, drow0, dk0; };
__device__ __forceinline__ TJob tjob_decode(const Args& a, int it) {
    constexpr int C_IN = 16 * 92, C_BP = 4 * 16, C_BS = 8 * 16, C_BH = 4 * 16, C_OUT = 256, C_GU = 16 * 88, C_DN = 44 * 16, C_PG = 256, C_PP = 2 * 16;
    constexpr int PER_L = C_IN + C_BP + C_BS + C_BH + C_OUT + C_GU + C_DN + C_PG + C_PP;
    const int L = it / PER_L; int r = it - L * PER_L;
    unsigned char* wl = a.ws + WS_W0 + (size_t)L * WL_SIZE;
    TJob J; J.gain = nullptr; J.dk0 = 0; int nkb, gu = 0;
    if (r < C_IN) { J.src = a.in[3] + (size_t)L * DM * INC; J.N = INC; J.dst = (bf16_t*)(wl + WL_IN); J.ldd = DM; nkb = 16; J.gain = a.in[2] + (size_t)L * DM; }
    else if ((r -= C_IN) < C_BP) { J.src = a.in[8] + (size_t)L * 512 * DM; J.N = DM; J.dst = (bf16_t*)(wl + WL_BR); J.ldd = DM; nkb = 4; }
    else if ((r -= C_BP) < C_BS) { J.src = a.in[9] + (size_t)L * 1024 * DM; J.N = DM; J.dst = (bf16_t*)(wl + WL_BR); J.ldd = DM; J.dk0 = 512; nkb = 8; }
    else if ((r -= C_BS) < C_BH) { J.src = a.in[10] + (size_t)L * 512 * DM; J.N = DM; J.dst = (bf16_t*)(wl + WL_BR); J.ldd = DM; J.dk0 = 1536; nkb = 4; }
    else if ((r -= C_BH) < C_OUT) { J.src = a.in[11] + (size_t)L * DM * DM; J.N = DM; J.dst = (bf16_t*)(wl + WL_OUT); J.ldd = DM; nkb = 16; }
    else if ((r -= C_OUT) < C_GU) { J.src = a.in[13] + (size_t)L * DM * 2 * DFF; J.N = 2 * DFF; J.dst = (bf16_t*)(wl + WL_GU); J.ldd = DM; nkb = 16; gu = 1; J.gain = a.in[12] + (size_t)L * DM; }
    else if ((r -= C_GU) < C_DN) { J.src = a.in[14] + (size_t)L * DFF * DM; J.N = DM; J.dst = (bf16_t*)(wl + WL_DN); J.ldd = DFF; nkb = 44; }
    else if ((r -= C_DN) < C_PG) { J.src = a.in[16] + (size_t)L * DM * DM; J.N = DM; J.dst = (bf16_t*)(wl + WL_PG); J.ldd = DM; nkb = 16; J.gain = a.in[15] + (size_t)L * DM; }
    else { r -= C_PG; J.src = a.in[17] + (size_t)L * PLE * DM; J.N = DM; J.dst = (bf16_t*)(wl + WL_PP); J.ldd = PLE; nkb = 2; }
    const int nb = r / nkb, kb = r - nb * nkb;
    J.drow0 = nb * 128; if (gu) J.drow0 = nb < 44 ? 256 * nb : 256 * (nb - 44) + 128;
    J.k0 = kb * 128; J.n0 = nb * 128;
    return J;
}
__device__ __forceinline__ void tjob_load(const TJob& J, int tid, f32x4 (&v)[8]) {
#pragma unroll
    for (int p = 0; p < 8; ++p) { const int k = p * 16 + (tid >> 5), c = (tid & 31) * 4;
        v[p] = __builtin_nontemporal_load((const f32x4*)(J.src + (size_t)(J.k0 + k) * J.N + J.n0 + c)); if (J.gain) v[p] = v[p] * J.gain[J.k0 + k]; }
}
__device__ __forceinline__ void tjob_finish(const TJob& J, int tid, const f32x4 (&v)[8], float* sm) {
#pragma unroll
    for (int p = 0; p < 8; ++p) { const int k = p * 16 + (tid >> 5), c = (tid & 31) * 4; float* s = sm + k * 129 + c; s[0] = v[p][0]; s[1] = v[p][1]; s[2] = v[p][2]; s[3] = v[p][3]; }
    __syncthreads();
#pragma unroll
    for (int i = 0; i < 4; ++i) { const int item = tid + 512 * i, c = item & 15, n = item >> 4; const float* s = sm + (8 * c) * 129 + n;
        u32x4 w; w.x = cvt_pk_bf16(s[0], s[129]); w.y = cvt_pk_bf16(s[2 * 129], s[3 * 129]); w.z = cvt_pk_bf16(s[4 * 129], s[5 * 129]); w.w = cvt_pk_bf16(s[6 * 129], s[7 * 129]);
        *(u32x4*)(J.dst + (size_t)(J.drow0 + n) * J.ldd + J.dk0 + J.k0 + 8 * c) = w; }
    __syncthreads();
}

__device__ __forceinline__ void prologue_phase(const Args& a, unsigned char* lds) {
    float* sm = (float*)lds;
    constexpr int N_ITEMS = NLAYER * (16 * 92 + 4 * 16 + 8 * 16 + 4 * 16 + 256 + 16 * 88 + 44 * 16 + 256 + 2 * 16);
    {   const int tid = opaque_tid();
        int it = blockIdx.x;
        if (it < N_ITEMS) {
            TJob J = tjob_decode(a, it); f32x4 v[8]; tjob_load(J, tid, v);
            for (;;) {
                const int itn = it + gridDim.x; const bool more = itn < N_ITEMS;
                TJob Jn = J; f32x4 vn[8];
#pragma unroll
                for (int p = 0; p < 8; ++p) vn[p] = v[p];
                if (more) { Jn = tjob_decode(a, itn); tjob_load(Jn, tid, vn); }
                tjob_finish(J, tid, v, sm);
                if (!more) break;
                J = Jn; it = itn;
#pragma unroll
                for (int p = 0; p < 8; ++p) v[p] = vn[p];
            }
        }
    }
    { const f32x4* ps = (const f32x4*)a.in[1]; u32x2* pd = (u32x2*)(a.ws + WS_PB); const int n4 = NLAYER * TT * PLE / 4;
      for (int i = blockIdx.x * 512 + opaque_tid(); i < n4; i += gridDim.x * 512) { const f32x4 v = ps[i]; u32x2 w; w.x = cvt_pk_bf16(v[0], v[1]); w.y = cvt_pk_bf16(v[2], v[3]); pd[i] = w; } }
    rows_bf16_ss(a.in[0], (bf16_t*)(a.ws + WS_H), (float*)(a.ws + WS_X));
}

__device__ __forceinline__ void pool_unit(unsigned char* lds, int tile, int gi, int L, const Args& a) {
    float* Wl = (float*)lds; float* uw = Wl + 128 * 128; float* mx = uw + 47 * 128;
    const int tid = opaque_tid();
    const float* U = (const float*)(a.ws + WS_U);
    const float* PW = a.in[4] + ((size_t)L * 4 + gi) * 128 * 128;
    const int t0 = tile * 32, s0 = t0 & (SEQ - 1);
#pragma unroll
    for (int i = 0; i < 8; ++i) ((f32x4*)Wl)[tid + 512 * i] = ((const f32x4*)PW)[tid + 512 * i];
    for (int i = tid; i < 47 * 32; i += 512) { const int rr = i >> 5, c4 = i & 31; const int sp = s0 - 15 + rr;
        f32x4 v = (f32x4){0.f, 0.f, 0.f, 0.f};
        if (sp >= 0) v = *(const f32x4*)(U + (size_t)(t0 - 15 + rr) * 512 + gi * 128 + c4 * 4);
        ((f32x4*)uw)[i] = v; }
    __syncthreads();
    const int w = 2 << gi;
    for (int i = tid; i < 32 * 128; i += 512) { const int tt = i >> 7, c = i & 127; float s = 0.f;
        for (int j = 0; j < w; ++j) s += uw[(15 + tt - j) * 128 + c];
        const int cnt = min(s0 + tt + 1, w);
        mx[i] = s / (float)cnt - uw[(15 + tt) * 128 + c]; }
    __syncthreads();
    const int d = tid & 127, tg = tid >> 7;
    float acc[8];
#pragma unroll
    for (int j = 0; j < 8; ++j) acc[j] = 0.f;
    for (int c = 0; c < 128; c += 4) {
        const float w0 = Wl[c * 128 + d], w1 = Wl[(c + 1) * 128 + d], w2 = Wl[(c + 2) * 128 + d], w3 = Wl[(c + 3) * 128 + d];
#pragma unroll
        for (int j = 0; j < 8; ++j) { const f32x4 mv = *(const f32x4*)(mx + (tg * 8 + j) * 128 + c); acc[j] += mv[0] * w0 + mv[1] * w1 + mv[2] * w2 + mv[3] * w3; }
    }
    const float sc = a.in[5][(size_t)L * 512 + gi * 128 + d];
    bf16_t* Y = (bf16_t*)(a.ws + WS_Y);
#pragma unroll
    for (int j = 0; j < 8; ++j) Y[(size_t)(t0 + tg * 8 + j) * 2048 + gi * 128 + d] = (bf16_t)(cvt_pk_bf16(acc[j] * sc, 0.f) & 0xffff);
    __syncthreads();
}

__device__ __forceinline__ void attn_unit(unsigned char* lds, int b, int h, int qb, const Args& a) {
    const bf16_t* SQ = (const bf16_t*)(a.ws + WS_SQ); const bf16_t* SK = (const bf16_t*)(a.ws + WS_SK); const bf16_t* VT = (const bf16_t*)(a.ws + WS_VT);
    bf16_t* Y = (bf16_t*)(a.ws + WS_Y);
    const int tid = opaque_tid(), lane = tid & 63, wid = tid >> 6, r = lane & 31, hi = lane >> 5;
    const int half = wid >> 2, wq = wid & 3, t256 = tid & 255;
    const int q0 = qb * 128, qw0 = q0 + wq * 32;
    const size_t rowbase = (size_t)b * SEQ;
    constexpr int KBY = 64 * 272, VBY = 128 * 144, BUF = KBY + VBY;
    unsigned char* hb = lds + half * BUF;
    bf16x8 qf[8];
    { const bf16_t* qp = SQ + (rowbase + qw0 + r) * 1024 + h * 128 + hi * 8;
#pragma unroll
      for (int ds = 0; ds < 8; ++ds) qf[ds] = *(const bf16x8*)(qp + ds * 16); }
    f32x16 o[4];
#pragma unroll
    for (int i = 0; i < 4; ++i)
#pragma unroll
        for (int j = 0; j < 16; ++j) o[i][j] = 0.f;
    float R = 1.f;
    const int nst = qb + 1;
    const int jstart = half == 0 ? 2 * qb + 1 : qb;
    u32x4 st[8];
#define ATT_LOAD(jj) do { _Pragma("unroll") for (int i = 0; i < 4; ++i) { const int ch = t256 + 256 * i; \
        st[i] = *(const u32x4*)(SK + (rowbase + 64 * (jj) + (ch >> 4)) * 1024 + h * 128 + (ch & 15) * 8); \
        st[4 + i] = *(const u32x4*)(VT + (((size_t)(b * 8 + h) * 128 + (ch >> 3)) << 11) + 64 * (jj) + (ch & 7) * 8); } } while (0)
#define ATT_STORE() do { _Pragma("unroll") for (int i = 0; i < 4; ++i) { const int ch = t256 + 256 * i; \
        *(u32x4*)(hb + (ch >> 4) * 272 + (ch & 15) * 16) = st[i]; *(u32x4*)(hb + KBY + (ch >> 3) * 144 + (ch & 7) * 16) = st[4 + i]; } } while (0)
    ATT_LOAD(jstart); ATT_STORE();
    __syncthreads();
    for (int sidx = 0; sidx < nst; ++sidx) {
        const int j = jstart - sidx;
        if (sidx + 1 < nst) ATT_LOAD(j - 1);
        if (64 * j <= qw0 + 31) {
            const unsigned char* Kb = hb; const unsigned char* Vb = hb + KBY;
            f32x16 p[2];
#pragma unroll
            for (int hh = 0; hh < 2; ++hh) {
#pragma unroll
                for (int jj = 0; jj < 16; ++jj) p[hh][jj] = 0.f;
#pragma unroll
                for (int ds = 0; ds < 8; ++ds) { const bf16x8 ka = *(const bf16x8*)(Kb + (32 * hh + r) * 272 + (16 * ds + 8 * hi) * 2); p[hh] = MFMA32(ka, qf[ds], p[hh]); }
            }
            const int t = qw0 + r; const int sbase = 64 * j + 4 * hi;
            float G[8];
#define ATT_ELEM(MASKED) \
            _Pragma("unroll") for (int hh = 0; hh < 2; ++hh) \
                _Pragma("unroll") for (int g = 0; g < 4; ++g) { \
                    float mm[4], bb[4]; \
                    _Pragma("unroll") for (int i = 0; i < 4; ++i) { const float uu = __builtin_amdgcn_exp2f(p[hh][4 * g + i]); \
                        const float mi = __builtin_amdgcn_rcpf(1.0f + uu); \
                        if (MASKED) { const int s = sbase + 32 * hh + 8 * g + i; const bool valid = s < t; mm[i] = valid ? mi : 1.0f; bb[i] = valid ? 1.0f - mi : 0.0f; } \
                        else { mm[i] = mi; bb[i] = 1.0f - mi; } } \
                    const float e2 = mm[3], e1 = mm[2] * e2, e0 = mm[1] * e1; \
                    G[hh * 4 + g] = mm[0] * e0; \
                    p[hh][4 * g + 0] = bb[0] * e0; p[hh][4 * g + 1] = bb[1] * e1; p[hh][4 * g + 2] = bb[2] * e2; p[hh][4 * g + 3] = bb[3]; \
                }
            if (64 * j + 63 < qw0) { ATT_ELEM(false) } else { ATT_ELEM(true) }
#undef ATT_ELEM
            float X = 1.0f;
#pragma unroll
            for (int idx = 7; idx >= 0; --idx) { const float gp = shflx(G[idx], 32, lane); const float f = X * (hi == 0 ? gp : 1.0f) * R;
                const int hh = idx >> 2, g = idx & 3;
#pragma unroll
                for (int i = 0; i < 4; ++i) p[hh][4 * g + i] *= f;
                X *= G[idx] * gp; }
            R *= X;
            bf16x8 pa[4];
#pragma unroll
            for (int kb = 0; kb < 4; ++kb) { const int hh = kb >> 1, b8 = (kb & 1) * 8;
                pa[kb] = pack8(p[hh][b8], p[hh][b8 + 1], p[hh][b8 + 2], p[hh][b8 + 3], p[hh][b8 + 4], p[hh][b8 + 5], p[hh][b8 + 6], p[hh][b8 + 7]); }
#pragma unroll
            for (int kb = 0; kb < 4; ++kb)
#pragma unroll
                for (int db = 0; db < 4; ++db) { const unsigned char* vp = Vb + (32 * db + r) * 144 + (16 * kb + 4 * hi) * 2;
                    const s16x4 lo = *(const s16x4*)vp, hi4 = *(const s16x4*)(vp + 16);
                    const bf16x8 vf = (bf16x8){lo[0], lo[1], lo[2], lo[3], hi4[0], hi4[1], hi4[2], hi4[3]};
                    o[db] = MFMA32(pa[kb], vf, o[db]); }
        }
        __syncthreads();
        if (sidx + 1 < nst) ATT_STORE();
        __syncthreads();
    }
#undef ATT_LOAD
#undef ATT_STORE
    float* OF = (float*)lds; float* RB = (float*)(lds + 128 * 132 * 4);
    if (half == 1) {
#pragma unroll
        for (int db = 0; db < 4; ++db)
#pragma unroll
            for (int reg = 0; reg < 16; ++reg) OF[(32 * wq + crow(reg, hi)) * 132 + 32 * db + r] = o[db][reg];
    } else if (hi == 0) RB[32 * wq + r] = R;
    __syncthreads();
    if (half == 0) {
#pragma unroll
        for (int reg = 0; reg < 16; ++reg) { const int q = 32 * wq + crow(reg, hi); const float rr = RB[q];
#pragma unroll
            for (int db = 0; db < 4; ++db) { const float v = o[db][reg] + rr * OF[q * 132 + 32 * db + r];
                Y[(rowbase + q0 + q) * 2048 + 512 + h * 128 + 32 * db + r] = (bf16_t)(cvt_pk_bf16(v, 0.f) & 0xffff); } }
    }
    __syncthreads();
}

__device__ __forceinline__ void hgrn_prep_unit(unsigned char* lds, int bh, int c, int L, const Args& a) {
    const float* ZF = (const float*)(a.ws + WS_ZF); const float* HQ = (const float*)(a.ws + WS_HQ); const bf16_t* HV = (const bf16_t*)(a.ws + WS_HV);
    bf16_t* HQD = (bf16_t*)(a.ws + WS_HQD); bf16_t* HKD = (bf16_t*)(a.ws + WS_HKD); bf16_t* HVT = (bf16_t*)(a.ws + WS_HVT);
    float* HDEC = (float*)(a.ws + WS_HDEC); float* HOI = (float*)(a.ws + WS_HOI);
    const int b = bh >> 2, h = bh & 3;
    const int tid = opaque_tid(), lane = tid & 63, wid = tid >> 6, r = lane & 31, hi = lane >> 5;
    float* TOT = (float*)lds; unsigned char* QD = lds + 2048; unsigned char* KT = QD + 32 * 272; unsigned char* VTl = KT + 32 * 272;
    const int k = tid & 127, tq = tid >> 7;
    float lbA, lbB, oml;
    { const int ch = h * 128 + k; const float h0 = a.in[6][ch], h1 = a.in[6][512 + ch]; const float mxv = fmaxf(h0, h1);
      const float e0 = __expf(h0 - mxv), e1 = __expf(h1 - mxv); float lb = (L == 0) ? 0.f : e1 / (e0 + e1);
      lb = fminf(fmaxf(lb, 0.f), 1.f); lbA = fmaxf(lb, 1e-20f); lbB = 1.0f - fminf(lb, 1.0f - 1e-6f); oml = 1.0f - lb; }
    const size_t row0 = (size_t)b * SEQ + c * 32;
    const size_t gbase = (row0 + tq * 8) * 512 + h * 128 + k;
    const size_t fidx = (size_t)(bh * 64 + c) * 4096 + (size_t)((((k >> 5) * 2 + (tq >> 1)) * 64 + (tq & 1) * 32 + (k & 31)) * 8);
    float kk[8], bl[8], qv[8]; float bs = 0.f;
#pragma unroll
    for (int i = 0; i < 8; ++i) { float zf = ZF[gbase + (size_t)i * 512]; qv[i] = HQ[gbase + (size_t)i * 512];
        zf = fminf(fmaxf(zf, -80.f), 80.f); const float e = __expf(-zf); const float sg = __builtin_amdgcn_rcpf(1.0f + e);
        const float f = lbA + lbB * sg; bs += logf(f); bl[i] = bs; kk[i] = oml * e * sg; }
    TOT[tq * 128 + k] = bs;
    { unsigned short x[8];
#pragma unroll
      for (int i = 0; i < 8; ++i) x[i] = HV[gbase + (size_t)i * 512];
      u32x4 w; w.x = x[0] | ((unsigned)x[1] << 16); w.y = x[2] | ((unsigned)x[3] << 16); w.z = x[4] | ((unsigned)x[5] << 16); w.w = x[6] | ((unsigned)x[7] << 16);
      *(u32x4*)(VTl + k * 80 + tq * 16) = w; *(u32x4*)(HVT + fidx) = w; }
    __syncthreads();
    float off = 0.f, tot = 0.f;
#pragma unroll
    for (int q = 0; q < 4; ++q) { const float v = TOT[q * 128 + k]; tot += v; if (q < tq) off += v; }
    float kd[8];
#pragma unroll
    for (int i = 0; i < 8; ++i) { const float bt = off + bl[i]; const int t = tq * 8 + i;
        *(bf16_t*)(QD + t * 272 + k * 2) = (bf16_t)(cvt_pk_bf16(qv[i] * __expf(bt), 0.f) & 0xffff);
        *(bf16_t*)(KT + t * 272 + k * 2) = (bf16_t)(cvt_pk_bf16(kk[i] * __expf(fminf(-bt, 80.f)), 0.f) & 0xffff);
        kd[i] = kk[i] * __expf(tot - bt); }
    *(bf16x8*)(HKD + fidx) = pack8(kd[0], kd[1], kd[2], kd[3], kd[4], kd[5], kd[6], kd[7]);
    if (tq == 0) HDEC[(size_t)(bh * 64 + c) * 128 + k] = __expf(tot);
    __syncthreads();
    { const int k0 = 32 * (wid >> 1) + 16 * (wid & 1) + 4 * hi; const unsigned char* p = QD + r * 272 + k0 * 2;
      const s16x4 lo = *(const s16x4*)p, hi4 = *(const s16x4*)(p + 16);
      *(bf16x8*)(HQD + (size_t)(bh * 64 + c) * 4096 + (wid * 64 + lane) * 8) = (bf16x8){lo[0], lo[1], lo[2], lo[3], hi4[0], hi4[1], hi4[2], hi4[3]}; }
    if (wid < 4) {
        const int w = wid;
        f32x16 pt;
#pragma unroll
        for (int j = 0; j < 16; ++j) pt[j] = 0.f;
#pragma unroll
        for (int ks = 0; ks < 8; ++ks) { const bf16x8 ka = *(const bf16x8*)(KT + r * 272 + (16 * ks + 8 * hi) * 2); const bf16x8 qa = *(const bf16x8*)(QD + r * 272 + (16 * ks + 8 * hi) * 2);
            pt = MFMA32(ka, qa, pt); }
#pragma unroll
        for (int reg = 0; reg < 16; ++reg) { if (crow(reg, hi) > r) pt[reg] = 0.f; }
        const bf16x8 pa0 = pack8(pt[0], pt[1], pt[2], pt[3], pt[4], pt[5], pt[6], pt[7]);
        const bf16x8 pa1 = pack8(pt[8], pt[9], pt[10], pt[11], pt[12], pt[13], pt[14], pt[15]);
        f32x16 o;
#pragma unroll
        for (int j = 0; j < 16; ++j) o[j] = 0.f;
#pragma unroll
        for (int s16 = 0; s16 < 2; ++s16) { const unsigned char* vp = VTl + (32 * w + r) * 80 + (16 * s16 + 4 * hi) * 2;
            const s16x4 lo = *(const s16x4*)vp, hi4 = *(const s16x4*)(vp + 16);
            const bf16x8 vf = (bf16x8){lo[0], lo[1], lo[2], lo[3], hi4[0], hi4[1], hi4[2], hi4[3]};
            o = MFMA32(s16 ? pa1 : pa0, vf, o); }
#pragma unroll
        for (int reg = 0; reg < 16; ++reg) HOI[(row0 + crow(reg, hi)) * 512 + h * 128 + 32 * w + r] = o[reg];
    }
    __syncthreads();
}

__device__ __forceinline__ float dpp_sum16(float v) {
    v += __int_as_float(__builtin_amdgcn_update_dpp(0, __float_as_int(v), 0xB1, 0xF, 0xF, true));
    v += __int_as_float(__builtin_amdgcn_update_dpp(0, __float_as_int(v), 0x4E, 0xF, 0xF, true));
    v += __int_as_float(__builtin_amdgcn_update_dpp(0, __float_as_int(v), 0x141, 0xF, 0xF, true));
    v += __int_as_float(__builtin_amdgcn_update_dpp(0, __float_as_int(v), 0x140, 0xF, 0xF, true));
    return v;
}
__device__ __forceinline__ void hgrn_chain_unit(unsigned char* lds, int bh, int L, const Args& a) {
    const bf16_t* HQD = (const bf16_t*)(a.ws + WS_HQD); const bf16_t* HKD = (const bf16_t*)(a.ws + WS_HKD); const bf16_t* HVT = (const bf16_t*)(a.ws + WS_HVT);
    const float* HDEC = (const float*)(a.ws + WS_HDEC); const float* HOI = (const float*)(a.ws + WS_HOI);
    const bf16_t* OG = (const bf16_t*)(a.ws + WS_OG); bf16_t* Y = (bf16_t*)(a.ws + WS_Y);
    const int b = bh >> 2, h = bh & 3;
    const int tid = opaque_tid(), lane = tid & 63, wid = tid >> 6, r = lane & 31, hi = lane >> 5;
    constexpr int BUFB = 25088;
    float* OB = (float*)(lds + 3 * BUFB);
    f32x16 Sacc[4];
#pragma unroll
    for (int i = 0; i < 4; ++i)
#pragma unroll
        for (int j = 0; j < 16; ++j) Sacc[i][j] = 0.f;
    const size_t cb = (size_t)bh * 64;
    const size_t rowb = (size_t)b * SEQ;
    u32x4 stA[3], stB[3]; f32x4 sdA = (f32x4){0.f, 0.f, 0.f, 0.f}, sdB = sdA;
#define HG_LOAD(cc, st, sd) do { const int cc_ = (cc) < 63 ? (cc) : 63; const size_t e_ = (cb + cc_) * 4096 + (size_t)tid * 8; st[0] = *(const u32x4*)(HQD + e_); st[1] = *(const u32x4*)(HKD + e_); st[2] = *(const u32x4*)(HVT + e_); \
        sd = *(const f32x4*)(HDEC + (cb + cc_) * 128 + (tid & 31) * 4); } while (0)
#define HG_STORE(bi, st, sd) do { unsigned char* B_ = lds + (bi) * BUFB; *(u32x4*)(B_ + tid * 16) = st[0]; *(u32x4*)(B_ + 8192 + tid * 16) = st[1]; *(u32x4*)(B_ + 16384 + tid * 16) = st[2]; \
        if (tid < 32) *(f32x4*)(B_ + 24576 + tid * 16) = sd; } while (0)
    HG_LOAD(0, stA, sdA); HG_STORE(0, stA, sdA); HG_LOAD(1, stA, sdA); HG_STORE(1, stA, sdA);
    HG_LOAD(2, stB, sdB);
    const int pt_ = tid >> 4, seg = tid & 15; const int ch = h * 128 + seg * 8;
    const float* gn = a.in[7] + (size_t)L * 512 + ch; const f32x4 g0 = *(const f32x4*)gn, g1 = *(const f32x4*)(gn + 4);
    f32x4 oiA0, oiA1, oiB0, oiB1; u32x4 ogA, ogB;
#define HG_PLOAD(cc, o0, o1, og_) do { const int cp_ = (cc) < 63 ? (cc) : 63; const size_t row_ = rowb + cp_ * 32 + pt_; o0 = *(const f32x4*)(HOI + row_ * 512 + ch); o1 = *(const f32x4*)(HOI + row_ * 512 + ch + 4); og_ = *(const u32x4*)(OG + row_ * 512 + ch); } while (0)
    HG_PLOAD(0, oiA0, oiA1, ogA);
    __syncthreads();
#define HG_ITER(c, stX, sdX, stY, sdY, oiC0, oiC1, ogC, oiN0, oiN1, ogN) do { \
        const int bi = (c) % 3; \
        HG_LOAD((c) + 3, stX, sdX); \
        HG_PLOAD((c) + 1, oiN0, oiN1, ogN); \
        if (wid < 4) { \
            const int w = wid; const unsigned char* B = lds + bi * BUFB; \
            f32x16 o, o2; \
            _Pragma("unroll") for (int j = 0; j < 16; ++j) { o[j] = 0.f; o2[j] = 0.f; } \
            _Pragma("unroll") for (int kb = 0; kb < 4; ++kb) \
                _Pragma("unroll") for (int s16 = 0; s16 < 2; ++s16) { const bf16x8 aq = *(const bf16x8*)(B + ((kb * 2 + s16) * 64 + lane) * 16); const int b8 = 8 * s16; \
                    const bf16x8 bsv = pack8(Sacc[kb][b8], Sacc[kb][b8 + 1], Sacc[kb][b8 + 2], Sacc[kb][b8 + 3], Sacc[kb][b8 + 4], Sacc[kb][b8 + 5], Sacc[kb][b8 + 6], Sacc[kb][b8 + 7]); \
                    if (kb < 2) o = MFMA32(aq, bsv, o); else o2 = MFMA32(aq, bsv, o2); } \
            _Pragma("unroll") for (int kb = 0; kb < 4; ++kb) { \
                _Pragma("unroll") for (int g = 0; g < 4; ++g) { const f32x4 dd = *(const f32x4*)(B + 24576 + (32 * kb + 8 * g + 4 * hi) * 4); \
                    _Pragma("unroll") for (int i = 0; i < 4; ++i) Sacc[kb][4 * g + i] *= dd[i]; } \
                _Pragma("unroll") for (int s16 = 0; s16 < 2; ++s16) { const bf16x8 ka = *(const bf16x8*)(B + 8192 + ((kb * 2 + s16) * 64 + lane) * 16); \
                    const bf16x8 va = *(const bf16x8*)(B + 16384 + ((w * 2 + s16) * 64 + lane) * 16); \
                    Sacc[kb] = MFMA32(ka, va, Sacc[kb]); } \
            } \
            _Pragma("unroll") for (int reg = 0; reg < 16; ++reg) OB[crow(reg, hi) * 132 + 32 * w + r] = o[reg] + o2[reg]; \
        } \
        __syncthreads(); \
        { const size_t row = rowb + (c) * 32 + pt_; const float* op = OB + pt_ * 132 + seg * 8; \
          const f32x4 x0 = *(const f32x4*)op + oiC0, x1 = *(const f32x4*)(op + 4) + oiC1; \
          float ss = (x0[0] * x0[0] + x0[1] * x0[1]) + (x0[2] * x0[2] + x0[3] * x0[3]) + (x1[0] * x1[0] + x1[1] * x1[1]) + (x1[2] * x1[2] + x1[3] * x1[3]); \
          ss = dpp_sum16(ss); \
          const float rstd = __builtin_amdgcn_rsqf(ss * (1.0f / 128.0f) + EPS); \
          f32x4 y0, y1; \
          y0[0] = x0[0] * rstd * g0[0] * bflo(ogC.x); y0[1] = x0[1] * rstd * g0[1] * bfhi(ogC.x); y0[2] = x0[2] * rstd * g0[2] * bflo(ogC.y); y0[3] = x0[3] * rstd * g0[3] * bfhi(ogC.y); \
          y1[0] = x1[0] * rstd * g1[0] * bflo(ogC.z); y1[1] = x1[1] * rstd * g1[1] * bfhi(ogC.z); y1[2] = x1[2] * rstd * g1[2] * bflo(ogC.w); y1[3] = x1[3] * rstd * g1[3] * bfhi(ogC.w); \
          *(u32x4*)(Y + row * 2048 + 1536 + ch) = pack8v(y0, y1); } \
        HG_STORE(((c) + 2) % 3, stY, sdY); \
        __syncthreads(); \
    } while (0)
    for (int c = 0; c < 64; c += 2) {
        HG_ITER(c, stA, sdA, stB, sdB, oiA0, oiA1, ogA, oiB0, oiB1, ogB);
        HG_ITER(c + 1, stB, sdB, stA, sdA, oiB0, oiB1, ogB, oiA0, oiA1, ogA);
    }
#undef HG_ITER
#undef HG_PLOAD
#undef HG_LOAD
#undef HG_STORE
}

#define WQ_NEXT(cw) ({ if (threadIdx.x == 0) sh[0] = atomicAdd((cw), 1u); __syncthreads(); const int u_ = (int)sh[0]; __syncthreads(); u_; })
constexpr int INP_MAIN_COLT = 40;
__device__ __forceinline__ void mixer_phase(const Args& a, unsigned char* lds, int L, int mp, int rep) {
    unsigned* ctr = (unsigned*)(a.ws + WS_CTL) + 64 * (L * 4 + mp * 2 + rep);
    volatile unsigned* sh = (volatile unsigned*)(lds + LDS_MISC);
    if (mp == 0) {
        for (;;) { const int u = WQ_NEXT(ctr); if (u >= 2048) break;
            if (u < 1024) hgrn_prep_unit(lds, u >> 6, u & 63, L, a);
            else { const int x = u - 1024; pool_unit(lds, x >> 2, x & 3, L, a); } }
    } else {
        { const int u = WQ_NEXT(ctr); if (u < 16) { hgrn_chain_unit(lds, u, L, a); if (CHAIN_TWICE) { __syncthreads(); hgrn_chain_unit(lds, u, L, a); } } }
        for (;;) { const int x = WQ_NEXT(ctr + 8); if (x >= 32 * (46 - INP_MAIN_COLT)) break;
            pg8::Gemm g{(const bf16_t*)(a.ws + WS_H), (const bf16_t*)(a.ws + WS_W0 + (size_t)L * WL_SIZE + WL_IN), TT, INC, DM, DM, 1, 0, 0, 0, DM / 64, 0, 0};
            pg8::OneUnit S1{x / (46 - INP_MAIN_COLT), INP_MAIN_COLT + x % (46 - INP_MAIN_COLT)};
            EpiIn E{a.ws, 3 * L * TT};
            pg8::gemm_phase((PG8_LAS unsigned char*)lds, g, S1, E); }
        for (;;) { const int x = WQ_NEXT(ctr + 16); if (x >= 512) break;
            attn_unit(lds, (x & 31) >> 3, x & 7, 15 - (x >> 5), a); }
        for (;;) { const int x = WQ_NEXT(ctr + 24); if (x >= 256) break;
            pg8::Gemm g{(const bf16_t*)(a.ws + WS_PB) + (size_t)L * TT * PLE, (const bf16_t*)(a.ws + WS_W0 + (size_t)L * WL_SIZE + WL_PP), TT, DM, PLE, PLE, 1, 0, 0, 0, PLE / 64, 0, 0};
            pg8::OneUnit S1{x >> 3, x & 7};
            EpiBf16 E{a.ws};
            pg8::gemm_phase((PG8_LAS unsigned char*)lds, g, S1, E); }
    }
}

#define LAS __attribute__((address_space(3)))
#define XB_TMO      128
#define XB_XCNT(j)  (256  + 64 * (j))
#define XB_XSUB(j)  (1280 + 64 * (j))
#define XB_XGEN(j)  (2304 + 64 * (j))
#define XB_TOP      3328
#define XB_TOPGEN   3392
#define XCD_BAR_WORDS 3456
#define XB_SPIN_CAP (1u << 20)
__device__ __forceinline__ unsigned xb_ld(unsigned* p)              { return __hip_atomic_load(p, __ATOMIC_RELAXED, __HIP_MEMORY_SCOPE_AGENT); }
__device__ __forceinline__ unsigned xb_add(unsigned* p, unsigned v) { return __hip_atomic_fetch_add(p, v, __ATOMIC_RELAXED, __HIP_MEMORY_SCOPE_AGENT); }
__device__ __forceinline__ unsigned xb_xcc_id() { return (unsigned)__builtin_amdgcn_s_getreg((3 << 11) | 20) & 0xFu; }
#define XB_SPIN(cond, bar) do { unsigned _sp = 0; while (cond) { __builtin_amdgcn_s_sleep(1); \
    if ((++_sp & 255u) == 0u) { if (xb_ld(&(bar)[XB_TMO])) break; if (_sp > XB_SPIN_CAP) { atomicAdd(&(bar)[XB_TMO], 1u); break; } } } } while (0)
struct XcdBarrier { unsigned* bar; unsigned x; volatile LAS unsigned* st; };
__device__ __forceinline__ XcdBarrier xcd_barrier_post(unsigned* bar, volatile LAS unsigned* st) {
    XcdBarrier b; b.bar = bar; b.x = xb_xcc_id(); b.st = st;
    if (threadIdx.x == 0) (void)xb_add(&bar[XB_XCNT(b.x)], 1u);
    return b;
}
__device__ __forceinline__ void xcd_barrier_complete(unsigned* bar, unsigned x, unsigned& nloc, unsigned& nx) {
    const unsigned G = gridDim.x * gridDim.y * gridDim.z;
    unsigned sum, cnt, mine, sp = 0u;
    for (;;) {
        sum = 0u; cnt = 0u; mine = 0u;
#pragma nounroll
        for (unsigned j = 0; j < 16; ++j) { const unsigned c = xb_ld(&bar[XB_XCNT(j)]); sum += c; cnt += (c > 0u) ? 1u : 0u; mine = (j == x) ? c : mine; }
        if (sum == G) break;
        __builtin_amdgcn_s_sleep(1);
        if ((++sp & 255u) == 0u) { if (xb_ld(&bar[XB_TMO])) break; if (sp > XB_SPIN_CAP) { atomicAdd(&bar[XB_TMO], 1u); break; } }
    }
    nloc = mine > 0u ? mine : 1u; nx = cnt > 0u ? cnt : 1u;
}
__device__ __forceinline__ void xcd_barrier(const XcdBarrier& b) {
    asm volatile("s_waitcnt vmcnt(0)" ::: "memory");
    __syncthreads();
    if (threadIdx.x == 0) {
        unsigned* bar = b.bar; asm volatile("" : "+s"(bar));
        __builtin_amdgcn_s_waitcnt(0);
        unsigned nloc = b.st[0], nx = b.st[1];
        if (nloc == 0u) { xcd_barrier_complete(bar, b.x, nloc, nx); b.st[0] = nloc; b.st[1] = nx; }
        const unsigned old = xb_add(&bar[XB_XSUB(b.x)], 1u);
        const unsigned gen = old / nloc;
        if (old + 1u == (gen + 1u) * nloc) {
            __builtin_amdgcn_fence(__ATOMIC_RELEASE, "agent");
            asm volatile("s_waitcnt vmcnt(0)" ::: "memory");
            const unsigned og = xb_add(&bar[XB_TOP], 1u);
            const unsigned tg = og / nx;
            if (og + 1u == (tg + 1u) * nx) xb_add(&bar[XB_TOPGEN], 1u);
            else XB_SPIN(xb_ld(&bar[XB_TOPGEN]) == tg, bar);
            __builtin_amdgcn_fence(__ATOMIC_ACQUIRE, "agent");
            xb_add(&bar[XB_XGEN(b.x)], 1u);
            asm volatile("s_waitcnt vmcnt(0)" ::: "memory");
        } else {
            XB_SPIN(xb_ld(&bar[XB_XGEN(b.x)]) == gen, bar);
            __builtin_amdgcn_fence(__ATOMIC_ACQUIRE, "agent");
            asm volatile("s_waitcnt vmcnt(0)" ::: "memory");
        }
    }
    __syncthreads();
}

typedef const Args __attribute__((address_space(4)))* KArgP;
#define LOAD_ARGS KArgP ap = (KArgP)__builtin_amdgcn_kernarg_segment_ptr(); asm volatile("" : "+s"(ap)); Args A; \
    _Pragma("unroll") for (int i_ = 0; i_ < 19; ++i_) A.in[i_] = ap->in[i_]; A.out = ap->out; A.ws = ap->ws; A.ph_lo = 0; A.ph_hi = 0;
__global__ void __launch_bounds__(512, 2) mega(Args a) {
    extern __shared__ __attribute__((aligned(16))) unsigned char lds[];
    cg::grid_group grid = cg::this_grid();
    PG8_LAS unsigned char* lds3 = (PG8_LAS unsigned char*)lds;
    const int G = gridDim.x, bx = blockIdx.x;
    if (threadIdx.x == 0) { ((volatile LAS unsigned*)((LAS unsigned char*)lds + LDS_MISC))[8] = 0u; ((volatile LAS unsigned*)((LAS unsigned char*)lds + LDS_MISC))[9] = 0u; }
    __syncthreads();
    XcdBarrier xbar = xcd_barrier_post((unsigned*)(a.ws + WS_CTL) + 1024, (volatile LAS unsigned*)((LAS unsigned char*)lds + LDS_MISC) + 8);
    constexpr int ph_hi_ = NPHASE;
#pragma nounroll
    for (int ph = 0; ph < ph_hi_; ++ph) {
      const int nrep = 1 + ((ph == 0 ? (REP_MASK >> 15) : (ph == NPHASE - 1 ? 0 : (REP_MASK >> ((ph - 1) % PPL)))) & 1);
      for (int rep = 0; rep < nrep; ++rep) {
        if (ph == 0) { if (PHMASK & 0x8000) { LOAD_ARGS prologue_phase(A, lds); } }
        else if (ph == NPHASE - 1) { if (PHMASK & 0x4000) { LOAD_ARGS final_norm_rows((const bf16_t*)(A.ws + WS_H), (const float*)(A.ws + WS_X) + (size_t)(3 * NLAYER) * TT * 8, A.in[18], A.out); } }
        else {
            const int L = (ph - 1) / PPL, s = (ph - 1) % PPL;
            if (s == 0) { if (PHMASK & (1 << 0)) {
                LOAD_ARGS unsigned char* wl = A.ws + WS_W0 + (size_t)L * WL_SIZE;
                pg8::Gemm g{(const bf16_t*)(A.ws + WS_H), (const bf16_t*)(wl + WL_IN), TT, INC, DM, DM, 1, 0, 0, 0, DM / 64, 0, 0};
                pg8::StaticOrder S; S.init(TT, INP_MAIN_COLT * 256, G, bx, 1);
                EpiIn E{A.ws, 3 * L * TT};
                pg8::gemm_phase(lds3, g, S, E);
            }} else if (s == 1) { if (PHMASK & (1 << 1)) {
                LOAD_ARGS mixer_phase(A, lds, L, 0, rep);
            }} else if (s == 2) { if (PHMASK & (1 << 2)) {
                LOAD_ARGS mixer_phase(A, lds, L, 1, rep);
            }} else if (s == 3) { if (PHMASK & (1 << 3)) {
                LOAD_ARGS unsigned char* wl = A.ws + WS_W0 + (size_t)L * WL_SIZE;
                pg8::Gemm g{(const bf16_t*)(A.ws + WS_Y), (const bf16_t*)(wl + WL_BR), TT, DM, DM, DM, 3, 0, 512, 1536, 8, 16, 8};
                pg8::StaticOrder S; S.init(TT, DM, G, bx, 3);
                EpiBranch E{A.ws};
                pg8::gemm_phase(lds3, g, S, E);
            }} else if (s == 4) { if (PHMASK & (1 << 4)) {
                LOAD_ARGS unsigned char* wl = A.ws + WS_W0 + (size_t)L * WL_SIZE;
                pg8::Gemm g{(const bf16_t*)(A.ws + WS_MIX), (const bf16_t*)(wl + WL_OUT), TT, DM, DM, DM, 1, 0, 0, 0, DM / 64, 0, 0};
                pg8::StaticOrder S; S.init(TT, DM, G, bx, 1);
                EpiResid E{A.ws, 0, 0, (3 * L + 1) * TT};
                pg8::gemm_phase(lds3, g, S, E);
            }} else if (s == 5) { if (PHMASK & (1 << 5)) {
                LOAD_ARGS unsigned char* wl = A.ws + WS_W0 + (size_t)L * WL_SIZE;
                pg8::Gemm g{(const bf16_t*)(A.ws + WS_H), (const bf16_t*)(wl + WL_GU), TT, 2 * DFF, DM, DM, 1, 0, 0, 0, DM / 64, 0, 0};
                pg8::StaticOrder S; S.init(TT, 2 * DFF, G, bx, 1);
                EpiSwiglu E{A.ws, (3 * L + 1) * TT};
                pg8::gemm_phase(lds3, g, S, E);
            }} else if (s == 6) { if (PHMASK & (1 << 6)) {
                LOAD_ARGS unsigned char* wl = A.ws + WS_W0 + (size_t)L * WL_SIZE;
                pg8::Gemm g{(const bf16_t*)(A.ws + WS_ACT), (const bf16_t*)(wl + WL_DN), TT, DM, DFF, DFF, 1, 0, 0, 0, DFF / 64, 0, 0};
                pg8::StaticOrder S; S.init(TT, DM, G, bx, 1);
                EpiResid E{A.ws, 0, (int)(WS_HB - WS_H), (3 * L + 2) * TT};
                pg8::gemm_phase(lds3, g, S, E);
            }} else { if (PHMASK & (1 << 7)) {
                LOAD_ARGS unsigned char* wl = A.ws + WS_W0 + (size_t)L * WL_SIZE;
                pg8::Gemm g{(const bf16_t*)(A.ws + WS_HB), (const bf16_t*)(wl + WL_PG), TT, DM, DM, DM, 1, 0, 0, 0, DM / 64, 0, 0};
                pg8::StaticOrder S; S.init(TT, DM, G, bx, 1);
                EpiPle E{A.ws, (3 * L + 2) * TT};
                pg8::gemm_phase(lds3, g, S, E);
            }}
        }
        if (ph + 1 < ph_hi_ || rep + 1 < nrep) { if (ph == 0) grid.sync(); else xcd_barrier(xbar); }
      }
    }
    for (int i = 0; i < EXTRA_SYNCS; ++i) xcd_barrier(xbar);
}

extern "C" void kernel_launch(void* const* d_in, const int* in_sizes, int n_in, void* d_out, int out_size, void* d_ws, size_t ws_size, hipStream_t stream) {
    static int grid = 0;
    if (grid == 0) {
        if (n_in != 19 || out_size != TT * DM || ws_size < WS_END) { fprintf(stderr, "kernel_launch: unexpected problem (n_in %d out %d ws %zu need %zu)\n", n_in, out_size, ws_size, (size_t)WS_END); grid = -1; return; }
        int dev = 0, cus = 0, per_cu = 0;
        hipGetDevice(&dev); hipDeviceGetAttribute(&cus, hipDeviceAttributeMultiprocessorCount, dev);
        if (hipFuncSetAttribute((const void*)mega, hipFuncAttributeMaxDynamicSharedMemorySize, LDS_BYTES) != hipSuccess) { fprintf(stderr, "kernel_launch: hipFuncSetAttribute failed\n"); grid = -1; return; }
        if (hipOccupancyMaxActiveBlocksPerMultiprocessor(&per_cu, (const void*)mega, 512, LDS_BYTES) != hipSuccess || per_cu < 1) { fprintf(stderr, "kernel_launch: occupancy query gave %d\n", per_cu); per_cu = 1; }
        (void)hipGetLastError();
        grid = cus * per_cu;
        fprintf(stderr, "kernel_launch: grid %d (cus %d x %d)\n", grid, cus, per_cu);
    }
    if (grid < 0) return;
    (void)hipMemsetAsync((char*)d_ws + WS_CTL, 0, CTL_ZERO, stream);
    Args a{};
    for (int i = 0; i < 19; ++i) a.in[i] = (const float*)d_in[i];
    a.out = (float*)d_out; a.ws = (unsigned char*)d_ws;
#if MK_MULTI
    for (int ph = 0; ph < NPHASE; ++ph) { a.ph_lo = ph; a.ph_hi = ph + 1; hipLaunchKernelGGL(mega, dim3(grid), dim3(512), LDS_BYTES, stream, a); }
#else
    a.ph_lo = 0; a.ph_hi = NPHASE;
    void* args[] = {&a};
    hipError_t e = hipLaunchCooperativeKernel((const void*)mega, dim3(grid), dim3(512), args, LDS_BYTES, stream);
    if (e != hipSuccess) fprintf(stderr, "kernel_launch: cooperative launch failed: %s (grid %d)\n", hipGetErrorString(e), grid);
#endif
}
```

```cpp
#include <hip/hip_runtime.h>
#include <hip/hip_cooperative_groups.h>
#include <cstdio>
#include <cstdint>
namespace cg = cooperative_groups;

#ifndef PHMASK
#define PHMASK 0xFFFF
#endif
#ifndef REP_MASK
#define REP_MASK 0
#endif
#ifndef EXTRA_SYNCS
#define EXTRA_SYNCS 0
#endif
#ifndef CHAIN_TWICE
#define CHAIN_TWICE 0
#endif
#ifndef MK_MULTI
#define MK_MULTI 0
#endif

typedef unsigned short bf16_t;
typedef short bf16x8 __attribute__((ext_vector_type(8)));
typedef short s16x4 __attribute__((ext_vector_type(4)));
typedef float f32x4 __attribute__((ext_vector_type(4)));
typedef float f32x16 __attribute__((ext_vector_type(16)));
typedef unsigned u32x4 __attribute__((ext_vector_type(4)));
typedef unsigned u32x2 __attribute__((ext_vector_type(2)));

constexpr int TT = 8192, DM = 2048, SEQ = 2048, INC = 11776, DFF = 5632, PLE = 256, NLAYER = 2;
constexpr float EPS = 1e-6f;

typedef float f32x2_t __attribute__((ext_vector_type(2))); typedef __bf16 bf16x2_t __attribute__((ext_vector_type(2)));
__device__ __forceinline__ unsigned cvt_pk_bf16(float lo, float hi) { const f32x2_t v = {lo, hi}; const bf16x2_t b = __builtin_convertvector(v, bf16x2_t); return __builtin_bit_cast(unsigned, b); }
__device__ __forceinline__ float bf2f(unsigned short b) { return __uint_as_float(((unsigned)b) << 16); }
__device__ __forceinline__ float bflo(unsigned w) { return __uint_as_float(w << 16); }
__device__ __forceinline__ float bfhi(unsigned w) { return __uint_as_float(w & 0xffff0000u); }
__device__ __forceinline__ float sigmoidf_(float x) { return __builtin_amdgcn_rcpf(1.0f + __builtin_amdgcn_exp2f(x * -1.4426950408889634f)); }
__device__ __forceinline__ bf16x8 pack8(float a0, float a1, float a2, float a3, float a4, float a5, float a6, float a7) {
    u32x4 w; w.x = cvt_pk_bf16(a0, a1); w.y = cvt_pk_bf16(a2, a3); w.z = cvt_pk_bf16(a4, a5); w.w = cvt_pk_bf16(a6, a7);
    return __builtin_bit_cast(bf16x8, w);
}
__device__ __forceinline__ int crow(int r, int hi) { return (r & 3) + 8 * (r >> 2) + 4 * hi; }
__device__ __forceinline__ int opaque_tid() { int t = threadIdx.x; asm volatile("" : "+v"(t)); return t; }
__device__ __forceinline__ float shflx(float v, int m, int lane) { return __int_as_float(__builtin_amdgcn_ds_bpermute((lane ^ m) << 2, __float_as_int(v))); }
#define MFMA32(a, b, c) __builtin_amdgcn_mfma_f32_32x32x16_bf16((a), (b), (c), 0, 0, 0)

namespace pg8 {
#define PG8_LAS __attribute__((address_space(3)))
constexpr int BM = 256, BK = 64, HALF = 128, HTB = HALF * BK * 2, STAGE_BYTES = 8 * HTB, NXCD = 8, WGM = 8;
__host__ __device__ __forceinline__ int lds_byte(int r, int c) { const int st = (r >> 4) * 2 + (c >> 5), rr = r & 15, cc = c & 31, ob = rr * 64 + cc * 2; return st * 1024 + (ob ^ (((ob >> 9) & 1) << 5)); }
__host__ __device__ __forceinline__ void stage_rc(int b, int& R, int& C) { const int st = b / 1024, sb = b % 1024, swz = sb ^ (((sb >> 9) & 1) << 5); R = (st >> 1) * 16 + swz / 64; C = (st & 1) * 32 + (swz % 64) / 2; }
__host__ __device__ __forceinline__ int perm32(int rho) { const int n = rho >> 4, i = rho & 15; return 8 * (i >> 2) + 4 * n + (i & 3); }

struct Unit { int pm, pn, kind; };
struct Gemm { const bf16_t* A; const bf16_t* Bt; int M, N, lda, ldb; int nseg; int kofs0, kofs1, kofs2; int nt0, nt1, nt2; };

struct StaticOrder {
    int nM, nN, nwg, G, c, nseg;
    __device__ void init(int M, int N, int G_, int c_, int nseg_) { nM = M / BM; nN = N / BM; nwg = nM * nN; G = G_; c = c_; nseg = nseg_; }
    __device__ bool next(int i, Unit& u) const {
        int j = i, kd = 0; if (nseg == 3) { j = i / 3; kd = i - 3 * j; }
        u.kind = kd;
        const long L = (long)j * G + c; if (L >= nwg) return false;
        int wgid = (int)L; { const int q = nwg / NXCD, r = nwg % NXCD, xcd = wgid % NXCD, off = wgid / NXCD; wgid = (xcd < r ? xcd * (q + 1) : r * (q + 1) + (xcd - r) * q) + off; }
        const int nig = WGM * nN, gid = wgid / nig, fm = gid * WGM, gsz = (nM - fm) < WGM ? (nM - fm) : WGM;
        u.pm = fm + ((wgid % nig) % gsz); u.pn = (wgid % nig) / gsz; return true;
    }
};

struct OneUnit { int pm, pn; __device__ bool next(int i, Unit& u) const { u.pm = pm; u.pn = pn; u.kind = 0; return i == 0; } };
template <class Epi, class Sched>
__device__ __forceinline__ void gemm_phase(PG8_LAS unsigned char* lds, const Gemm g, const Sched& S, const Epi& E) {
    const int tid = opaque_tid(), wid = __builtin_amdgcn_readfirstlane(tid >> 6), lane = tid & 63, wr = wid >> 2, wc = wid & 3, fr = lane & 15, fq = lane >> 4;
    unsigned voffA, voffB;
    { int R, C; stage_rc(tid * 16, R, C); const int Rb = (R & ~31) + perm32(R & 31);
      voffA = (unsigned)(R * g.lda + C) * 2u; voffB = (unsigned)(Rb * g.ldb + C) * 2u; }
    const size_t qstepoffA = (size_t)64 * g.lda * 2, qstepoffB = (size_t)64 * g.ldb * 2;
    const size_t kstep = (size_t)(BK * 2);
    const size_t hstepA = (size_t)HALF * g.lda * 2, hstepB = (size_t)HALF * g.ldb * 2;
    const size_t tstepA = 2 * hstepA, tstepB = 2 * hstepB;
    const unsigned ldsw = (unsigned)wid * 1024u;
    const int aoff = lds_byte(wr * 64 + fr, fq * 8), boff = lds_byte(wc * 32 + fr, fq * 8);
#define PG8_SA(b, h) (((b) * 2 + (h)) * HTB)
#define PG8_SB(b, h) ((4 + (b) * 2 + (h)) * HTB)
#define PG8_STAGE(bufoff, gbase, voff) do { _Pragma("unroll") for (int _i = 0; _i < 2; ++_i) \
        __builtin_amdgcn_global_load_lds((const unsigned*)((const char*)(gbase) + (size_t)_i * qstep##voff + v##voff), (PG8_LAS unsigned*)(lds + (bufoff) + ldsw + _i * 8192), 16, 0, 0); } while (0)
#define PG8_LDA(dst, b, h) do { _Pragma("unroll") for (int m = 0; m < 4; ++m) _Pragma("unroll") for (int k = 0; k < 2; ++k) dst[m][k] = *(const PG8_LAS bf16x8*)(lds + PG8_SA(b, h) + aoff + m * 2048 + k * 1024); } while (0)
#define PG8_LDB(dst, b, h) do { _Pragma("unroll") for (int n = 0; n < 2; ++n) _Pragma("unroll") for (int k = 0; k < 2; ++k) dst[n][k] = *(const PG8_LAS bf16x8*)(lds + PG8_SB(b, h) + boff + n * 2048 + k * 1024); } while (0)
#define PG8_MMA(ai, bj, At, Bt) do { __builtin_amdgcn_s_setprio(1); _Pragma("unroll") for (int m = 0; m < 4; ++m) _Pragma("unroll") for (int n = 0; n < 2; ++n) _Pragma("unroll") for (int k = 0; k < 2; ++k) \
        acc[ai][bj][m][n] = __builtin_amdgcn_mfma_f32_16x16x32_bf16(Bt[n][k], At[m][k], acc[ai][bj][m][n], 0, 0, 0); __builtin_amdgcn_s_setprio(0); } while (0)
#define PG8_WAIT_V(n) asm volatile("s_waitcnt vmcnt(" #n ")" ::: "memory")
#define PG8_WAIT_L(n) asm volatile("s_waitcnt lgkmcnt(" #n ")" ::: "memory")
#define PG8_BAR __builtin_amdgcn_s_barrier()
#define PG8_SCHED __builtin_amdgcn_sched_barrier(0)
#define PG8_KOFS(u) ((u).kind == 0 ? g.kofs0 : ((u).kind == 1 ? g.kofs1 : g.kofs2))
#define PG8_NT(u) ((u).kind == 0 ? g.nt0 : ((u).kind == 1 ? g.nt1 : g.nt2))
    Unit cur, nxt; int ui = 0;
    if (!S.next(0, cur)) return;
    f32x4 acc[2][2][4][2];
#pragma unroll
    for (int a = 0; a < 2; ++a)
#pragma unroll
        for (int b = 0; b < 2; ++b)
#pragma unroll
            for (int m = 0; m < 4; ++m)
#pragma unroll
                for (int n = 0; n < 2; ++n) acc[a][b][m][n] = (f32x4){0.f, 0.f, 0.f, 0.f};
    bf16x8 At[4][2], B0[2][2], B1[2][2];
    const char* cA = (const char*)g.A + (size_t)cur.pm * tstepA + (size_t)PG8_KOFS(cur) * 2; const char* cB = (const char*)g.Bt + (size_t)cur.pn * tstepB + (size_t)PG8_KOFS(cur) * 2;
    PG8_STAGE(PG8_SB(0, 0), cB, offB); PG8_STAGE(PG8_SB(0, 1), cB + hstepB, offB); PG8_STAGE(PG8_SA(0, 0), cA, offA); PG8_STAGE(PG8_SA(0, 1), cA + hstepA, offA);
    if (wr == 1) PG8_BAR;
    PG8_WAIT_V(2); PG8_BAR;
    PG8_STAGE(PG8_SB(1, 0), cB + kstep, offB); PG8_STAGE(PG8_SA(1, 0), cA + kstep, offA); PG8_STAGE(PG8_SB(1, 1), cB + hstepB + kstep, offB);
    PG8_WAIT_V(6); PG8_BAR;
    for (;;) {
        const bool has_next = S.next(ui + 1, nxt);
        const char* nA = has_next ? (const char*)g.A + (size_t)nxt.pm * tstepA + (size_t)PG8_KOFS(nxt) * 2 : cA;
        const char* nB = has_next ? (const char*)g.Bt + (size_t)nxt.pn * tstepB + (size_t)PG8_KOFS(nxt) * 2 : cB;
        const int nt = PG8_NT(cur);
        for (int t = 0; t < nt; t += 2) {
            const bool last = (t == nt - 2);
            const char* a1 = cA + (size_t)(t + 1) * kstep;
            const char* a2 = last ? nA : cA + (size_t)(t + 2) * kstep; const char* b2 = last ? nB : cB + (size_t)(t + 2) * kstep;
            const char* a3 = a2 + kstep; const char* b3 = b2 + kstep;
            PG8_LDB(B0, 0, 0); PG8_LDB(B1, 0, 1); PG8_SCHED; PG8_LDA(At, 0, 0); PG8_STAGE(PG8_SA(1, 1), a1 + hstepA, offA);
            PG8_WAIT_V(8); PG8_WAIT_L(0); PG8_BAR; PG8_MMA(0, 0, At, B0); PG8_MMA(0, 1, At, B1); PG8_BAR; PG8_SCHED;
            PG8_LDA(At, 0, 1); PG8_STAGE(PG8_SB(0, 0), b2, offB); PG8_STAGE(PG8_SB(0, 1), b2 + hstepB, offB); PG8_STAGE(PG8_SA(0, 0), a2, offA);
            PG8_WAIT_V(8); PG8_WAIT_L(0); PG8_BAR; PG8_MMA(1, 0, At, B0); PG8_MMA(1, 1, At, B1); PG8_BAR; PG8_SCHED;
            PG8_LDB(B0, 1, 0); PG8_LDB(B1, 1, 1); PG8_SCHED; PG8_LDA(At, 1, 0); PG8_STAGE(PG8_SA(0, 1), a2 + hstepA, offA);
            PG8_WAIT_V(8); PG8_WAIT_L(0); PG8_BAR; PG8_MMA(0, 0, At, B0); PG8_MMA(0, 1, At, B1); PG8_BAR; PG8_SCHED;
            PG8_LDA(At, 1, 1); PG8_STAGE(PG8_SB(1, 0), b3, offB); PG8_STAGE(PG8_SB(1, 1), b3 + hstepB, offB); PG8_STAGE(PG8_SA(1, 0), a3, offA);
            PG8_WAIT_V(8); PG8_WAIT_L(0); PG8_BAR; PG8_MMA(1, 0, At, B0); PG8_MMA(1, 1, At, B1); PG8_BAR; PG8_SCHED;
        }
        if (wr == 0) PG8_BAR;
        const bool keep = E(acc, cur, wr, wc, fr, fq);
        if (!has_next) break;
        if (!keep) {
#pragma unroll
        for (int a = 0; a < 2; ++a)
#pragma unroll
            for (int b = 0; b < 2; ++b)
#pragma unroll
                for (int m = 0; m < 4; ++m)
#pragma unroll
                    for (int n = 0; n < 2; ++n) acc[a][b][m][n] = (f32x4){0.f, 0.f, 0.f, 0.f};
        }
        cur = nxt; cA = nA; cB = nB; ++ui;
        if (wr == 1) PG8_BAR;
    }
    PG8_WAIT_V(0);
    PG8_BAR;
#undef PG8_SA
#undef PG8_SB
#undef PG8_STAGE
#undef PG8_LDA
#undef PG8_LDB
#undef PG8_MMA
#undef PG8_WAIT_V
#undef PG8_WAIT_L
#undef PG8_BAR
#undef PG8_SCHED
#undef PG8_KOFS
#undef PG8_NT
}
}

constexpr size_t MiB = 1u << 20;
constexpr size_t WS_CTL = 0;
constexpr size_t WS_W0 = 1 * MiB;
constexpr size_t WL_IN = 0, WL_BR = 46 * MiB, WL_OUT = 54 * MiB, WL_GU = 62 * MiB, WL_DN = 106 * MiB, WL_PG = 128 * MiB, WL_PP = 136 * MiB, WL_SIZE = 137 * MiB;
constexpr size_t WS_H = WS_W0 + 2 * WL_SIZE;
constexpr size_t WS_X = WS_H + 32 * MiB;
constexpr size_t WS_U = WS_X + 64 * MiB;
constexpr size_t WS_SQ = WS_U + 16 * MiB;
constexpr size_t WS_SK = WS_SQ + 16 * MiB;
constexpr size_t WS_VT = WS_SK + 16 * MiB;
constexpr size_t WS_ZF = WS_VT + 16 * MiB;
constexpr size_t WS_HV = WS_ZF + 16 * MiB;
constexpr size_t WS_HQ = WS_HV + 8 * MiB;
constexpr size_t WS_OG = WS_HQ + 16 * MiB;
constexpr size_t WS_GT = WS_OG + 8 * MiB;
constexpr size_t WS_ACT = WS_GT;
constexpr size_t WS_Y = WS_GT + 96 * MiB;
constexpr size_t WS_MIX = WS_Y + 32 * MiB;
constexpr size_t WS_PB = WS_MIX + 32 * MiB;
constexpr size_t WS_HVT = WS_PB + 8 * MiB;
constexpr size_t WS_HDEC = WS_HVT + 8 * MiB;
constexpr size_t WS_HB = WS_HDEC + 1 * MiB;
constexpr size_t WS_PPB = WS_HB + 32 * MiB;
constexpr size_t WS_END = WS_PPB + 32 * MiB;
constexpr size_t WS_HOI = WS_MIX;
constexpr size_t WS_HQD = WS_MIX + 16 * MiB;
constexpr size_t WS_HKD = WS_MIX + 24 * MiB;
constexpr size_t CTL_SS = 65536;
constexpr size_t CTL_ZERO = CTL_SS + 7 * TT * 4;

constexpr int LDS_PSUM_OFF = 132096;
typedef f32x4 AccT[2][2][4][2];
#define EPI_LOOP_BEGIN  const int row0_ = u.pm * 256 + wr * 64 + fr; \
    _Pragma("unroll") for (int ai = 0; ai < 2; ++ai) _Pragma("unroll") for (int m = 0; m < 4; ++m) { const int row = row0_ + ai * 128 + m * 16; \
    _Pragma("unroll") for (int bj = 0; bj < 2; ++bj) { const int col = u.pn * 256 + bj * 128 + wc * 32 + 8 * fq; f32x4 v0 = acc[ai][bj][m][0], v1 = acc[ai][bj][m][1];
#define EPI_LOOP_END }}
__device__ __forceinline__ float rstd_of(float ss) { return __builtin_amdgcn_rsqf(ss * (1.0f / DM) + EPS); }
__device__ __forceinline__ float rstd_row(const float* SSP, int row) { const f32x4 a = *(const f32x4*)(SSP + (size_t)row * 8), b = *(const f32x4*)(SSP + (size_t)row * 8 + 4);
    return rstd_of(((a[0] + a[1]) + (a[2] + a[3])) + ((b[0] + b[1]) + (b[2] + b[3]))); }
__device__ __forceinline__ void ps_write(int rit, int wc, float sq) {
    extern __shared__ __attribute__((aligned(16))) unsigned char lds_e_[];
    ((float*)(lds_e_ + LDS_PSUM_OFF))[rit * 4 + wc] = sq;
}
__device__ __forceinline__ void ps_finish(float* SSP, const pg8::Unit& u, int wr, int wc, int fr, int fq) {
    extern __shared__ __attribute__((aligned(16))) unsigned char lds_e_[];
    const float* PS = (const float*)(lds_e_ + LDS_PSUM_OFF);
    asm volatile("s_waitcnt lgkmcnt(0)" ::: "memory"); __builtin_amdgcn_s_barrier(); asm volatile("" ::: "memory");
    const int t_ = (wr * 4 + wc) * 64 + fq * 16 + fr;
    if (t_ < 256) { const f32x4 p = *(const f32x4*)(PS + t_ * 4); SSP[(size_t)(u.pm * 256 + t_) * 8 + u.pn] = (p[0] + p[1]) + (p[2] + p[3]); }
}
#define EPI_LOOP_BEGIN_R(SSP)  const int row0_ = u.pm * 256 + wr * 64 + fr; \
    _Pragma("unroll") for (int ai = 0; ai < 2; ++ai) _Pragma("unroll") for (int m = 0; m < 4; ++m) { const int row = row0_ + ai * 128 + m * 16; const float rs_ = rstd_row((SSP), row); \
    _Pragma("unroll") for (int bj = 0; bj < 2; ++bj) { const int col = u.pn * 256 + bj * 128 + wc * 32 + 8 * fq; f32x4 v0 = acc[ai][bj][m][0] * rs_, v1 = acc[ai][bj][m][1] * rs_;

__device__ __forceinline__ u32x4 pack8v(f32x4 v0, f32x4 v1) { u32x4 w; w.x = cvt_pk_bf16(v0[0], v0[1]); w.y = cvt_pk_bf16(v0[2], v0[3]); w.z = cvt_pk_bf16(v1[0], v1[1]); w.w = cvt_pk_bf16(v1[2], v1[3]); return w; }

struct EpiIn {
    unsigned char* ws; int ssofs;
    __device__ __forceinline__ bool operator()(AccT& acc, const pg8::Unit& u, int wr, int wc, int fr, int fq) const {
        float* U = (float*)(ws + WS_U); bf16_t* SQ = (bf16_t*)(ws + WS_SQ); bf16_t* SK = (bf16_t*)(ws + WS_SK); bf16_t* VT = (bf16_t*)(ws + WS_VT); float* ZF = (float*)(ws + WS_ZF);
        bf16_t* HV = (bf16_t*)(ws + WS_HV); float* HQ = (float*)(ws + WS_HQ); bf16_t* OG = (bf16_t*)(ws + WS_OG); bf16_t* GT = (bf16_t*)(ws + WS_GT);
        const float* SS = (const float*)(ws + WS_X) + (size_t)ssofs * 8; const float qscale = 0.08838834764831845f * 1.4426950408889634f;
        const int colt = u.pn * 256;
        if (colt < 512) {
            EPI_LOOP_BEGIN_R(SS) float* p = U + (size_t)row * 512 + col; *(f32x4*)p = v0; *(f32x4*)(p + 4) = v1; EPI_LOOP_END
        } else if (colt < 1536) {
            const float s = qscale;
            EPI_LOOP_BEGIN_R(SS) *(u32x4*)(SQ + (size_t)row * 1024 + (col - 512)) = pack8v(v0 * s, v1 * s); EPI_LOOP_END
        } else if (colt < 2560) {
            EPI_LOOP_BEGIN_R(SS) *(u32x4*)(SK + (size_t)row * 1024 + (col - 1536)) = pack8v(v0, v1); EPI_LOOP_END
        } else if (colt < 3584) {
            EPI_LOOP_BEGIN_R(SS) const int cc = col - 2560, hh = cc >> 7, d = cc & 127, b = row >> 11, s = row & 2047;
                bf16_t* p = VT + (((size_t)(b * 8 + hh) * 128 + d) << 11) + s; const u32x4 w = pack8v(v0, v1);
                p[0] = (bf16_t)(w.x & 0xffff); p[2048] = (bf16_t)(w.x >> 16); p[2 * 2048] = (bf16_t)(w.y & 0xffff); p[3 * 2048] = (bf16_t)(w.y >> 16);
                p[4 * 2048] = (bf16_t)(w.z & 0xffff); p[5 * 2048] = (bf16_t)(w.z >> 16); p[6 * 2048] = (bf16_t)(w.w & 0xffff); p[7 * 2048] = (bf16_t)(w.w >> 16); EPI_LOOP_END
        } else if (colt < 4096) {
            EPI_LOOP_BEGIN_R(SS) float* p = ZF + (size_t)row * 512 + (col - 3584); *(f32x4*)p = v0; *(f32x4*)(p + 4) = v1; EPI_LOOP_END
        } else if (colt < 4608) {
            EPI_LOOP_BEGIN_R(SS) *(u32x4*)(HV + (size_t)row * 512 + (col - 4096)) = pack8v(v0, v1); EPI_LOOP_END
        } else if (colt < 5120) {
            EPI_LOOP_BEGIN_R(SS)
#pragma unroll
                for (int j = 0; j < 4; ++j) { v0[j] = v0[j] * sigmoidf_(v0[j]); v1[j] = v1[j] * sigmoidf_(v1[j]); }
                float* p = HQ + (size_t)row * 512 + (col - 4608); *(f32x4*)p = v0; *(f32x4*)(p + 4) = v1; EPI_LOOP_END
        } else if (colt < 5632) {
            EPI_LOOP_BEGIN_R(SS)
#pragma unroll
                for (int j = 0; j < 4; ++j) { v0[j] = v0[j] * sigmoidf_(v0[j]); v1[j] = v1[j] * sigmoidf_(v1[j]); }
                *(u32x4*)(OG + (size_t)row * 512 + (col - 5120)) = pack8v(v0, v1); EPI_LOOP_END
        } else {
            EPI_LOOP_BEGIN_R(SS)
#pragma unroll
                for (int j = 0; j < 4; ++j) { v0[j] = sigmoidf_(v0[j]); v1[j] = sigmoidf_(v1[j]); }
                *(u32x4*)(GT + (size_t)row * 6144 + (col - 5632)) = pack8v(v0, v1); EPI_LOOP_END
        }
        return false;
    }
};
struct EpiBranch {
    unsigned char* ws;
    __device__ __forceinline__ bool operator()(AccT& acc, const pg8::Unit& u, int wr, int wc, int fr, int fq) const {
        const bf16_t* GT = (const bf16_t*)(ws + WS_GT); bf16_t* MIX = (bf16_t*)(ws + WS_MIX);
        const int kind = u.kind;
        const int row0_ = u.pm * 256 + wr * 64 + fr;
#pragma unroll
        for (int ai = 0; ai < 2; ++ai)
#pragma unroll
            for (int m = 0; m < 4; ++m) { const int row = row0_ + ai * 128 + m * 16;
#pragma unroll
                for (int bj = 0; bj < 2; ++bj) { const int col = u.pn * 256 + bj * 128 + wc * 32 + 8 * fq;
                    const u32x4 ga = *(const u32x4*)(GT + (size_t)row * 6144 + kind * 2048 + col);
                    float a[8] = {bflo(ga.x), bfhi(ga.x), bflo(ga.y), bfhi(ga.y), bflo(ga.z), bfhi(ga.z), bflo(ga.w), bfhi(ga.w)};
#pragma unroll
                    for (int j = 0; j < 8; ++j) a[j] = fmaxf(a[j], 1e-30f);
                    if (kind < 2) {
                        const u32x4 gb = *(const u32x4*)(GT + (size_t)row * 6144 + (kind + 1) * 2048 + col);
                        float b[8] = {bflo(gb.x), bfhi(gb.x), bflo(gb.y), bfhi(gb.y), bflo(gb.z), bfhi(gb.z), bflo(gb.w), bfhi(gb.w)};
#pragma unroll
                        for (int j = 0; j < 8; ++j) { const float rr = a[j] * __builtin_amdgcn_rcpf(fmaxf(b[j], 1e-30f)); if (j < 4) acc[ai][bj][m][0][j] *= rr; else acc[ai][bj][m][1][j - 4] *= rr; }
                    } else {
                        f32x4 v0 = acc[ai][bj][m][0], v1 = acc[ai][bj][m][1];
#pragma unroll
                        for (int j = 0; j < 4; ++j) { v0[j] *= a[j]; v1[j] *= a[j + 4]; }
                        *(u32x4*)(MIX + (size_t)row * 2048 + col) = pack8v(v0, v1);
                    }
                } }
        return kind < 2;
    }
};
struct EpiResid {
    unsigned char* ws; int rboff, xboff, ssofs;
    __device__ __forceinline__ bool operator()(AccT& acc, const pg8::Unit& u, int wr, int wc, int fr, int fq) const {
        const bf16_t* RB = (const bf16_t*)(ws + WS_H + (size_t)rboff); bf16_t* XB = (bf16_t*)(ws + WS_H + (size_t)xboff); float* SSO = (float*)(ws + WS_X) + (size_t)ssofs * 8;
        const int row0_ = u.pm * 256 + wr * 64 + fr;
#pragma unroll
        for (int ai = 0; ai < 2; ++ai)
#pragma unroll
            for (int m = 0; m < 4; ++m) { const int row = row0_ + ai * 128 + m * 16; float sq = 0.f;
#pragma unroll
                for (int bj = 0; bj < 2; ++bj) { const int col = u.pn * 256 + bj * 128 + wc * 32 + 8 * fq; const size_t o = (size_t)row * 2048 + col;
                    const u32x4 rw = *(const u32x4*)(RB + o); f32x4 v0 = acc[ai][bj][m][0], v1 = acc[ai][bj][m][1];
                    v0[0] += bflo(rw.x); v0[1] += bfhi(rw.x); v0[2] += bflo(rw.y); v0[3] += bfhi(rw.y); v1[0] += bflo(rw.z); v1[1] += bfhi(rw.z); v1[2] += bflo(rw.w); v1[3] += bfhi(rw.w);
                    *(u32x4*)(XB + o) = pack8v(v0, v1);
                    sq += (v0[0] * v0[0] + v0[1] * v0[1]) + (v0[2] * v0[2] + v0[3] * v0[3]) + (v1[0] * v1[0] + v1[1] * v1[1]) + (v1[2] * v1[2] + v1[3] * v1[3]); }
                sq += shflx(sq, 16, fr + 16 * fq); sq += shflx(sq, 32, fr + 16 * fq); if (fq == 0) ps_write(ai * 128 + wr * 64 + m * 16 + fr, wc, sq); }
        ps_finish(SSO, u, wr, wc, fr, fq);
        return false;
    }
};
struct EpiSwiglu {
    unsigned char* ws; int ssofs;
    __device__ __forceinline__ bool operator()(AccT& acc, const pg8::Unit& u, int wr, int wc, int fr, int fq) const {
        bf16_t* ACT = (bf16_t*)(ws + WS_ACT); const float* SS = (const float*)(ws + WS_X) + (size_t)ssofs * 8;
        const int row0_ = u.pm * 256 + wr * 64 + fr;
#pragma unroll
        for (int ai = 0; ai < 2; ++ai)
#pragma unroll
            for (int m = 0; m < 4; ++m) { const int row = row0_ + ai * 128 + m * 16; const int col = u.pn * 128 + wc * 32 + 8 * fq; const float rs_ = rstd_row(SS, row);
                f32x4 g0 = acc[ai][0][m][0] * rs_, g1 = acc[ai][0][m][1] * rs_; const f32x4 u0 = acc[ai][1][m][0] * rs_, u1 = acc[ai][1][m][1] * rs_;
#pragma unroll
                for (int j = 0; j < 4; ++j) { g0[j] = g0[j] * sigmoidf_(g0[j]) * u0[j]; g1[j] = g1[j] * sigmoidf_(g1[j]) * u1[j]; }
                *(u32x4*)(ACT + (size_t)row * DFF + col) = pack8v(g0, g1); }
        return false;
    }
};
struct EpiBf16 {
    unsigned char* ws;
    __device__ __forceinline__ bool operator()(AccT& acc, const pg8::Unit& u, int wr, int wc, int fr, int fq) const {
        bf16_t* OUT = (bf16_t*)(ws + WS_PPB);
        EPI_LOOP_BEGIN *(u32x4*)(OUT + (size_t)row * 2048 + col) = pack8v(v0, v1); EPI_LOOP_END
        return false;
    }
};
struct EpiPle {
    unsigned char* ws; int ssofs;
    __device__ __forceinline__ bool operator()(AccT& acc, const pg8::Unit& u, int wr, int wc, int fr, int fq) const {
        const bf16_t* RB = (const bf16_t*)(ws + WS_HB); const bf16_t* PP = (const bf16_t*)(ws + WS_PPB); bf16_t* XB = (bf16_t*)(ws + WS_H);
        const float* SS = (const float*)(ws + WS_X) + (size_t)ssofs * 8; float* SSO = (float*)(ws + WS_X) + (size_t)(ssofs + TT) * 8;
        const int row0_ = u.pm * 256 + wr * 64 + fr;
#pragma unroll
        for (int ai = 0; ai < 2; ++ai)
#pragma unroll
            for (int m = 0; m < 4; ++m) { const int row = row0_ + ai * 128 + m * 16; const float rs_ = rstd_row(SS, row); float sq = 0.f;
#pragma unroll
                for (int bj = 0; bj < 2; ++bj) { const int col = u.pn * 256 + bj * 128 + wc * 32 + 8 * fq; const size_t o = (size_t)row * 2048 + col;
                    const u32x4 rw = *(const u32x4*)(RB + o); const u32x4 pw = *(const u32x4*)(PP + o);
                    f32x4 v0 = acc[ai][bj][m][0] * rs_, v1 = acc[ai][bj][m][1] * rs_;
                    v0[0] = bflo(rw.x) + sigmoidf_(v0[0]) * bflo(pw.x); v0[1] = bfhi(rw.x) + sigmoidf_(v0[1]) * bfhi(pw.x); v0[2] = bflo(rw.y) + sigmoidf_(v0[2]) * bflo(pw.y); v0[3] = bfhi(rw.y) + sigmoidf_(v0[3]) * bfhi(pw.y);
                    v1[0] = bflo(rw.z) + sigmoidf_(v1[0]) * bflo(pw.z); v1[1] = bfhi(rw.z) + sigmoidf_(v1[1]) * bfhi(pw.z); v1[2] = bflo(rw.w) + sigmoidf_(v1[2]) * bflo(pw.w); v1[3] = bfhi(rw.w) + sigmoidf_(v1[3]) * bfhi(pw.w);
                    *(u32x4*)(XB + o) = pack8v(v0, v1);
                    sq += (v0[0] * v0[0] + v0[1] * v0[1]) + (v0[2] * v0[2] + v0[3] * v0[3]) + (v1[0] * v1[0] + v1[1] * v1[1]) + (v1[2] * v1[2] + v1[3] * v1[3]); }
                sq += shflx(sq, 16, fr + 16 * fq); sq += shflx(sq, 32, fr + 16 * fq); if (fq == 0) ps_write(ai * 128 + wr * 64 + m * 16 + fr, wc, sq); }
        ps_finish(SSO, u, wr, wc, fr, fq);
        return false;
    }
};

constexpr int LDS_MISC = 131072, LDS_PSUM = 132096, LDS_BYTES = 132096 + 4096;
constexpr int PPL = 8;
constexpr int NPHASE = 2 + PPL * NLAYER;

struct Args { const float* in[19]; float* out; unsigned char* ws; int ph_lo, ph_hi; };

__device__ __forceinline__ float wave_sum(float v, int lane) {
#pragma unroll
    for (int o = 1; o < 64; o <<= 1) v += shflx(v, o, lane);
    return v;
}
template <bool F32OUT>
__device__ __forceinline__ void rmsnorm_rows(const float* X, const float* G, bf16_t* OB, float* OF) {
    const int tid_ = opaque_tid(); const int lane = tid_ & 63, gw = blockIdx.x * 8 + (tid_ >> 6), ngw = gridDim.x * 8;
    for (int row = gw; row < TT; row += ngw) {
        const f32x4* xr = (const f32x4*)(X + (size_t)row * DM) + lane;
        f32x4 v[8]; float s = 0.f;
#pragma unroll
        for (int j = 0; j < 8; ++j) { v[j] = xr[64 * j]; s += (v[j][0] * v[j][0] + v[j][1] * v[j][1]) + (v[j][2] * v[j][2] + v[j][3] * v[j][3]); }
        const float rstd = 1.0f / sqrtf(wave_sum(s, lane) * (1.0f / DM) + EPS);
#pragma unroll
        for (int j = 0; j < 8; ++j) { const f32x4 gg = ((const f32x4*)G)[lane + 64 * j]; const f32x4 y = v[j] * rstd * gg;
            if (F32OUT) ((f32x4*)(OF + (size_t)row * DM))[lane + 64 * j] = y;
            else { u32x2 w; w.x = cvt_pk_bf16(y[0], y[1]); w.y = cvt_pk_bf16(y[2], y[3]); ((u32x2*)(OB + (size_t)row * DM))[lane + 64 * j] = w; } }
    }
}

__device__ __forceinline__ void final_norm_rows(const bf16_t* XB, const float* SS, const float* G, float* OF) {
    const int tid_ = opaque_tid(); const int lane = tid_ & 63, gw = blockIdx.x * 8 + (tid_ >> 6), ngw = gridDim.x * 8;
    for (int row = gw; row < TT; row += ngw) {
        const float rstd = rstd_row(SS, row);
#pragma unroll
        for (int j = 0; j < 4; ++j) { const u32x4 w = ((const u32x4*)(XB + (size_t)row * DM))[lane + 64 * j];
            const f32x4 ga = ((const f32x4*)G)[2 * (lane + 64 * j)], gb = ((const f32x4*)G)[2 * (lane + 64 * j) + 1];
            f32x4 y0, y1; y0[0] = bflo(w.x) * rstd * ga[0]; y0[1] = bfhi(w.x) * rstd * ga[1]; y0[2] = bflo(w.y) * rstd * ga[2]; y0[3] = bfhi(w.y) * rstd * ga[3];
            y1[0] = bflo(w.z) * rstd * gb[0]; y1[1] = bfhi(w.z) * rstd * gb[1]; y1[2] = bflo(w.w) * rstd * gb[2]; y1[3] = bfhi(w.w) * rstd * gb[3];
            ((f32x4*)(OF + (size_t)row * DM))[2 * (lane + 64 * j)] = y0; ((f32x4*)(OF + (size_t)row * DM))[2 * (lane + 64 * j) + 1] = y1; }
    }
}
__device__ __forceinline__ void rows_bf16_ss(const float* X, bf16_t* OB, float* SSO) {
    const int tid_ = opaque_tid(); const int lane = tid_ & 63, gw = blockIdx.x * 8 + (tid_ >> 6), ngw = gridDim.x * 8;
    for (int row = gw; row < TT; row += ngw) {
        const f32x4* xr = (const f32x4*)(X + (size_t)row * DM) + lane; float s = 0.f;
#pragma unroll
        for (int j = 0; j < 8; ++j) { const f32x4 v = xr[64 * j]; s += (v[0] * v[0] + v[1] * v[1]) + (v[2] * v[2] + v[3] * v[3]);
            u32x2 w; w.x = cvt_pk_bf16(v[0], v[1]); w.y = cvt_pk_bf16(v[2], v[3]); ((u32x2*)(OB + (size_t)row * DM))[lane + 64 * j] = w; }
        s = wave_sum(s, lane); if (lane == 0) { float z = 0.f; asm volatile("" : "+v"(z)); *(f32x4*)(SSO + (size_t)row * 8) = (f32x4){s, z, z, z}; *(f32x4*)(SSO + (size_t)row * 8 + 4) = (f32x4){z, z, z, z}; }
    }
}
struct TJob { const float* src; const float* gain; bf16_t* dst; int N, ldd, k0, n0, drow0, dk0; };
__device__ __forceinline__ TJob tjob_decode(const Args& a, int it) {
    constexpr int C_IN = 16 * 92, C_BP = 4 * 16, C_BS = 8 * 16, C_BH = 4 * 16, C_OUT = 256, C_GU = 16 * 88, C_DN = 44 * 16, C_PG = 256, C_PP = 2 * 16;
    constexpr int PER_L = C_IN + C_BP + C_BS + C_BH + C_OUT + C_GU + C_DN + C_PG + C_PP;
    const int L = it / PER_L; int r = it - L * PER_L;
    unsigned char* wl = a.ws + WS_W0 + (size_t)L * WL_SIZE;
    TJob J; J.gain = nullptr; J.dk0 = 0; int nkb, gu = 0;
    if (r < C_IN) { J.src = a.in[3] + (size_t)L * DM * INC; J.N = INC; J.dst = (bf16_t*)(wl + WL_IN); J.ldd = DM; nkb = 16; J.gain = a.in[2] + (size_t)L * DM; }
    else if ((r -= C_IN) < C_BP) { J.src = a.in[8] + (size_t)L * 512 * DM; J.N = DM; J.dst = (bf16_t*)(wl + WL_BR); J.ldd = DM; nkb = 4; }
    else if ((r -= C_BP) < C_BS) { J.src = a.in[9] + (size_t)L * 1024 * DM; J.N = DM; J.dst = (bf16_t*)(wl + WL_BR); J.ldd = DM; J.dk0 = 512; nkb = 8; }
    else if ((r -= C_BS) < C_BH) { J.src = a.in[10] + (size_t)L * 512 * DM; J.N = DM; J.dst = (bf16_t*)(wl + WL_BR); J.ldd = DM; J.dk0 = 1536; nkb = 4; }
    else if ((r -= C_BH) < C_OUT) { J.src = a.in[11] + (size_t)L * DM * DM; J.N = DM; J.dst = (bf16_t*)(wl + WL_OUT); J.ldd = DM; nkb = 16; }
    else if ((r -= C_OUT) < C_GU) { J.src = a.in[13] + (size_t)L * DM * 2 * DFF; J.N = 2 * DFF; J.dst = (bf16_t*)(wl + WL_GU); J.ldd = DM; nkb = 16; gu = 1; J.gain = a.in[12] + (size_t)L * DM; }
    else if ((r -= C_GU) < C_DN) { J.src = a.in[14] + (size_t)L * DFF * DM; J.N = DM; J.dst = (bf16_t*)(wl + WL_DN); J.ldd = DFF; nkb = 44; }
    else if ((r -= C_DN) < C_PG) { J.src = a.in[16] + (size_t)L * DM * DM; J.N = DM; J.dst = (bf16_t*)(wl + WL_PG); J.ldd = DM; nkb = 16; J.gain = a.in[15] + (size_t)L * DM; }
    else { r -= C_PG; J.src = a.in[17] + (size_t)L * PLE * DM; J.N = DM; J.dst = (bf16_t*)(wl + WL_PP); J.ldd = PLE; nkb = 2; }
    const int nb = r / nkb, kb = r - nb * nkb;
    J.drow0 = nb * 128; if (gu) J.drow0 = nb < 44 ? 256 * nb : 256 * (nb - 44) + 128;
    J.k0 = kb * 128; J.n0 = nb * 128;
    return J;
}
__device__ __forceinline__ void tjob_load(const TJob& J, int tid, f32x4 (&v)[8]) {
#pragma unroll
    for (int p = 0; p < 8; ++p) { const int k = p * 16 + (tid >> 5), c = (tid & 31) * 4;
        v[p] = __builtin_nontemporal_load((const f32x4*)(J.src + (size_t)(J.k0 + k) * J.N + J.n0 + c)); if (J.gain) v[p] = v[p] * J.gain[J.k0 + k]; }
}
__device__ __forceinline__ void tjob_finish(const TJob& J, int tid, const f32x4 (&v)[8], float* sm) {
#pragma unroll
    for (int p = 0; p < 8; ++p) { const int k = p * 16 + (tid >> 5), c = (tid & 31) * 4; float* s = sm + k * 129 + c; s[0] = v[p][0]; s[1] = v[p][1]; s[2] = v[p][2]; s[3] = v[p][3]; }
    __syncthreads();
#pragma unroll
    for (int i = 0; i < 4; ++i) { const int item = tid + 512 * i, c = item & 15, n = item >> 4; const float* s = sm + (8 * c) * 129 + n;
        u32x4 w; w.x = cvt_pk_bf16(s[0], s[129]); w.y = cvt_pk_bf16(s[2 * 129], s[3 * 129]); w.z = cvt_pk_bf16(s[4 * 129], s[5 * 129]); w.w = cvt_pk_bf16(s[6 * 129], s[7 * 129]);
        *(u32x4*)(J.dst + (size_t)(J.drow0 + n) * J.ldd + J.dk0 + J.k0 + 8 * c) = w; }
    __syncthreads();
}

__device__ __forceinline__ void prologue_phase(const Args& a, unsigned char* lds) {
    float* sm = (float*)lds;
    constexpr int N_ITEMS = NLAYER * (16 * 92 + 4 * 16 + 8 * 16 + 4 * 16 + 256 + 16 * 88 + 44 * 16 + 256 + 2 * 16);
    {   const int tid = opaque_tid();
        int it = blockIdx.x;
        if (it < N_ITEMS) {
            TJob J = tjob_decode(a, it); f32x4 v[8]; tjob_load(J, tid, v);
            for (;;) {
                const int itn = it + gridDim.x; const bool more = itn < N_ITEMS;
                TJob Jn = J; f32x4 vn[8];
#pragma unroll
                for (int p = 0; p < 8; ++p) vn[p] = v[p];
                if (more) { Jn = tjob_decode(a, itn); tjob_load(Jn, tid, vn); }
                tjob_finish(J, tid, v, sm);
                if (!more) break;
                J = Jn; it = itn;
#pragma unroll
                for (int p = 0; p < 8; ++p) v[p] = vn[p];
            }
        }
    }
    { const f32x4* ps = (const f32x4*)a.in[1]; u32x2* pd = (u32x2*)(a.ws + WS_PB); const int n4 = NLAYER * TT * PLE / 4;
      for (int i = blockIdx.x * 512 + opaque_tid(); i < n4; i += gridDim.x * 512) { const f32x4 v = ps[i]; u32x2 w; w.x = cvt_pk_bf16(v[0], v[1]); w.y = cvt_pk_bf16(v[2], v[3]); pd[i] = w; } }
    rows_bf16_ss(a.in[0], (bf16_t*)(a.ws + WS_H), (float*)(a.ws + WS_X));
}

__device__ __forceinline__ void pool_unit(unsigned char* lds, int tile, int gi, int L, const Args& a) {
    float* Wl = (float*)lds; float* uw = Wl + 128 * 128; float* mx = uw + 47 * 128;
    const int tid = opaque_tid();
    const float* U = (const float*)(a.ws + WS_U);
    const float* PW = a.in[4] + ((size_t)L * 4 + gi) * 128 * 128;
    const int t0 = tile * 32, s0 = t0 & (SEQ - 1);
#pragma unroll
    for (int i = 0; i < 8; ++i) ((f32x4*)Wl)[tid + 512 * i] = ((const f32x4*)PW)[tid + 512 * i];
    for (int i = tid; i < 47 * 32; i += 512) { const int rr = i >> 5, c4 = i & 31; const int sp = s0 - 15 + rr;
        f32x4 v = (f32x4){0.f, 0.f, 0.f, 0.f};
        if (sp >= 0) v = *(const f32x4*)(U + (size_t)(t0 - 15 + rr) * 512 + gi * 128 + c4 * 4);
        ((f32x4*)uw)[i] = v; }
    __syncthreads();
    const int w = 2 << gi;
    for (int i = tid; i < 32 * 128; i += 512) { const int tt = i >> 7, c = i & 127; float s = 0.f;
        for (int j = 0; j < w; ++j) s += uw[(15 + tt - j) * 128 + c];
        const int cnt = min(s0 + tt + 1, w);
        mx[i] = s / (float)cnt - uw[(15 + tt) * 128 + c]; }
    __syncthreads();
    const int d = tid & 127, tg = tid >> 7;
    float acc[8];
#pragma unroll
    for (int j = 0; j < 8; ++j) acc[j] = 0.f;
    for (int c = 0; c < 128; c += 4) {
        const float w0 = Wl[c * 128 + d], w1 = Wl[(c + 1) * 128 + d], w2 = Wl[(c + 2) * 128 + d], w3 = Wl[(c + 3) * 128 + d];
#pragma unroll
        for (int j = 0; j < 8; ++j) { const f32x4 mv = *(const f32x4*)(mx + (tg * 8 + j) * 128 + c); acc[j] += mv[0] * w0 + mv[1] * w1 + mv[2] * w2 + mv[3] * w3; }
    }
    const float sc = a.in[5][(size_t)L * 512 + gi * 128 + d];
    bf16_t* Y = (bf16_t*)(a.ws + WS_Y);
#pragma unroll
    for (int j = 0; j < 8; ++j) Y[(size_t)(t0 + tg * 8 + j) * 2048 + gi * 128 + d] = (bf16_t)(cvt_pk_bf16(acc[j] * sc, 0.f) & 0xffff);
    __syncthreads();
}

__device__ __forceinline__ void attn_unit(unsigned char* lds, int b, int h, int qb, const Args& a) {
    const bf16_t* SQ = (const bf16_t*)(a.ws + WS_SQ); const bf16_t* SK = (const bf16_t*)(a.ws + WS_SK); const bf16_t* VT = (const bf16_t*)(a.ws + WS_VT);
    bf16_t* Y = (bf16_t*)(a.ws + WS_Y);
    const int tid = opaque_tid(), lane = tid & 63, wid = tid >> 6, r = lane & 31, hi = lane >> 5;
    const int half = wid >> 2, wq = wid & 3, t256 = tid & 255;
    const int q0 = qb * 128, qw0 = q0 + wq * 32;
    const size_t rowbase = (size_t)b * SEQ;
    constexpr int KBY = 64 * 272, VBY = 128 * 144, BUF = KBY + VBY;
    unsigned char* hb = lds + half * BUF;
    bf16x8 qf[8];
    { const bf16_t* qp = SQ + (rowbase + qw0 + r) * 1024 + h * 128 + hi * 8;
#pragma unroll
      for (int ds = 0; ds < 8; ++ds) qf[ds] = *(const bf16x8*)(qp + ds * 16); }
    f32x16 o[4];
#pragma unroll
    for (int i = 0; i < 4; ++i)
#pragma unroll
        for (int j = 0; j < 16; ++j) o[i][j] = 0.f;
    float R = 1.f;
    const int nst = qb + 1;
    const int jstart = half == 0 ? 2 * qb + 1 : qb;
    u32x4 st[8];
#define ATT_LOAD(jj) do { _Pragma("unroll") for (int i = 0; i < 4; ++i) { const int ch = t256 + 256 * i; \
        st[i] = *(const u32x4*)(SK + (rowbase + 64 * (jj) + (ch >> 4)) * 1024 + h * 128 + (ch & 15) * 8); \
        st[4 + i] = *(const u32x4*)(VT + (((size_t)(b * 8 + h) * 128 + (ch >> 3)) << 11) + 64 * (jj) + (ch & 7) * 8); } } while (0)
#define ATT_STORE() do { _Pragma("unroll") for (int i = 0; i < 4; ++i) { const int ch = t256 + 256 * i; \
        *(u32x4*)(hb + (ch >> 4) * 272 + (ch & 15) * 16) = st[i]; *(u32x4*)(hb + KBY + (ch >> 3) * 144 + (ch & 7) * 16) = st[4 + i]; } } while (0)
    ATT_LOAD(jstart); ATT_STORE();
    __syncthreads();
    for (int sidx = 0; sidx < nst; ++sidx) {
        const int j = jstart - sidx;
        if (sidx + 1 < nst) ATT_LOAD(j - 1);
        if (64 * j <= qw0 + 31) {
            const unsigned char* Kb = hb; const unsigned char* Vb = hb + KBY;
            f32x16 p[2];
#pragma unroll
            for (int hh = 0; hh < 2; ++hh) {
#pragma unroll
                for (int jj = 0; jj < 16; ++jj) p[hh][jj] = 0.f;
#pragma unroll
                for (int ds = 0; ds < 8; ++ds) { const bf16x8 ka = *(const bf16x8*)(Kb + (32 * hh + r) * 272 + (16 * ds + 8 * hi) * 2); p[hh] = MFMA32(ka, qf[ds], p[hh]); }
            }
            const int t = qw0 + r; const int sbase = 64 * j + 4 * hi;
            float G[8];
#define ATT_ELEM(MASKED) \
            _Pragma("unroll") for (int hh = 0; hh < 2; ++hh) \
                _Pragma("unroll") for (int g = 0; g < 4; ++g) { \
                    float mm[4], bb[4]; \
                    _Pragma("unroll") for (int i = 0; i < 4; ++i) { const float uu = __builtin_amdgcn_exp2f(p[hh][4 * g + i]); \
                        const float mi = __builtin_amdgcn_rcpf(1.0f + uu); \
                        if (MASKED) { const int s = sbase + 32 * hh + 8 * g + i; const bool valid = s < t; mm[i] = valid ? mi : 1.0f; bb[i] = valid ? 1.0f - mi : 0.0f; } \
                        else { mm[i] = mi; bb[i] = 1.0f - mi; } } \
                    const float e2 = mm[3], e1 = mm[2] * e2, e0 = mm[1] * e1; \
                    G[hh * 4 + g] = mm[0] * e0; \
                    p[hh][4 * g + 0] = bb[0] * e0; p[hh][4 * g + 1] = bb[1] * e1; p[hh][4 * g + 2] = bb[2] * e2; p[hh][4 * g + 3] = bb[3]; \
                }
            if (64 * j + 63 < qw0) { ATT_ELEM(false) } else { ATT_ELEM(true) }
#undef ATT_ELEM
            float X = 1.0f;
#pragma unroll
            for (int idx = 7; idx >= 0; --idx) { const float gp = shflx(G[idx], 32, lane); const float f = X * (hi == 0 ? gp : 1.0f) * R;
                const int hh = idx >> 2, g = idx & 3;
#pragma unroll
                for (int i = 0; i < 4; ++i) p[hh][4 * g + i] *= f;
                X *= G[idx] * gp; }
            R *= X;
            bf16x8 pa[4];
#pragma unroll
            for (int kb = 0; kb < 4; ++kb) { const int hh = kb >> 1, b8 = (kb & 1) * 8;
                pa[kb] = pack8(p[hh][b8], p[hh][b8 + 1], p[hh][b8 + 2], p[hh][b8 + 3], p[hh][b8 + 4], p[hh][b8 + 5], p[hh][b8 + 6], p[hh][b8 + 7]); }
#pragma unroll
            for (int kb = 0; kb < 4; ++kb)
#pragma unroll
                for (int db = 0; db < 4; ++db) { const unsigned char* vp = Vb + (32 * db + r) * 144 + (16 * kb + 4 * hi) * 2;
                    const s16x4 lo = *(const s16x4*)vp, hi4 = *(const s16x4*)(vp + 16);
                    const bf16x8 vf = (bf16x8){lo[0], lo[1], lo[2], lo[3], hi4[0], hi4[1], hi4[2], hi4[3]};
                    o[db] = MFMA32(pa[kb], vf, o[db]); }
        }
        __syncthreads();
        if (sidx + 1 < nst) ATT_STORE();
        __syncthreads();
    }
#undef ATT_LOAD
#undef ATT_STORE
    float* OF = (float*)lds; float* RB = (float*)(lds + 128 * 132 * 4);
    if (half == 1) {
#pragma unroll
        for (int db = 0; db < 4; ++db)
#pragma unroll
            for (int reg = 0; reg < 16; ++reg) OF[(32 * wq + crow(reg, hi)) * 132 + 32 * db + r] = o[db][reg];
    } else if (hi == 0) RB[32 * wq + r] = R;
    __syncthreads();
    if (half == 0) {
#pragma unroll
        for (int reg = 0; reg < 16; ++reg) { const int q = 32 * wq + crow(reg, hi); const float rr = RB[q];
#pragma unroll
            for (int db = 0; db < 4; ++db) { const float v = o[db][reg] + rr * OF[q * 132 + 32 * db + r];
                Y[(rowbase + q0 + q) * 2048 + 512 + h * 128 + 32 * db + r] = (bf16_t)(cvt_pk_bf16(v, 0.f) & 0xffff); } }
    }
    __syncthreads();
}

__device__ __forceinline__ void hgrn_prep_unit(unsigned char* lds, int bh, int c, int L, const Args& a) {
    const float* ZF = (const float*)(a.ws + WS_ZF); const float* HQ = (const float*)(a.ws + WS_HQ); const bf16_t* HV = (const bf16_t*)(a.ws + WS_HV);
    bf16_t* HQD = (bf16_t*)(a.ws + WS_HQD); bf16_t* HKD = (bf16_t*)(a.ws + WS_HKD); bf16_t* HVT = (bf16_t*)(a.ws + WS_HVT);
    float* HDEC = (float*)(a.ws + WS_HDEC); float* HOI = (float*)(a.ws + WS_HOI);
    const int b = bh >> 2, h = bh & 3;
    const int tid = opaque_tid(), lane = tid & 63, wid = tid >> 6, r = lane & 31, hi = lane >> 5;
    float* TOT = (float*)lds; unsigned char* QD = lds + 2048; unsigned char* KT = QD + 32 * 272; unsigned char* VTl = KT + 32 * 272;
    const int k = tid & 127, tq = tid >> 7;
    float lbA, lbB, oml;
    { const int ch = h * 128 + k; const float h0 = a.in[6][ch], h1 = a.in[6][512 + ch]; const float mxv = fmaxf(h0, h1);
      const float e0 = __expf(h0 - mxv), e1 = __expf(h1 - mxv); float lb = (L == 0) ? 0.f : e1 / (e0 + e1);
      lb = fminf(fmaxf(lb, 0.f), 1.f); lbA = fmaxf(lb, 1e-20f); lbB = 1.0f - fminf(lb, 1.0f - 1e-6f); oml = 1.0f - lb; }
    const size_t row0 = (size_t)b * SEQ + c * 32;
    const size_t gbase = (row0 + tq * 8) * 512 + h * 128 + k;
    const size_t fidx = (size_t)(bh * 64 + c) * 4096 + (size_t)((((k >> 5) * 2 + (tq >> 1)) * 64 + (tq & 1) * 32 + (k & 31)) * 8);
    float kk[8], bl[8], qv[8]; float bs = 0.f;
#pragma unroll
    for (int i = 0; i < 8; ++i) { float zf = ZF[gbase + (size_t)i * 512]; qv[i] = HQ[gbase + (size_t)i * 512];
        zf = fminf(fmaxf(zf, -80.f), 80.f); const float e = __expf(-zf); const float sg = __builtin_amdgcn_rcpf(1.0f + e);
        const float f = lbA + lbB * sg; bs += logf(f); bl[i] = bs; kk[i] = oml * e * sg; }
    TOT[tq * 128 + k] = bs;
    { unsigned short x[8];
#pragma unroll
      for (int i = 0; i < 8; ++i) x[i] = HV[gbase + (size_t)i * 512];
      u32x4 w; w.x = x[0] | ((unsigned)x[1] << 16); w.y = x[2] | ((unsigned)x[3] << 16); w.z = x[4] | ((unsigned)x[5] << 16); w.w = x[6] | ((unsigned)x[7] << 16);
      *(u32x4*)(VTl + k * 80 + tq * 16) = w; *(u32x4*)(HVT + fidx) = w; }
    __syncthreads();
    float off = 0.f, tot = 0.f;
#pragma unroll
    for (int q = 0; q < 4; ++q) { const float v = TOT[q * 128 + k]; tot += v; if (q < tq) off += v; }
    float kd[8];
#pragma unroll
    for (int i = 0; i < 8; ++i) { const float bt = off + bl[i]; const int t = tq * 8 + i;
        *(bf16_t*)(QD + t * 272 + k * 2) = (bf16_t)(cvt_pk_bf16(qv[i] * __expf(bt), 0.f) & 0xffff);
        *(bf16_t*)(KT + t * 272 + k * 2) = (bf16_t)(cvt_pk_bf16(kk[i] * __expf(fminf(-bt, 80.f)), 0.f) & 0xffff);
        kd[i] = kk[i] * __expf(tot - bt); }
    *(bf16x8*)(HKD + fidx) = pack8(kd[0], kd[1], kd[2], kd[3], kd[4], kd[5], kd[6], kd[7]);
    if (tq == 0) HDEC[(size_t)(bh * 64 + c) * 128 + k] = __expf(tot);
    __syncthreads();
    { const int k0 = 32 * (wid >> 1) + 16 * (wid & 1) + 4 * hi; const unsigned char* p = QD + r * 272 + k0 * 2;
      const s16x4 lo = *(const s16x4*)p, hi4 = *(const s16x4*)(p + 16);
      *(bf16x8*)(HQD + (size_t)(bh * 64 + c) * 4096 + (wid * 64 + lane) * 8) = (bf16x8){lo[0], lo[1], lo[2], lo[3], hi4[0], hi4[1], hi4[2], hi4[3]}; }
    if (wid < 4) {
        const int w = wid;
        f32x16 pt;
#pragma unroll
        for (int j = 0; j < 16; ++j) pt[j] = 0.f;
#pragma unroll
        for (int ks = 0; ks < 8; ++ks) { const bf16x8 ka = *(const bf16x8*)(KT + r * 272 + (16 * ks + 8 * hi) * 2); const bf16x8 qa = *(const bf16x8*)(QD + r * 272 + (16 * ks + 8 * hi) * 2);
            pt = MFMA32(ka, qa, pt); }
#pragma unroll
        for (int reg = 0; reg < 16; ++reg) { if (crow(reg, hi) > r) pt[reg] = 0.f; }
        const bf16x8 pa0 = pack8(pt[0], pt[1], pt[2], pt[3], pt[4], pt[5], pt[6], pt[7]);
        const bf16x8 pa1 = pack8(pt[8], pt[9], pt[10], pt[11], pt[12], pt[13], pt[14], pt[15]);
        f32x16 o;
#pragma unroll
        for (int j = 0; j < 16; ++j) o[j] = 0.f;
#pragma unroll
        for (int s16 = 0; s16 < 2; ++s16) { const unsigned char* vp = VTl + (32 * w + r) * 80 + (16 * s16 + 4 * hi) * 2;
            const s16x4 lo = *(const s16x4*)vp, hi4 = *(const s16x4*)(vp + 16);
            const bf16x8 vf = (bf16x8){lo[0], lo[1], lo[2], lo[3], hi4[0], hi4[1], hi4[2], hi4[3]};
            o = MFMA32(s16 ? pa1 : pa0, vf, o); }
#pragma unroll
        for (int reg = 0; reg < 16; ++reg) HOI[(row0 + crow(reg, hi)) * 512 + h * 128 + 32 * w + r] = o[reg];
    }
    __syncthreads();
}

__device__ __forceinline__ float dpp_sum16(float v) {
    v += __int_as_float(__builtin_amdgcn_update_dpp(0, __float_as_int(v), 0xB1, 0xF, 0xF, true));
    v += __int_as_float(__builtin_amdgcn_update_dpp(0, __float_as_int(v), 0x4E, 0xF, 0xF, true));
    v += __int_as_float(__builtin_amdgcn_update_dpp(0, __float_as_int(v), 0x141, 0xF, 0xF, true));
    v += __int_as_float(__builtin_amdgcn_update_dpp(0, __float_as_int(v), 0x140, 0xF, 0xF, true));
    return v;
}
__device__ __forceinline__ void hgrn_chain_unit(unsigned char* lds, int bh, int L, const Args& a) {
    const bf16_t* HQD = (const bf16_t*)(a.ws + WS_HQD); const bf16_t* HKD = (const bf16_t*)(a.ws + WS_HKD); const bf16_t* HVT = (const bf16_t*)(a.ws + WS_HVT);
    const float* HDEC = (const float*)(a.ws + WS_HDEC); const float* HOI = (const float*)(a.ws + WS_HOI);
    const bf16_t* OG = (const bf16_t*)(a.ws + WS_OG); bf16_t* Y = (bf16_t*)(a.ws + WS_Y);
    const int b = bh >> 2, h = bh & 3;
    const int tid = opaque_tid(), lane = tid & 63, wid = tid >> 6, r = lane & 31, hi = lane >> 5;
    constexpr int BUFB = 25088;
    float* OB = (float*)(lds + 3 * BUFB);
    f32x16 Sacc[4];
#pragma unroll
    for (int i = 0; i < 4; ++i)
#pragma unroll
        for (int j = 0; j < 16; ++j) Sacc[i][j] = 0.f;
    const size_t cb = (size_t)bh * 64;
    const size_t rowb = (size_t)b * SEQ;
    u32x4 stA[3], stB[3]; f32x4 sdA = (f32x4){0.f, 0.f, 0.f, 0.f}, sdB = sdA;
#define HG_LOAD(cc, st, sd) do { const int cc_ = (cc) < 63 ? (cc) : 63; const size_t e_ = (cb + cc_) * 4096 + (size_t)tid * 8; st[0] = *(const u32x4*)(HQD + e_); st[1] = *(const u32x4*)(HKD + e_); st[2] = *(const u32x4*)(HVT + e_); \
        sd = *(const f32x4*)(HDEC + (cb + cc_) * 128 + (tid & 31) * 4); } while (0)
#define HG_STORE(bi, st, sd) do { unsigned char* B_ = lds + (bi) * BUFB; *(u32x4*)(B_ + tid * 16) = st[0]; *(u32x4*)(B_ + 8192 + tid * 16) = st[1]; *(u32x4*)(B_ + 16384 + tid * 16) = st[2]; \
        if (tid < 32) *(f32x4*)(B_ + 24576 + tid * 16) = sd; } while (0)
    HG_LOAD(0, stA, sdA); HG_STORE(0, stA, sdA); HG_LOAD(1, stA, sdA); HG_STORE(1, stA, sdA);
    HG_LOAD(2, stB, sdB);
    const int pt_ = tid >> 4, seg = tid & 15; const int ch = h * 128 + seg * 8;
    const float* gn = a.in[7] + (size_t)L * 512 + ch; const f32x4 g0 = *(const f32x4*)gn, g1 = *(const f32x4*)(gn + 4);
    f32x4 oiA0, oiA1, oiB0, oiB1; u32x4 ogA, ogB;
#define HG_PLOAD(cc, o0, o1, og_) do { const int cp_ = (cc) < 63 ? (cc) : 63; const size_t row_ = rowb + cp_ * 32 + pt_; o0 = *(const f32x4*)(HOI + row_ * 512 + ch); o1 = *(const f32x4*)(HOI + row_ * 512 + ch + 4); og_ = *(const u32x4*)(OG + row_ * 512 + ch); } while (0)
    HG_PLOAD(0, oiA0, oiA1, ogA);
    __syncthreads();
#define HG_ITER(c, stX, sdX, stY, sdY, oiC0, oiC1, ogC, oiN0, oiN1, ogN) do { \
        const int bi = (c) % 3; \
        HG_LOAD((c) + 3, stX, sdX); \
        HG_PLOAD((c) + 1, oiN0, oiN1, ogN); \
        if (wid < 4) { \
            const int w = wid; const unsigned char* B = lds + bi * BUFB; \
            f32x16 o, o2; \
            _Pragma("unroll") for (int j = 0; j < 16; ++j) { o[j] = 0.f; o2[j] = 0.f; } \
            _Pragma("unroll") for (int kb = 0; kb < 4; ++kb) \
                _Pragma("unroll") for (int s16 = 0; s16 < 2; ++s16) { const bf16x8 aq = *(const bf16x8*)(B + ((kb * 2 + s16) * 64 + lane) * 16); const int b8 = 8 * s16; \
                    const bf16x8 bsv = pack8(Sacc[kb][b8], Sacc[kb][b8 + 1], Sacc[kb][b8 + 2], Sacc[kb][b8 + 3], Sacc[kb][b8 + 4], Sacc[kb][b8 + 5], Sacc[kb][b8 + 6], Sacc[kb][b8 + 7]); \
                    if (kb < 2) o = MFMA32(aq, bsv, o); else o2 = MFMA32(aq, bsv, o2); } \
            _Pragma("unroll") for (int kb = 0; kb < 4; ++kb) { \
                _Pragma("unroll") for (int g = 0; g < 4; ++g) { const f32x4 dd = *(const f32x4*)(B + 24576 + (32 * kb + 8 * g + 4 * hi) * 4); \
                    _Pragma("unroll") for (int i = 0; i < 4; ++i) Sacc[kb][4 * g + i] *= dd[i]; } \
                _Pragma("unroll") for (int s16 = 0; s16 < 2; ++s16) { const bf16x8 ka = *(const bf16x8*)(B + 8192 + ((kb * 2 + s16) * 64 + lane) * 16); \
                    const bf16x8 va = *(const bf16x8*)(B + 16384 + ((w * 2 + s16) * 64 + lane) * 16); \
                    Sacc[kb] = MFMA32(ka, va, Sacc[kb]); } \
            } \
            _Pragma("unroll") for (int reg = 0; reg < 16; ++reg) OB[crow(reg, hi) * 132 + 32 * w + r] = o[reg] + o2[reg]; \
        } \
        __syncthreads(); \
        { const size_t row = rowb + (c) * 32 + pt_; const float* op = OB + pt_ * 132 + seg * 8; \
          const f32x4 x0 = *(const f32x4*)op + oiC0, x1 = *(const f32x4*)(op + 4) + oiC1; \
          float ss = (x0[0] * x0[0] + x0[1] * x0[1]) + (x0[2] * x0[2] + x0[3] * x0[3]) + (x1[0] * x1[0] + x1[1] * x1[1]) + (x1[2] * x1[2] + x1[3] * x1[3]); \
          ss = dpp_sum16(ss); \
          const float rstd = __builtin_amdgcn_rsqf(ss * (1.0f / 128.0f) + EPS); \
          f32x4 y0, y1; \
          y0[0] = x0[0] * rstd * g0[0] * bflo(ogC.x); y0[1] = x0[1] * rstd * g0[1] * bfhi(ogC.x); y0[2] = x0[2] * rstd * g0[2] * bflo(ogC.y); y0[3] = x0[3] * rstd * g0[3] * bfhi(ogC.y); \
          y1[0] = x1[0] * rstd * g1[0] * bflo(ogC.z); y1[1] = x1[1] * rstd * g1[1] * bfhi(ogC.z); y1[2] = x1[2] * rstd * g1[2] * bflo(ogC.w); y1[3] = x1[3] * rstd * g1[3] * bfhi(ogC.w); \
          *(u32x4*)(Y + row * 2048 + 1536 + ch) = pack8v(y0, y1); } \
        HG_STORE(((c) + 2) % 3, stY, sdY); \
        __syncthreads(); \
    } while (0)
    for (int c = 0; c < 64; c += 2) {
        HG_ITER(c, stA, sdA, stB, sdB, oiA0, oiA1, ogA, oiB0, oiB1, ogB);
        HG_ITER(c + 1, stB, sdB, stA, sdA, oiB0, oiB1, ogB, oiA0, oiA1, ogA);
    }
#undef HG_ITER
#undef HG_PLOAD
#undef HG_LOAD
#undef HG_STORE
}

#define WQ_NEXT(cw) ({ if (threadIdx.x == 0) sh[0] = atomicAdd((cw), 1u); __syncthreads(); const int u_ = (int)sh[0]; __syncthreads(); u_; })
constexpr int INP_MAIN_COLT = 40;
__device__ __forceinline__ void mixer_phase(const Args& a, unsigned char* lds, int L, int mp, int rep) {
    unsigned* ctr = (unsigned*)(a.ws + WS_CTL) + 64 * (L * 4 + mp * 2 + rep);
    volatile unsigned* sh = (volatile unsigned*)(lds + LDS_MISC);
    if (mp == 0) {
        for (;;) { const int u = WQ_NEXT(ctr); if (u >= 2048) break;
            if (u < 1024) hgrn_prep_unit(lds, u >> 6, u & 63, L, a);
            else { const int x = u - 1024; pool_unit(lds, x >> 2, x & 3, L, a); } }
    } else {
        { const int u = WQ_NEXT(ctr); if (u < 16) { hgrn_chain_unit(lds, u, L, a); if (CHAIN_TWICE) { __syncthreads(); hgrn_chain_unit(lds, u, L, a); } } }
        for (;;) { const int x = WQ_NEXT(ctr + 8); if (x >= 32 * (46 - INP_MAIN_COLT)) break;
            pg8::Gemm g{(const bf16_t*)(a.ws + WS_H), (const bf16_t*)(a.ws + WS_W0 + (size_t)L * WL_SIZE + WL_IN), TT, INC, DM, DM, 1, 0, 0, 0, DM / 64, 0, 0};
            pg8::OneUnit S1{x / (46 - INP_MAIN_COLT), INP_MAIN_COLT + x % (46 - INP_MAIN_COLT)};
            EpiIn E{a.ws, 3 * L * TT};
            pg8::gemm_phase((PG8_LAS unsigned char*)lds, g, S1, E); }
        for (;;) { const int x = WQ_NEXT(ctr + 16); if (x >= 512) break;
            attn_unit(lds, (x & 31) >> 3, x & 7, 15 - (x >> 5), a); }
    }
}
__device__ __forceinline__ void pp_queue(const Args& a, unsigned char* lds, int L) {
    unsigned* ctr = (unsigned*)(a.ws + WS_CTL) + 64 * (L * 4 + 2) + 24;
    volatile unsigned* sh = (volatile unsigned*)(lds + LDS_MISC);
    for (;;) { const int x = WQ_NEXT(ctr); if (x >= 256) break;
        pg8::Gemm g{(const bf16_t*)(a.ws + WS_PB) + (size_t)L * TT * PLE, (const bf16_t*)(a.ws + WS_W0 + (size_t)L * WL_SIZE + WL_PP), TT, DM, PLE, PLE, 1, 0, 0, 0, PLE / 64, 0, 0};
        pg8::OneUnit S1{x >> 3, x & 7};
        EpiBf16 E{a.ws};
        pg8::gemm_phase((PG8_LAS unsigned char*)lds, g, S1, E); }
}

#define LAS __attribute__((address_space(3)))
#define XB_TMO      128
#define XB_XCNT(j)  (256  + 64 * (j))
#define XB_XSUB(j)  (1280 + 64 * (j))
#define XB_XGEN(j)  (2304 + 64 * (j))
#define XB_TOP      3328
#define XB_TOPGEN   3392
#define XCD_BAR_WORDS 3456
#define XB_SPIN_CAP (1u << 20)
__device__ __forceinline__ unsigned xb_ld(unsigned* p)              { return __hip_atomic_load(p, __ATOMIC_RELAXED, __HIP_MEMORY_SCOPE_AGENT); }
__device__ __forceinline__ unsigned xb_add(unsigned* p, unsigned v) { return __hip_atomic_fetch_add(p, v, __ATOMIC_RELAXED, __HIP_MEMORY_SCOPE_AGENT); }
__device__ __forceinline__ unsigned xb_xcc_id() { return (unsigned)__builtin_amdgcn_s_getreg((3 << 11) | 20) & 0xFu; }
#define XB_SPIN(cond, bar) do { unsigned _sp = 0; while (cond) { __builtin_amdgcn_s_sleep(1); \
    if ((++_sp & 255u) == 0u) { if (xb_ld(&(bar)[XB_TMO])) break; if (_sp > XB_SPIN_CAP) { atomicAdd(&(bar)[XB_TMO], 1u); break; } } } } while (0)
struct XcdBarrier { unsigned* bar; unsigned x; volatile LAS unsigned* st; };
__device__ __forceinline__ XcdBarrier xcd_barrier_post(unsigned* bar, volatile LAS unsigned* st) {
    XcdBarrier b; b.bar = bar; b.x = xb_xcc_id(); b.st = st;
    if (threadIdx.x == 0) (void)xb_add(&bar[XB_XCNT(b.x)], 1u);
    return b;
}
__device__ __forceinline__ void xcd_barrier_complete(unsigned* bar, unsigned x, unsigned& nloc, unsigned& nx) {
    const unsigned G = gridDim.x * gridDim.y * gridDim.z;
    unsigned sum, cnt, mine, sp = 0u;
    for (;;) {
        sum = 0u; cnt = 0u; mine = 0u;
#pragma nounroll
        for (unsigned j = 0; j < 16; ++j) { const unsigned c = xb_ld(&bar[XB_XCNT(j)]); sum += c; cnt += (c > 0u) ? 1u : 0u; mine = (j == x) ? c : mine; }
        if (sum == G) break;
        __builtin_amdgcn_s_sleep(1);
        if ((++sp & 255u) == 0u) { if (xb_ld(&bar[XB_TMO])) break; if (sp > XB_SPIN_CAP) { atomicAdd(&bar[XB_TMO], 1u); break; } }
    }
    nloc = mine > 0u ? mine : 1u; nx = cnt > 0u ? cnt : 1u;
}
__device__ __forceinline__ void xcd_barrier(const XcdBarrier& b) {
    asm volatile("s_waitcnt vmcnt(0)" ::: "memory");
    __syncthreads();
    if (threadIdx.x == 0) {
        unsigned* bar = b.bar; asm volatile("" : "+s"(bar));
        __builtin_amdgcn_s_waitcnt(0);
        unsigned nloc = b.st[0], nx = b.st[1];
        if (nloc == 0u) { xcd_barrier_complete(bar, b.x, nloc, nx); b.st[0] = nloc; b.st[1] = nx; }
        const unsigned old = xb_add(&bar[XB_XSUB(b.x)], 1u);
        const unsigned gen = old / nloc;
        if (old + 1u == (gen + 1u) * nloc) {
            __builtin_amdgcn_fence(__ATOMIC_RELEASE, "agent");
            asm volatile("s_waitcnt vmcnt(0)" ::: "memory");
            const unsigned og = xb_add(&bar[XB_TOP], 1u);
            const unsigned tg = og / nx;
            if (og + 1u == (tg + 1u) * nx) xb_add(&bar[XB_TOPGEN], 1u);
            else XB_SPIN(xb_ld(&bar[XB_TOPGEN]) == tg, bar);
            __builtin_amdgcn_fence(__ATOMIC_ACQUIRE, "agent");
            xb_add(&bar[XB_XGEN(b.x)], 1u);
            asm volatile("s_waitcnt vmcnt(0)" ::: "memory");
        } else {
            XB_SPIN(xb_ld(&bar[XB_XGEN(b.x)]) == gen, bar);
            __builtin_amdgcn_fence(__ATOMIC_ACQUIRE, "agent");
            asm volatile("s_waitcnt vmcnt(0)" ::: "memory");
        }
    }
    __syncthreads();
}

typedef const Args __attribute__((address_space(4)))* KArgP;
#define LOAD_ARGS KArgP ap = (KArgP)__builtin_amdgcn_kernarg_segment_ptr(); asm volatile("" : "+s"(ap)); Args A; \
    _Pragma("unroll") for (int i_ = 0; i_ < 19; ++i_) A.in[i_] = ap->in[i_]; A.out = ap->out; A.ws = ap->ws; A.ph_lo = 0; A.ph_hi = 0;
__global__ void __launch_bounds__(512, 2) mega(Args a) {
    extern __shared__ __attribute__((aligned(16))) unsigned char lds[];
    cg::grid_group grid = cg::this_grid();
    PG8_LAS unsigned char* lds3 = (PG8_LAS unsigned char*)lds;
    const int G = gridDim.x, bx = blockIdx.x;
    if (threadIdx.x == 0) { ((volatile LAS unsigned*)((LAS unsigned char*)lds + LDS_MISC))[8] = 0u; ((volatile LAS unsigned*)((LAS unsigned char*)lds + LDS_MISC))[9] = 0u; }
    __syncthreads();
    XcdBarrier xbar = xcd_barrier_post((unsigned*)(a.ws + WS_CTL) + 1024, (volatile LAS unsigned*)((LAS unsigned char*)lds + LDS_MISC) + 8);
    constexpr int ph_hi_ = NPHASE;
#pragma nounroll
    for (int ph = 0; ph < ph_hi_; ++ph) {
      const int nrep = 1 + ((ph == 0 ? (REP_MASK >> 15) : (ph == NPHASE - 1 ? 0 : (REP_MASK >> ((ph - 1) % PPL)))) & 1);
      for (int rep = 0; rep < nrep; ++rep) {
        if (ph == 0) { if (PHMASK & 0x8000) { LOAD_ARGS prologue_phase(A, lds); } }
        else if (ph == NPHASE - 1) { if (PHMASK & 0x4000) { LOAD_ARGS final_norm_rows((const bf16_t*)(A.ws + WS_H), (const float*)(A.ws + WS_X) + (size_t)(3 * NLAYER) * TT * 8, A.in[18], A.out); } }
        else {
            const int L = (ph - 1) / PPL, s = (ph - 1) % PPL;
            if (s == 0) { if (PHMASK & (1 << 0)) {
                LOAD_ARGS unsigned char* wl = A.ws + WS_W0 + (size_t)L * WL_SIZE;
                pg8::Gemm g{(const bf16_t*)(A.ws + WS_H), (const bf16_t*)(wl + WL_IN), TT, INC, DM, DM, 1, 0, 0, 0, DM / 64, 0, 0};
                pg8::StaticOrder S; S.init(TT, INP_MAIN_COLT * 256, G, bx, 1);
                EpiIn E{A.ws, 3 * L * TT};
                pg8::gemm_phase(lds3, g, S, E);
            }} else if (s == 1) { if (PHMASK & (1 << 1)) {
                LOAD_ARGS mixer_phase(A, lds, L, 0, rep);
            }} else if (s == 2) { if (PHMASK & (1 << 2)) {
                LOAD_ARGS mixer_phase(A, lds, L, 1, rep);
            }} else if (s == 3) { if (PHMASK & (1 << 3)) {
                LOAD_ARGS unsigned char* wl = A.ws + WS_W0 + (size_t)L * WL_SIZE;
                pg8::Gemm g{(const bf16_t*)(A.ws + WS_Y), (const bf16_t*)(wl + WL_BR), TT, DM, DM, DM, 3, 0, 512, 1536, 8, 16, 8};
                pg8::StaticOrder S; S.init(TT, DM, G, bx, 3);
                EpiBranch E{A.ws};
                pg8::gemm_phase(lds3, g, S, E);
            }} else if (s == 4) { if (PHMASK & (1 << 4)) {
                LOAD_ARGS unsigned char* wl = A.ws + WS_W0 + (size_t)L * WL_SIZE;
                pg8::Gemm g{(const bf16_t*)(A.ws + WS_MIX), (const bf16_t*)(wl + WL_OUT), TT, DM, DM, DM, 1, 0, 0, 0, DM / 64, 0, 0};
                pg8::StaticOrder S; S.init(TT, DM, G, bx, 1);
                EpiResid E{A.ws, 0, 0, (3 * L + 1) * TT};
                pg8::gemm_phase(lds3, g, S, E);
            }} else if (s == 5) { if (PHMASK & (1 << 5)) {
                LOAD_ARGS unsigned char* wl = A.ws + WS_W0 + (size_t)L * WL_SIZE;
                pg8::Gemm g{(const bf16_t*)(A.ws + WS_H), (const bf16_t*)(wl + WL_GU), TT, 2 * DFF, DM, DM, 1, 0, 0, 0, DM / 64, 0, 0};
                pg8::StaticOrder S; S.init(TT, 2 * DFF, G, bx, 1);
                EpiSwiglu E{A.ws, (3 * L + 1) * TT};
                pg8::gemm_phase(lds3, g, S, E);
                if (rep == 0) pp_queue(A, lds, L);
            }} else if (s == 6) { if (PHMASK & (1 << 6)) {
                LOAD_ARGS unsigned char* wl = A.ws + WS_W0 + (size_t)L * WL_SIZE;
                pg8::Gemm g{(const bf16_t*)(A.ws + WS_ACT), (const bf16_t*)(wl + WL_DN), TT, DM, DFF, DFF, 1, 0, 0, 0, DFF / 64, 0, 0};
                pg8::StaticOrder S; S.init(TT, DM, G, bx, 1);
                EpiResid E{A.ws, 0, (int)(WS_HB - WS_H), (3 * L + 2) * TT};
                pg8::gemm_phase(lds3, g, S, E);
            }} else { if (PHMASK & (1 << 7)) {
                LOAD_ARGS unsigned char* wl = A.ws + WS_W0 + (size_t)L * WL_SIZE;
                pg8::Gemm g{(const bf16_t*)(A.ws + WS_HB), (const bf16_t*)(wl + WL_PG), TT, DM, DM, DM, 1, 0, 0, 0, DM / 64, 0, 0};
                pg8::StaticOrder S; S.init(TT, DM, G, bx, 1);
                EpiPle E{A.ws, (3 * L + 2) * TT};
                pg8::gemm_phase(lds3, g, S, E);
            }}
        }
        if (ph + 1 < ph_hi_ || rep + 1 < nrep) { if (ph == 0) grid.sync(); else xcd_barrier(xbar); }
      }
    }
    for (int i = 0; i < EXTRA_SYNCS; ++i) xcd_barrier(xbar);
}

extern "C" void kernel_launch(void* const* d_in, const int* in_sizes, int n_in, void* d_out, int out_size, void* d_ws, size_t ws_size, hipStream_t stream) {
    static int grid = 0;
    if (grid == 0) {
        if (n_in != 19 || out_size != TT * DM || ws_size < WS_END) { fprintf(stderr, "kernel_launch: unexpected problem (n_in %d out %d ws %zu need %zu)\n", n_in, out_size, ws_size, (size_t)WS_END); grid = -1; return; }
        int dev = 0, cus = 0, per_cu = 0;
        hipGetDevice(&dev); hipDeviceGetAttribute(&cus, hipDeviceAttributeMultiprocessorCount, dev);
        if (hipFuncSetAttribute((const void*)mega, hipFuncAttributeMaxDynamicSharedMemorySize, LDS_BYTES) != hipSuccess) { fprintf(stderr, "kernel_launch: hipFuncSetAttribute failed\n"); grid = -1; return; }
        if (hipOccupancyMaxActiveBlocksPerMultiprocessor(&per_cu, (const void*)mega, 512, LDS_BYTES) != hipSuccess || per_cu < 1) { fprintf(stderr, "kernel_launch: occupancy query gave %d\n", per_cu); per_cu = 1; }
        (void)hipGetLastError();
        grid = cus * per_cu;
        fprintf(stderr, "kernel_launch: grid %d (cus %d x %d)\n", grid, cus, per_cu);
    }
    if (grid < 0) return;
    (void)hipMemsetAsync((char*)d_ws + WS_CTL, 0, CTL_ZERO, stream);
    Args a{};
    for (int i = 0; i < 19; ++i) a.in[i] = (const float*)d_in[i];
    a.out = (float*)d_out; a.ws = (unsigned char*)d_ws;
#if MK_MULTI
    for (int ph = 0; ph < NPHASE; ++ph) { a.ph_lo = ph; a.ph_hi = ph + 1; hipLaunchKernelGGL(mega, dim3(grid), dim3(512), LDS_BYTES, stream, a); }
#else
    a.ph_lo = 0; a.ph_hi = NPHASE;
    void* args[] = {&a};
    hipError_t e = hipLaunchCooperativeKernel((const void*)mega, dim3(grid), dim3(512), args, LDS_BYTES, stream);
    if (e != hipSuccess) fprintf(stderr, "kernel_launch: cooperative launch failed: %s (grid %d)\n", hipGetErrorString(e), grid);
#endif
}
```

```cpp
#include <hip/hip_runtime.h>
#include <hip/hip_cooperative_groups.h>
#include <cstdio>
#include <cstdint>
namespace cg = cooperative_groups;

#ifndef PHMASK
#define PHMASK 0xFFFF
#endif
#ifndef REP_MASK
#define REP_MASK 0
#endif
#ifndef EXTRA_SYNCS
#define EXTRA_SYNCS 0
#endif
#ifndef CHAIN_TWICE
#define CHAIN_TWICE 0
#endif
#ifndef MK_MULTI
#define MK_MULTI 0
#endif

typedef unsigned short bf16_t;
typedef short bf16x8 __attribute__((ext_vector_type(8)));
typedef short s16x4 __attribute__((ext_vector_type(4)));
typedef float f32x4 __attribute__((ext_vector_type(4)));
typedef float f32x16 __attribute__((ext_vector_type(16)));
typedef unsigned u32x4 __attribute__((ext_vector_type(4)));
typedef unsigned u32x2 __attribute__((ext_vector_type(2)));

constexpr int TT = 8192, DM = 2048, SEQ = 2048, INC = 11776, DFF = 5632, PLE = 256, NLAYER = 2;
constexpr float EPS = 1e-6f;

typedef float f32x2_t __attribute__((ext_vector_type(2))); typedef __bf16 bf16x2_t __attribute__((ext_vector_type(2)));
__device__ __forceinline__ unsigned cvt_pk_bf16(float lo, float hi) { const f32x2_t v = {lo, hi}; const bf16x2_t b = __builtin_convertvector(v, bf16x2_t); return __builtin_bit_cast(unsigned, b); }
__device__ __forceinline__ float bf2f(unsigned short b) { return __uint_as_float(((unsigned)b) << 16); }
__device__ __forceinline__ float bflo(unsigned w) { return __uint_as_float(w << 16); }
__device__ __forceinline__ float bfhi(unsigned w) { return __uint_as_float(w & 0xffff0000u); }
__device__ __forceinline__ float sigmoidf_(float x) { return __builtin_amdgcn_rcpf(1.0f + __builtin_amdgcn_exp2f(x * -1.4426950408889634f)); }
__device__ __forceinline__ bf16x8 pack8(float a0, float a1, float a2, float a3, float a4, float a5, float a6, float a7) {
    u32x4 w; w.x = cvt_pk_bf16(a0, a1); w.y = cvt_pk_bf16(a2, a3); w.z = cvt_pk_bf16(a4, a5); w.w = cvt_pk_bf16(a6, a7);
    return __builtin_bit_cast(bf16x8, w);
}
__device__ __forceinline__ int crow(int r, int hi) { return (r & 3) + 8 * (r >> 2) + 4 * hi; }
__device__ __forceinline__ int opaque_tid() { int t = threadIdx.x; asm volatile("" : "+v"(t)); return t; }
__device__ __forceinline__ float shflx(float v, int m, int lane) { return __int_as_float(__builtin_amdgcn_ds_bpermute((lane ^ m) << 2, __float_as_int(v))); }
#define MFMA32(a, b, c) __builtin_amdgcn_mfma_f32_32x32x16_bf16((a), (b), (c), 0, 0, 0)

namespace pg8 {
#define PG8_LAS __attribute__((address_space(3)))
constexpr int BM = 256, BK = 64, HALF = 128, HTB = HALF * BK * 2, STAGE_BYTES = 8 * HTB, NXCD = 8, WGM = 8;
__host__ __device__ __forceinline__ int lds_byte(int r, int c) { const int st = (r >> 4) * 2 + (c >> 5), rr = r & 15, cc = c & 31, ob = rr * 64 + cc * 2; return st * 1024 + (ob ^ (((ob >> 9) & 1) << 5)); }
__host__ __device__ __forceinline__ void stage_rc(int b, int& R, int& C) { const int st = b / 1024, sb = b % 1024, swz = sb ^ (((sb >> 9) & 1) << 5); R = (st >> 1) * 16 + swz / 64; C = (st & 1) * 32 + (swz % 64) / 2; }
__host__ __device__ __forceinline__ int perm32(int rho) { const int n = rho >> 4, i = rho & 15; return 8 * (i >> 2) + 4 * n + (i & 3); }

struct Unit { int pm, pn, kind; };
struct Gemm { const bf16_t* A; const bf16_t* Bt; int M, N, lda, ldb; int nseg; int kofs0, kofs1, kofs2; int nt0, nt1, nt2; };

struct StaticOrder {
    int nM, nN, nwg, G, c, nseg;
    __device__ void init(int M, int N, int G_, int c_, int nseg_) { nM = M / BM; nN = N / BM; nwg = nM * nN; G = G_; c = c_; nseg = nseg_; }
    __device__ bool next(int i, Unit& u) const {
        int j = i, kd = 0; if (nseg == 3) { j = i / 3; kd = i - 3 * j; }
        u.kind = kd;
        const long L = (long)j * G + c; if (L >= nwg) return false;
        int wgid = (int)L; { const int q = nwg / NXCD, r = nwg % NXCD, xcd = wgid % NXCD, off = wgid / NXCD; wgid = (xcd < r ? xcd * (q + 1) : r * (q + 1) + (xcd - r) * q) + off; }
        const int nig = WGM * nN, gid = wgid / nig, fm = gid * WGM, gsz = (nM - fm) < WGM ? (nM - fm) : WGM;
        u.pm = fm + ((wgid % nig) % gsz); u.pn = (wgid % nig) / gsz; return true;
    }
};

struct OneUnit { int pm, pn; __device__ bool next(int i, Unit& u) const { u.pm = pm; u.pn = pn; u.kind = 0; return i == 0; } };
template <class Epi, class Sched>
__device__ __forceinline__ void gemm_phase(PG8_LAS unsigned char* lds, const Gemm g, const Sched& S, const Epi& E) {
    const int tid = opaque_tid(), wid = __builtin_amdgcn_readfirstlane(tid >> 6), lane = tid & 63, wr = wid >> 2, wc = wid & 3, fr = lane & 15, fq = lane >> 4;
    unsigned voffA, voffB;
    { int R, C; stage_rc(tid * 16, R, C); const int Rb = (R & ~31) + perm32(R & 31);
      voffA = (unsigned)(R * g.lda + C) * 2u; voffB = (unsigned)(Rb * g.ldb + C) * 2u; }
    const size_t qstepoffA = (size_t)64 * g.lda * 2, qstepoffB = (size_t)64 * g.ldb * 2;
    const size_t kstep = (size_t)(BK * 2);
    const size_t hstepA = (size_t)HALF * g.lda * 2, hstepB = (size_t)HALF * g.ldb * 2;
    const size_t tstepA = 2 * hstepA, tstepB = 2 * hstepB;
    const unsigned ldsw = (unsigned)wid * 1024u;
    const int aoff = lds_byte(wr * 64 + fr, fq * 8), boff = lds_byte(wc * 32 + fr, fq * 8);
#define PG8_SA(b, h) (((b) * 2 + (h)) * HTB)
#define PG8_SB(b, h) ((4 + (b) * 2 + (h)) * HTB)
#define PG8_STAGE(bufoff, gbase, voff) do { _Pragma("unroll") for (int _i = 0; _i < 2; ++_i) \
        __builtin_amdgcn_global_load_lds((const unsigned*)((const char*)(gbase) + (size_t)_i * qstep##voff + v##voff), (PG8_LAS unsigned*)(lds + (bufoff) + ldsw + _i * 8192), 16, 0, 0); } while (0)
#define PG8_LDA(dst, b, h) do { _Pragma("unroll") for (int m = 0; m < 4; ++m) _Pragma("unroll") for (int k = 0; k < 2; ++k) dst[m][k] = *(const PG8_LAS bf16x8*)(lds + PG8_SA(b, h) + aoff + m * 2048 + k * 1024); } while (0)
#define PG8_LDB(dst, b, h) do { _Pragma("unroll") for (int n = 0; n < 2; ++n) _Pragma("unroll") for (int k = 0; k < 2; ++k) dst[n][k] = *(const PG8_LAS bf16x8*)(lds + PG8_SB(b, h) + boff + n * 2048 + k * 1024); } while (0)
#define PG8_MMA(ai, bj, At, Bt) do { __builtin_amdgcn_s_setprio(1); _Pragma("unroll") for (int m = 0; m < 4; ++m) _Pragma("unroll") for (int n = 0; n < 2; ++n) _Pragma("unroll") for (int k = 0; k < 2; ++k) \
        acc[ai][bj][m][n] = __builtin_amdgcn_mfma_f32_16x16x32_bf16(Bt[n][k], At[m][k], acc[ai][bj][m][n], 0, 0, 0); __builtin_amdgcn_s_setprio(0); } while (0)
#define PG8_WAIT_V(n) asm volatile("s_waitcnt vmcnt(" #n ")" ::: "memory")
#define PG8_WAIT_L(n) asm volatile("s_waitcnt lgkmcnt(" #n ")" ::: "memory")
#define PG8_BAR __builtin_amdgcn_s_barrier()
#define PG8_SCHED __builtin_amdgcn_sched_barrier(0)
#define PG8_KOFS(u) ((u).kind == 0 ? g.kofs0 : ((u).kind == 1 ? g.kofs1 : g.kofs2))
#define PG8_NT(u) ((u).kind == 0 ? g.nt0 : ((u).kind == 1 ? g.nt1 : g.nt2))
    Unit cur, nxt; int ui = 0;
    if (!S.next(0, cur)) return;
    f32x4 acc[2][2][4][2];
#pragma unroll
    for (int a = 0; a < 2; ++a)
#pragma unroll
        for (int b = 0; b < 2; ++b)
#pragma unroll
            for (int m = 0; m < 4; ++m)
#pragma unroll
                for (int n = 0; n < 2; ++n) acc[a][b][m][n] = (f32x4){0.f, 0.f, 0.f, 0.f};
    bf16x8 At[4][2], B0[2][2], B1[2][2];
    const char* cA = (const char*)g.A + (size_t)cur.pm * tstepA + (size_t)PG8_KOFS(cur) * 2; const char* cB = (const char*)g.Bt + (size_t)cur.pn * tstepB + (size_t)PG8_KOFS(cur) * 2;
    PG8_STAGE(PG8_SB(0, 0), cB, offB); PG8_STAGE(PG8_SB(0, 1), cB + hstepB, offB); PG8_STAGE(PG8_SA(0, 0), cA, offA); PG8_STAGE(PG8_SA(0, 1), cA + hstepA, offA);
    if (wr == 1) PG8_BAR;
    PG8_WAIT_V(2); PG8_BAR;
    PG8_STAGE(PG8_SB(1, 0), cB + kstep, offB); PG8_STAGE(PG8_SA(1, 0), cA + kstep, offA); PG8_STAGE(PG8_SB(1, 1), cB + hstepB + kstep, offB);
    PG8_WAIT_V(6); PG8_BAR;
    for (;;) {
        const bool has_next = S.next(ui + 1, nxt);
        const char* nA = has_next ? (const char*)g.A + (size_t)nxt.pm * tstepA + (size_t)PG8_KOFS(nxt) * 2 : cA;
        const char* nB = has_next ? (const char*)g.Bt + (size_t)nxt.pn * tstepB + (size_t)PG8_KOFS(nxt) * 2 : cB;
        const int nt = PG8_NT(cur);
        for (int t = 0; t < nt; t += 2) {
            const bool last = (t == nt - 2);
            const char* a1 = cA + (size_t)(t + 1) * kstep;
            const char* a2 = last ? nA : cA + (size_t)(t + 2) * kstep; const char* b2 = last ? nB : cB + (size_t)(t + 2) * kstep;
            const char* a3 = a2 + kstep; const char* b3 = b2 + kstep;
            PG8_LDB(B0, 0, 0); PG8_LDB(B1, 0, 1); PG8_SCHED; PG8_LDA(At, 0, 0); PG8_STAGE(PG8_SA(1, 1), a1 + hstepA, offA);
            PG8_WAIT_V(8); PG8_WAIT_L(0); PG8_BAR; PG8_MMA(0, 0, At, B0); PG8_MMA(0, 1, At, B1); PG8_BAR; PG8_SCHED;
            PG8_LDA(At, 0, 1); PG8_STAGE(PG8_SB(0, 0), b2, offB); PG8_STAGE(PG8_SB(0, 1), b2 + hstepB, offB); PG8_STAGE(PG8_SA(0, 0), a2, offA);
            PG8_WAIT_V(8); PG8_WAIT_L(0); PG8_BAR; PG8_MMA(1, 0, At, B0); PG8_MMA(1, 1, At, B1); PG8_BAR; PG8_SCHED;
            PG8_LDB(B0, 1, 0); PG8_LDB(B1, 1, 1); PG8_SCHED; PG8_LDA(At, 1, 0); PG8_STAGE(PG8_SA(0, 1), a2 + hstepA, offA);
            PG8_WAIT_V(8); PG8_WAIT_L(0); PG8_BAR; PG8_MMA(0, 0, At, B0); PG8_MMA(0, 1, At, B1); PG8_BAR; PG8_SCHED;
            PG8_LDA(At, 1, 1); PG8_STAGE(PG8_SB(1, 0), b3, offB); PG8_STAGE(PG8_SB(1, 1), b3 + hstepB, offB); PG8_STAGE(PG8_SA(1, 0), a3, offA);
            PG8_WAIT_V(8); PG8_WAIT_L(0); PG8_BAR; PG8_MMA(1, 0, At, B0); PG8_MMA(1, 1, At, B1); PG8_BAR; PG8_SCHED;
        }
        if (wr == 0) PG8_BAR;
        const bool keep = E(acc, cur, wr, wc, fr, fq);
        if (!has_next) break;
        if (!keep) {
#pragma unroll
        for (int a = 0; a < 2; ++a)
#pragma unroll
            for (int b = 0; b < 2; ++b)
#pragma unroll
                for (int m = 0; m < 4; ++m)
#pragma unroll
                    for (int n = 0; n < 2; ++n) acc[a][b][m][n] = (f32x4){0.f, 0.f, 0.f, 0.f};
        }
        cur = nxt; cA = nA; cB = nB; ++ui;
        if (wr == 1) PG8_BAR;
    }
    PG8_WAIT_V(0);
    PG8_BAR;
#undef PG8_SA
#undef PG8_SB
#undef PG8_STAGE
#undef PG8_LDA
#undef PG8_LDB
#undef PG8_MMA
#undef PG8_WAIT_V
#undef PG8_WAIT_L
#undef PG8_BAR
#undef PG8_SCHED
#undef PG8_KOFS
#undef PG8_NT
}
}

constexpr size_t MiB = 1u << 20;
constexpr size_t WS_CTL = 0;
constexpr size_t WS_W0 = 1 * MiB;
constexpr size_t WL_IN = 0, WL_BR = 46 * MiB, WL_OUT = 54 * MiB, WL_GU = 62 * MiB, WL_DN = 106 * MiB, WL_PG = 128 * MiB, WL_PP = 136 * MiB, WL_SIZE = 137 * MiB;
constexpr size_t WS_H = WS_W0 + 2 * WL_SIZE;
constexpr size_t WS_X = WS_H + 32 * MiB;
constexpr size_t WS_U = WS_X + 64 * MiB;
constexpr size_t WS_SQ = WS_U + 16 * MiB;
constexpr size_t WS_SK = WS_SQ + 16 * MiB;
constexpr size_t WS_VT = WS_SK + 16 * MiB;
constexpr size_t WS_ZF = WS_VT + 16 * MiB;
constexpr size_t WS_HV = WS_ZF + 16 * MiB;
constexpr size_t WS_HQ = WS_HV + 8 * MiB;
constexpr size_t WS_OG = WS_HQ + 16 * MiB;
constexpr size_t WS_GT = WS_OG + 8 * MiB;
constexpr size_t WS_ACT = WS_GT;
constexpr size_t WS_Y = WS_GT + 96 * MiB;
constexpr size_t WS_MIX = WS_Y + 32 * MiB;
constexpr size_t WS_PB = WS_MIX + 32 * MiB;
constexpr size_t WS_HVT = WS_PB + 8 * MiB;
constexpr size_t WS_HDEC = WS_HVT + 8 * MiB;
constexpr size_t WS_HB = WS_HDEC + 1 * MiB;
constexpr size_t WS_PPB = WS_HB + 32 * MiB;
constexpr size_t WS_END = WS_PPB + 32 * MiB;
constexpr size_t WS_HOI = WS_MIX;
constexpr size_t WS_HQD = WS_MIX + 16 * MiB;
constexpr size_t WS_HKD = WS_MIX + 24 * MiB;
constexpr size_t CTL_SS = 65536;
constexpr size_t CTL_ZERO = CTL_SS + 7 * TT * 4;

constexpr int LDS_PSUM_OFF = 132096;
typedef f32x4 AccT[2][2][4][2];
#define EPI_LOOP_BEGIN  const int row0_ = u.pm * 256 + wr * 64 + fr; \
    _Pragma("unroll") for (int ai = 0; ai < 2; ++ai) _Pragma("unroll") for (int m = 0; m < 4; ++m) { const int row = row0_ + ai * 128 + m * 16; \
    _Pragma("unroll") for (int bj = 0; bj < 2; ++bj) { const int col = u.pn * 256 + bj * 128 + wc * 32 + 8 * fq; f32x4 v0 = acc[ai][bj][m][0], v1 = acc[ai][bj][m][1];
#define EPI_LOOP_END }}
__device__ __forceinline__ float rstd_of(float ss) { return __builtin_amdgcn_rsqf(ss * (1.0f / DM) + EPS); }
__device__ __forceinline__ float rstd_row(const float* SSP, int row) { const f32x4 a = *(const f32x4*)(SSP + (size_t)row * 8), b = *(const f32x4*)(SSP + (size_t)row * 8 + 4);
    return rstd_of(((a[0] + a[1]) + (a[2] + a[3])) + ((b[0] + b[1]) + (b[2] + b[3]))); }
__device__ __forceinline__ void ps_write(int rit, int wc, float sq) {
    extern __shared__ __attribute__((aligned(16))) unsigned char lds_e_[];
    ((float*)(lds_e_ + LDS_PSUM_OFF))[rit * 4 + wc] = sq;
}
__device__ __forceinline__ void ps_finish(float* SSP, const pg8::Unit& u, int wr, int wc, int fr, int fq) {
    extern __shared__ __attribute__((aligned(16))) unsigned char lds_e_[];
    const float* PS = (const float*)(lds_e_ + LDS_PSUM_OFF);
    asm volatile("s_waitcnt lgkmcnt(0)" ::: "memory"); __builtin_amdgcn_s_barrier(); asm volatile("" ::: "memory");
    const int t_ = (wr * 4 + wc) * 64 + fq * 16 + fr;
    if (t_ < 256) { const f32x4 p = *(const f32x4*)(PS + t_ * 4); SSP[(size_t)(u.pm * 256 + t_) * 8 + u.pn] = (p[0] + p[1]) + (p[2] + p[3]); }
}
#define EPI_LOOP_BEGIN_R(SSP)  const int row0_ = u.pm * 256 + wr * 64 + fr; \
    _Pragma("unroll") for (int ai = 0; ai < 2; ++ai) _Pragma("unroll") for (int m = 0; m < 4; ++m) { const int row = row0_ + ai * 128 + m * 16; const float rs_ = rstd_row((SSP), row); \
    _Pragma("unroll") for (int bj = 0; bj < 2; ++bj) { const int col = u.pn * 256 + bj * 128 + wc * 32 + 8 * fq; f32x4 v0 = acc[ai][bj][m][0] * rs_, v1 = acc[ai][bj][m][1] * rs_;

__device__ __forceinline__ u32x4 pack8v(f32x4 v0, f32x4 v1) { u32x4 w; w.x = cvt_pk_bf16(v0[0], v0[1]); w.y = cvt_pk_bf16(v0[2], v0[3]); w.z = cvt_pk_bf16(v1[0], v1[1]); w.w = cvt_pk_bf16(v1[2], v1[3]); return w; }

struct EpiIn {
    unsigned char* ws; int ssofs;
    __device__ __forceinline__ bool operator()(AccT& acc, const pg8::Unit& u, int wr, int wc, int fr, int fq) const {
        float* U = (float*)(ws + WS_U); bf16_t* SQ = (bf16_t*)(ws + WS_SQ); bf16_t* SK = (bf16_t*)(ws + WS_SK); bf16_t* VT = (bf16_t*)(ws + WS_VT); float* ZF = (float*)(ws + WS_ZF);
        bf16_t* HV = (bf16_t*)(ws + WS_HV); float* HQ = (float*)(ws + WS_HQ); bf16_t* OG = (bf16_t*)(ws + WS_OG); bf16_t* GT = (bf16_t*)(ws + WS_GT);
        const float* SS = (const float*)(ws + WS_X) + (size_t)ssofs * 8; const float qscale = 0.08838834764831845f * 1.4426950408889634f;
        const int colt = u.pn * 256;
        if (colt < 512) {
            EPI_LOOP_BEGIN_R(SS) float* p = U + (size_t)row * 512 + col; *(f32x4*)p = v0; *(f32x4*)(p + 4) = v1; EPI_LOOP_END
        } else if (colt < 1536) {
            const float s = qscale;
            EPI_LOOP_BEGIN_R(SS) *(u32x4*)(SQ + (size_t)row * 1024 + (col - 512)) = pack8v(v0 * s, v1 * s); EPI_LOOP_END
        } else if (colt < 2560) {
            EPI_LOOP_BEGIN_R(SS) *(u32x4*)(SK + (size_t)row * 1024 + (col - 1536)) = pack8v(v0, v1); EPI_LOOP_END
        } else if (colt < 3584) {
            EPI_LOOP_BEGIN_R(SS) const int cc = col - 2560, hh = cc >> 7, d = cc & 127, b = row >> 11, s = row & 2047;
                bf16_t* p = VT + (((size_t)(b * 8 + hh) * 128 + d) << 11) + s; const u32x4 w = pack8v(v0, v1);
                p[0] = (bf16_t)(w.x & 0xffff); p[2048] = (bf16_t)(w.x >> 16); p[2 * 2048] = (bf16_t)(w.y & 0xffff); p[3 * 2048] = (bf16_t)(w.y >> 16);
                p[4 * 2048] = (bf16_t)(w.z & 0xffff); p[5 * 2048] = (bf16_t)(w.z >> 16); p[6 * 2048] = (bf16_t)(w.w & 0xffff); p[7 * 2048] = (bf16_t)(w.w >> 16); EPI_LOOP_END
        } else if (colt < 4096) {
            EPI_LOOP_BEGIN_R(SS) float* p = ZF + (size_t)row * 512 + (col - 3584); *(f32x4*)p = v0; *(f32x4*)(p + 4) = v1; EPI_LOOP_END
        } else if (colt < 4608) {
            EPI_LOOP_BEGIN_R(SS) *(u32x4*)(HV + (size_t)row * 512 + (col - 4096)) = pack8v(v0, v1); EPI_LOOP_END
        } else if (colt < 5120) {
            EPI_LOOP_BEGIN_R(SS)
#pragma unroll
                for (int j = 0; j < 4; ++j) { v0[j] = v0[j] * sigmoidf_(v0[j]); v1[j] = v1[j] * sigmoidf_(v1[j]); }
                float* p = HQ + (size_t)row * 512 + (col - 4608); *(f32x4*)p = v0; *(f32x4*)(p + 4) = v1; EPI_LOOP_END
        } else if (colt < 5632) {
            EPI_LOOP_BEGIN_R(SS)
#pragma unroll
                for (int j = 0; j < 4; ++j) { v0[j] = v0[j] * sigmoidf_(v0[j]); v1[j] = v1[j] * sigmoidf_(v1[j]); }
                *(u32x4*)(OG + (size_t)row * 512 + (col - 5120)) = pack8v(v0, v1); EPI_LOOP_END
        } else {
            EPI_LOOP_BEGIN_R(SS)
#pragma unroll
                for (int j = 0; j < 4; ++j) { v0[j] = sigmoidf_(v0[j]); v1[j] = sigmoidf_(v1[j]); }
                *(u32x4*)(GT + (size_t)row * 6144 + (col - 5632)) = pack8v(v0, v1); EPI_LOOP_END
        }
        return false;
    }
};
struct EpiBranch {
    unsigned char* ws;
    __device__ __forceinline__ bool operator()(AccT& acc, const pg8::Unit& u, int wr, int wc, int fr, int fq) const {
        const bf16_t* GT = (const bf16_t*)(ws + WS_GT); bf16_t* MIX = (bf16_t*)(ws + WS_MIX);
        const int kind = u.kind;
        const int row0_ = u.pm * 256 + wr * 64 + fr;
#pragma unroll
        for (int ai = 0; ai < 2; ++ai)
#pragma unroll
            for (int m = 0; m < 4; ++m) { const int row = row0_ + ai * 128 + m * 16;
#pragma unroll
                for (int bj = 0; bj < 2; ++bj) { const int col = u.pn * 256 + bj * 128 + wc * 32 + 8 * fq;
                    const u32x4 ga = *(const u32x4*)(GT + (size_t)row * 6144 + kind * 2048 + col);
                    float a[8] = {bflo(ga.x), bfhi(ga.x), bflo(ga.y), bfhi(ga.y), bflo(ga.z), bfhi(ga.z), bflo(ga.w), bfhi(ga.w)};
#pragma unroll
                    for (int j = 0; j < 8; ++j) a[j] = fmaxf(a[j], 1e-30f);
                    if (kind < 2) {
                        const u32x4 gb = *(const u32x4*)(GT + (size_t)row * 6144 + (kind + 1) * 2048 + col);
                        float b[8] = {bflo(gb.x), bfhi(gb.x), bflo(gb.y), bfhi(gb.y), bflo(gb.z), bfhi(gb.z), bflo(gb.w), bfhi(gb.w)};
#pragma unroll
                        for (int j = 0; j < 8; ++j) { const float rr = a[j] * __builtin_amdgcn_rcpf(fmaxf(b[j], 1e-30f)); if (j < 4) acc[ai][bj][m][0][j] *= rr; else acc[ai][bj][m][1][j - 4] *= rr; }
                    } else {
                        f32x4 v0 = acc[ai][bj][m][0], v1 = acc[ai][bj][m][1];
#pragma unroll
                        for (int j = 0; j < 4; ++j) { v0[j] *= a[j]; v1[j] *= a[j + 4]; }
                        *(u32x4*)(MIX + (size_t)row * 2048 + col) = pack8v(v0, v1);
                    }
                } }
        return kind < 2;
    }
};
struct EpiResid {
    unsigned char* ws; int rboff, xboff, ssofs;
    __device__ __forceinline__ bool operator()(AccT& acc, const pg8::Unit& u, int wr, int wc, int fr, int fq) const {
        const bf16_t* RB = (const bf16_t*)(ws + WS_H + (size_t)rboff); bf16_t* XB = (bf16_t*)(ws + WS_H + (size_t)xboff); float* SSO = (float*)(ws + WS_X) + (size_t)ssofs * 8;
        const int row0_ = u.pm * 256 + wr * 64 + fr;
#pragma unroll
        for (int ai = 0; ai < 2; ++ai)
#pragma unroll
            for (int m = 0; m < 4; ++m) { const int row = row0_ + ai * 128 + m * 16; float sq = 0.f;
#pragma unroll
                for (int bj = 0; bj < 2; ++bj) { const int col = u.pn * 256 + bj * 128 + wc * 32 + 8 * fq; const size_t o = (size_t)row * 2048 + col;
                    const u32x4 rw = *(const u32x4*)(RB + o); f32x4 v0 = acc[ai][bj][m][0], v1 = acc[ai][bj][m][1];
                    v0[0] += bflo(rw.x); v0[1] += bfhi(rw.x); v0[2] += bflo(rw.y); v0[3] += bfhi(rw.y); v1[0] += bflo(rw.z); v1[1] += bfhi(rw.z); v1[2] += bflo(rw.w); v1[3] += bfhi(rw.w);
                    *(u32x4*)(XB + o) = pack8v(v0, v1);
                    sq += (v0[0] * v0[0] + v0[1] * v0[1]) + (v0[2] * v0[2] + v0[3] * v0[3]) + (v1[0] * v1[0] + v1[1] * v1[1]) + (v1[2] * v1[2] + v1[3] * v1[3]); }
                sq += shflx(sq, 16, fr + 16 * fq); sq += shflx(sq, 32, fr + 16 * fq); if (fq == 0) ps_write(ai * 128 + wr * 64 + m * 16 + fr, wc, sq); }
        ps_finish(SSO, u, wr, wc, fr, fq);
        return false;
    }
};
struct EpiSwiglu {
    unsigned char* ws; int ssofs;
    __device__ __forceinline__ bool operator()(AccT& acc, const pg8::Unit& u, int wr, int wc, int fr, int fq) const {
        bf16_t* ACT = (bf16_t*)(ws + WS_ACT); const float* SS = (const float*)(ws + WS_X) + (size_t)ssofs * 8;
        const int row0_ = u.pm * 256 + wr * 64 + fr;
#pragma unroll
        for (int ai = 0; ai < 2; ++ai)
#pragma unroll
            for (int m = 0; m < 4; ++m) { const int row = row0_ + ai * 128 + m * 16; const int col = u.pn * 128 + wc * 32 + 8 * fq; const float rs_ = rstd_row(SS, row);
                f32x4 g0 = acc[ai][0][m][0] * rs_, g1 = acc[ai][0][m][1] * rs_; const f32x4 u0 = acc[ai][1][m][0] * rs_, u1 = acc[ai][1][m][1] * rs_;
#pragma unroll
                for (int j = 0; j < 4; ++j) { g0[j] = g0[j] * sigmoidf_(g0[j]) * u0[j]; g1[j] = g1[j] * sigmoidf_(g1[j]) * u1[j]; }
                *(u32x4*)(ACT + (size_t)row * DFF + col) = pack8v(g0, g1); }
        return false;
    }
};
struct EpiBf16 {
    unsigned char* ws;
    __device__ __forceinline__ bool operator()(AccT& acc, const pg8::Unit& u, int wr, int wc, int fr, int fq) const {
        bf16_t* OUT = (bf16_t*)(ws + WS_PPB);
        EPI_LOOP_BEGIN *(u32x4*)(OUT + (size_t)row * 2048 + col) = pack8v(v0, v1); EPI_LOOP_END
        return false;
    }
};
struct EpiPle {
    unsigned char* ws; int ssofs;
    __device__ __forceinline__ bool operator()(AccT& acc, const pg8::Unit& u, int wr, int wc, int fr, int fq) const {
        const bf16_t* RB = (const bf16_t*)(ws + WS_HB); const bf16_t* PP = (const bf16_t*)(ws + WS_PPB); bf16_t* XB = (bf16_t*)(ws + WS_H);
        const float* SS = (const float*)(ws + WS_X) + (size_t)ssofs * 8; float* SSO = (float*)(ws + WS_X) + (size_t)(ssofs + TT) * 8;
        const int row0_ = u.pm * 256 + wr * 64 + fr;
#pragma unroll
        for (int ai = 0; ai < 2; ++ai)
#pragma unroll
            for (int m = 0; m < 4; ++m) { const int row = row0_ + ai * 128 + m * 16; const float rs_ = rstd_row(SS, row); float sq = 0.f;
#pragma unroll
                for (int bj = 0; bj < 2; ++bj) { const int col = u.pn * 256 + bj * 128 + wc * 32 + 8 * fq; const size_t o = (size_t)row * 2048 + col;
                    const u32x4 rw = *(const u32x4*)(RB + o); const u32x4 pw = *(const u32x4*)(PP + o);
                    f32x4 v0 = acc[ai][bj][m][0] * rs_, v1 = acc[ai][bj][m][1] * rs_;
                    v0[0] = bflo(rw.x) + sigmoidf_(v0[0]) * bflo(pw.x); v0[1] = bfhi(rw.x) + sigmoidf_(v0[1]) * bfhi(pw.x); v0[2] = bflo(rw.y) + sigmoidf_(v0[2]) * bflo(pw.y); v0[3] = bfhi(rw.y) + sigmoidf_(v0[3]) * bfhi(pw.y);
                    v1[0] = bflo(rw.z) + sigmoidf_(v1[0]) * bflo(pw.z); v1[1] = bfhi(rw.z) + sigmoidf_(v1[1]) * bfhi(pw.z); v1[2] = bflo(rw.w) + sigmoidf_(v1[2]) * bflo(pw.w); v1[3] = bfhi(rw.w) + sigmoidf_(v1[3]) * bfhi(pw.w);
                    *(u32x4*)(XB + o) = pack8v(v0, v1);
                    sq += (v0[0] * v0[0] + v0[1] * v0[1]) + (v0[2] * v0[2] + v0[3] * v0[3]) + (v1[0] * v1[0] + v1[1] * v1[1]) + (v1[2] * v1[2] + v1[3] * v1[3]); }
                sq += shflx(sq, 16, fr + 16 * fq); sq += shflx(sq, 32, fr + 16 * fq); if (fq == 0) ps_write(ai * 128 + wr * 64 + m * 16 + fr, wc, sq); }
        ps_finish(SSO, u, wr, wc, fr, fq);
        return false;
    }
};

constexpr int LDS_MISC = 131072, LDS_PSUM = 132096, LDS_BYTES = 132096 + 4096;
constexpr int PPL = 8;
constexpr int NPHASE = 2 + PPL * NLAYER;

struct Args { const float* in[19]; float* out; unsigned char* ws; int ph_lo, ph_hi; };

__device__ __forceinline__ float wave_sum(float v, int lane) {
#pragma unroll
    for (int o = 1; o < 64; o <<= 1) v += shflx(v, o, lane);
    return v;
}
template <bool F32OUT>
__device__ __forceinline__ void rmsnorm_rows(const float* X, const float* G, bf16_t* OB, float* OF) {
    const int tid_ = opaque_tid(); const int lane = tid_ & 63, gw = blockIdx.x * 8 + (tid_ >> 6), ngw = gridDim.x * 8;
    for (int row = gw; row < TT; row += ngw) {
        const f32x4* xr = (const f32x4*)(X + (size_t)row * DM) + lane;
        f32x4 v[8]; float s = 0.f;
#pragma unroll
        for (int j = 0; j < 8; ++j) { v[j] = xr[64 * j]; s += (v[j][0] * v[j][0] + v[j][1] * v[j][1]) + (v[j][2] * v[j][2] + v[j][3] * v[j][3]); }
        const float rstd = 1.0f / sqrtf(wave_sum(s, lane) * (1.0f / DM) + EPS);
#pragma unroll
        for (int j = 0; j < 8; ++j) { const f32x4 gg = ((const f32x4*)G)[lane + 64 * j]; const f32x4 y = v[j] * rstd * gg;
            if (F32OUT) ((f32x4*)(OF + (size_t)row * DM))[lane + 64 * j] = y;
            else { u32x2 w; w.x = cvt_pk_bf16(y[0], y[1]); w.y = cvt_pk_bf16(y[2], y[3]); ((u32x2*)(OB + (size_t)row * DM))[lane + 64 * j] = w; } }
    }
}

__device__ __forceinline__ void final_norm_rows(const bf16_t* XB, const float* SS, const float* G, float* OF) {
    const int tid_ = opaque_tid(); const int lane = tid_ & 63, gw = blockIdx.x * 8 + (tid_ >> 6), ngw = gridDim.x * 8;
    for (int row = gw; row < TT; row += ngw) {
        const float rstd = rstd_row(SS, row);
#pragma unroll
        for (int j = 0; j < 4; ++j) { const u32x4 w = ((const u32x4*)(XB + (size_t)row * DM))[lane + 64 * j];
            const f32x4 ga = ((const f32x4*)G)[2 * (lane + 64 * j)], gb = ((const f32x4*)G)[2 * (lane + 64 * j) + 1];
            f32x4 y0, y1; y0[0] = bflo(w.x) * rstd * ga[0]; y0[1] = bfhi(w.x) * rstd * ga[1]; y0[2] = bflo(w.y) * rstd * ga[2]; y0[3] = bfhi(w.y) * rstd * ga[3];
            y1[0] = bflo(w.z) * rstd * gb[0]; y1[1] = bfhi(w.z) * rstd * gb[1]; y1[2] = bflo(w.w) * rstd * gb[2]; y1[3] = bfhi(w.w) * rstd * gb[3];
            ((f32x4*)(OF + (size_t)row * DM))[2 * (lane + 64 * j)] = y0; ((f32x4*)(OF + (size_t)row * DM))[2 * (lane + 64 * j) + 1] = y1; }
    }
}
__device__ __forceinline__ void rows_bf16_ss(const float* X, bf16_t* OB, float* SSO) {
    const int tid_ = opaque_tid(); const int lane = tid_ & 63, gw = blockIdx.x * 8 + (tid_ >> 6), ngw = gridDim.x * 8;
    for (int row = gw; row < TT; row += ngw) {
        const f32x4* xr = (const f32x4*)(X + (size_t)row * DM) + lane; float s = 0.f;
#pragma unroll
        for (int j = 0; j < 8; ++j) { const f32x4 v = xr[64 * j]; s += (v[0] * v[0] + v[1] * v[1]) + (v[2] * v[2] + v[3] * v[3]);
            u32x2 w; w.x = cvt_pk_bf16(v[0], v[1]); w.y = cvt_pk_bf16(v[2], v[3]); ((u32x2*)(OB + (size_t)row * DM))[lane + 64 * j] = w; }
        s = wave_sum(s, lane); if (lane == 0) { float z = 0.f; asm volatile("" : "+v"(z)); *(f32x4*)(SSO + (size_t)row * 8) = (f32x4){s, z, z, z}; *(f32x4*)(SSO + (size_t)row * 8 + 4) = (f32x4){z, z, z, z}; }
    }
}
struct TJob { const float* src; const float* gain; bf16_t* dst; int N, ldd, k0, n0, drow0, dk0; };
__device__ __forceinline__ TJob tjob_decode(const Args& a, int it) {
    constexpr int C_IN = 16 * 92, C_BP = 4 * 16, C_BS = 8 * 16, C_BH = 4 * 16, C_OUT = 256, C_GU = 16 * 88, C_DN = 44 * 16, C_PG = 256, C_PP = 2 * 16;
    constexpr int PER_L = C_IN + C_BP + C_BS + C_BH + C_OUT + C_GU + C_DN + C_PG + C_PP;
    const int L = it / PER_L; int r = it - L * PER_L;
    unsigned char* wl = a.ws + WS_W0 + (size_t)L * WL_SIZE;
    TJob J; J.gain = nullptr; J.dk0 = 0; int nkb, gu = 0;
    if (r < C_IN) { J.src = a.in[3] + (size_t)L * DM * INC; J.N = INC; J.dst = (bf16_t*)(wl + WL_IN); J.ldd = DM; nkb = 16; J.gain = a.in[2] + (size_t)L * DM; }
    else if ((r -= C_IN) < C_BP) { J.src = a.in[8] + (size_t)L * 512 * DM; J.N = DM; J.dst = (bf16_t*)(wl + WL_BR); J.ldd = DM; nkb = 4; }
    else if ((r -= C_BP) < C_BS) { J.src = a.in[9] + (size_t)L * 1024 * DM; J.N = DM; J.dst = (bf16_t*)(wl + WL_BR); J.ldd = DM; J.dk0 = 512; nkb = 8; }
    else if ((r -= C_BS) < C_BH) { J.src = a.in[10] + (size_t)L * 512 * DM; J.N = DM; J.dst = (bf16_t*)(wl + WL_BR); J.ldd = DM; J.dk0 = 1536; nkb = 4; }
    else if ((r -= C_BH) < C_OUT) { J.src = a.in[11] + (size_t)L * DM * DM; J.N = DM; J.dst = (bf16_t*)(wl + WL_OUT); J.ldd = DM; nkb = 16; }
    else if ((r -= C_OUT) < C_GU) { J.src = a.in[13] + (size_t)L * DM * 2 * DFF; J.N = 2 * DFF; J.dst = (bf16_t*)(wl + WL_GU); J.ldd = DM; nkb = 16; gu = 1; J.gain = a.in[12] + (size_t)L * DM; }
    else if ((r -= C_GU) < C_DN) { J.src = a.in[14] + (size_t)L * DFF * DM; J.N = DM; J.dst = (bf16_t*)(wl + WL_DN); J.ldd = DFF; nkb = 44; }
    else if ((r -= C_DN) < C_PG) { J.src = a.in[16] + (size_t)L * DM * DM; J.N = DM; J.dst = (bf16_t*)(wl + WL_PG); J.ldd = DM; nkb = 16; J.gain = a.in[15] + (size_t)L * DM; }
    else { r -= C_PG; J.src = a.in[17] + (size_t)L * PLE * DM; J.N = DM; J.dst = (bf16_t*)(wl + WL_PP); J.ldd = PLE; nkb = 2; }
    const int nb = r / nkb, kb = r - nb * nkb;
    J.drow0 = nb * 128; if (gu) J.drow0 = nb < 44 ? 256 * nb : 256 * (nb - 44) + 128;
    J.k0 = kb * 128; J.n0 = nb * 128;
    return J;
}
__device__ __forceinline__ void tjob_load(const TJob& J, int tid, f32x4 (&v)[8]) {
#pragma unroll
    for (int p = 0; p < 8; ++p) { const int k = p * 16 + (tid >> 5), c = (tid & 31) * 4;
        v[p] = __builtin_nontemporal_load((const f32x4*)(J.src + (size_t)(J.k0 + k) * J.N + J.n0 + c)); if (J.gain) v[p] = v[p] * J.gain[J.k0 + k]; }
}
__device__ __forceinline__ void tjob_finish(const TJob& J, int tid, const f32x4 (&v)[8], float* sm) {
#pragma unroll
    for (int p = 0; p < 8; ++p) { const int k = p * 16 + (tid >> 5), c = (tid & 31) * 4; float* s = sm + k * 129 + c; s[0] = v[p][0]; s[1] = v[p][1]; s[2] = v[p][2]; s[3] = v[p][3]; }
    __syncthreads();
#pragma unroll
    for (int i = 0; i < 4; ++i) { const int item = tid + 512 * i, c = item & 15, n = item >> 4; const float* s = sm + (8 * c) * 129 + n;
        u32x4 w; w.x = cvt_pk_bf16(s[0], s[129]); w.y = cvt_pk_bf16(s[2 * 129], s[3 * 129]); w.z = cvt_pk_bf16(s[4 * 129], s[5 * 129]); w.w = cvt_pk_bf16(s[6 * 129], s[7 * 129]);
        *(u32x4*)(J.dst + (size_t)(J.drow0 + n) * J.ldd + J.dk0 + J.k0 + 8 * c) = w; }
    __syncthreads();
}

__device__ __forceinline__ void prologue_phase(const Args& a, unsigned char* lds) {
    float* sm = (float*)lds;
    constexpr int N_ITEMS = NLAYER * (16 * 92 + 4 * 16 + 8 * 16 + 4 * 16 + 256 + 16 * 88 + 44 * 16 + 256 + 2 * 16);
    {   const int tid = opaque_tid();
        int it = blockIdx.x;
        if (it < N_ITEMS) {
            TJob J = tjob_decode(a, it); f32x4 v[8]; tjob_load(J, tid, v);
            for (;;) {
                const int itn = it + gridDim.x; const bool more = itn < N_ITEMS;
                TJob Jn = J; f32x4 vn[8];
#pragma unroll
                for (int p = 0; p < 8; ++p) vn[p] = v[p];
                if (more) { Jn = tjob_decode(a, itn); tjob_load(Jn, tid, vn); }
                tjob_finish(J, tid, v, sm);
                if (!more) break;
                J = Jn; it = itn;
#pragma unroll
                for (int p = 0; p < 8; ++p) v[p] = vn[p];
            }
        }
    }
    { const f32x4* ps = (const f32x4*)a.in[1]; u32x2* pd = (u32x2*)(a.ws + WS_PB); const int n4 = NLAYER * TT * PLE / 4;
      for (int i = blockIdx.x * 512 + opaque_tid(); i < n4; i += gridDim.x * 512) { const f32x4 v = ps[i]; u32x2 w; w.x = cvt_pk_bf16(v[0], v[1]); w.y = cvt_pk_bf16(v[2], v[3]); pd[i] = w; } }
    rows_bf16_ss(a.in[0], (bf16_t*)(a.ws + WS_H), (float*)(a.ws + WS_X));
}

__device__ __forceinline__ void pool_unit(unsigned char* lds, int tile, int gi, int L, const Args& a) {
    float* Wl = (float*)lds; float* uw = Wl + 128 * 128; float* mx = uw + 47 * 128;
    const int tid = opaque_tid();
    const float* U = (const float*)(a.ws + WS_U);
    const float* PW = a.in[4] + ((size_t)L * 4 + gi) * 128 * 128;
    const int t0 = tile * 32, s0 = t0 & (SEQ - 1);
#pragma unroll
    for (int i = 0; i < 8; ++i) ((f32x4*)Wl)[tid + 512 * i] = ((const f32x4*)PW)[tid + 512 * i];
    for (int i = tid; i < 47 * 32; i += 512) { const int rr = i >> 5, c4 = i & 31; const int sp = s0 - 15 + rr;
        f32x4 v = (f32x4){0.f, 0.f, 0.f, 0.f};
        if (sp >= 0) v = *(const f32x4*)(U + (size_t)(t0 - 15 + rr) * 512 + gi * 128 + c4 * 4);
        ((f32x4*)uw)[i] = v; }
    __syncthreads();
    const int w = 2 << gi;
    for (int i = tid; i < 32 * 128; i += 512) { const int tt = i >> 7, c = i & 127; float s = 0.f;
        for (int j = 0; j < w; ++j) s += uw[(15 + tt - j) * 128 + c];
        const int cnt = min(s0 + tt + 1, w);
        mx[i] = s / (float)cnt - uw[(15 + tt) * 128 + c]; }
    __syncthreads();
    const int d = tid & 127, tg = tid >> 7;
    float acc[8];
#pragma unroll
    for (int j = 0; j < 8; ++j) acc[j] = 0.f;
    for (int c = 0; c < 128; c += 4) {
        const float w0 = Wl[c * 128 + d], w1 = Wl[(c + 1) * 128 + d], w2 = Wl[(c + 2) * 128 + d], w3 = Wl[(c + 3) * 128 + d];
#pragma unroll
        for (int j = 0; j < 8; ++j) { const f32x4 mv = *(const f32x4*)(mx + (tg * 8 + j) * 128 + c); acc[j] += mv[0] * w0 + mv[1] * w1 + mv[2] * w2 + mv[3] * w3; }
    }
    const float sc = a.in[5][(size_t)L * 512 + gi * 128 + d];
    bf16_t* Y = (bf16_t*)(a.ws + WS_Y);
#pragma unroll
    for (int j = 0; j < 8; ++j) Y[(size_t)(t0 + tg * 8 + j) * 2048 + gi * 128 + d] = (bf16_t)(cvt_pk_bf16(acc[j] * sc, 0.f) & 0xffff);
    __syncthreads();
}

__device__ __forceinline__ void attn_unit(unsigned char* lds, int b, int h, int qb, const Args& a) {
    const bf16_t* SQ = (const bf16_t*)(a.ws + WS_SQ); const bf16_t* SK = (const bf16_t*)(a.ws + WS_SK); const bf16_t* VT = (const bf16_t*)(a.ws + WS_VT);
    bf16_t* Y = (bf16_t*)(a.ws + WS_Y);
    const int tid = opaque_tid(), lane = tid & 63, wid = tid >> 6, r = lane & 31, hi = lane >> 5;
    const int q0 = qb * 256, qw0 = q0 + wid * 32;
    const size_t rowbase = (size_t)b * SEQ;
    constexpr int KBY = 64 * 272, VBY = 128 * 144, BUF = KBY + VBY;
    volatile unsigned* FLG = (volatile unsigned*)(lds + 2 * BUF);
    bf16x8 qf[8];
    { const bf16_t* qp = SQ + (rowbase + qw0 + r) * 1024 + h * 128 + hi * 8;
#pragma unroll
      for (int ds = 0; ds < 8; ++ds) qf[ds] = *(const bf16x8*)(qp + ds * 16); }
    f32x16 o[4];
#pragma unroll
    for (int i = 0; i < 4; ++i)
#pragma unroll
        for (int j = 0; j < 16; ++j) o[i][j] = 0.f;
    float R = 1.f;
    const int jmax = qb * 4 + 3;
    u32x4 st[4];
#define ATT_LOAD(jj) do { _Pragma("unroll") for (int i = 0; i < 2; ++i) { const int ch = tid + 512 * i; \
        st[i] = *(const u32x4*)(SK + (rowbase + 64 * (jj) + (ch >> 4)) * 1024 + h * 128 + (ch & 15) * 8); \
        st[2 + i] = *(const u32x4*)(VT + (((size_t)(b * 8 + h) * 128 + (ch >> 3)) << 11) + 64 * (jj) + (ch & 7) * 8); } } while (0)
#define ATT_STORE(bufp) do { _Pragma("unroll") for (int i = 0; i < 2; ++i) { const int ch = tid + 512 * i; \
        *(u32x4*)((bufp) + (ch >> 4) * 272 + (ch & 15) * 16) = st[i]; *(u32x4*)((bufp) + KBY + (ch >> 3) * 144 + (ch & 7) * 16) = st[2 + i]; } } while (0)
    ATT_LOAD(jmax); ATT_STORE(lds);
    __syncthreads();
    for (int j = jmax; j >= 0; --j) {
        const int cur = (jmax - j) & 1;
        if (j > 0) ATT_LOAD(j - 1);
        if (64 * j <= qw0 + 31) {
            const unsigned char* Kb = lds + cur * BUF; const unsigned char* Vb = Kb + KBY;
            f32x16 p[2];
#pragma unroll
            for (int hh = 0; hh < 2; ++hh) {
#pragma unroll
                for (int jj = 0; jj < 16; ++jj) p[hh][jj] = 0.f;
#pragma unroll
                for (int ds = 0; ds < 8; ++ds) { const bf16x8 ka = *(const bf16x8*)(Kb + (32 * hh + r) * 272 + (16 * ds + 8 * hi) * 2); p[hh] = MFMA32(ka, qf[ds], p[hh]); }
            }
            const int t = qw0 + r; const int sbase = 64 * j + 4 * hi;
            float G[8];
#define ATT_ELEM(MASKED) \
            _Pragma("unroll") for (int hh = 0; hh < 2; ++hh) \
                _Pragma("unroll") for (int g = 0; g < 4; ++g) { \
                    float mm[4], bb[4]; \
                    _Pragma("unroll") for (int i = 0; i < 4; ++i) { const float uu = __builtin_amdgcn_exp2f(p[hh][4 * g + i]); \
                        const float mi = __builtin_amdgcn_rcpf(1.0f + uu); \
                        if (MASKED) { const int s = sbase + 32 * hh + 8 * g + i; const bool valid = s < t; mm[i] = valid ? mi : 1.0f; bb[i] = valid ? 1.0f - mi : 0.0f; } \
                        else { mm[i] = mi; bb[i] = 1.0f - mi; } } \
                    const float e2 = mm[3], e1 = mm[2] * e2, e0 = mm[1] * e1; \
                    G[hh * 4 + g] = mm[0] * e0; \
                    p[hh][4 * g + 0] = bb[0] * e0; p[hh][4 * g + 1] = bb[1] * e1; p[hh][4 * g + 2] = bb[2] * e2; p[hh][4 * g + 3] = bb[3]; \
                }
            if (64 * j + 63 < qw0) { ATT_ELEM(false) } else { ATT_ELEM(true) }
#undef ATT_ELEM
            float X = 1.0f;
#pragma unroll
            for (int idx = 7; idx >= 0; --idx) { const float gp = shflx(G[idx], 32, lane); const float f = X * (hi == 0 ? gp : 1.0f) * R;
                const int hh = idx >> 2, g = idx & 3;
#pragma unroll
                for (int i = 0; i < 4; ++i) p[hh][4 * g + i] *= f;
                X *= G[idx] * gp; }
            R *= X;
            bf16x8 pa[4];
#pragma unroll
            for (int kb = 0; kb < 4; ++kb) { const int hh = kb >> 1, b8 = (kb & 1) * 8;
                pa[kb] = pack8(p[hh][b8], p[hh][b8 + 1], p[hh][b8 + 2], p[hh][b8 + 3], p[hh][b8 + 4], p[hh][b8 + 5], p[hh][b8 + 6], p[hh][b8 + 7]); }
#pragma unroll
            for (int kb = 0; kb < 4; ++kb)
#pragma unroll
                for (int db = 0; db < 4; ++db) { const unsigned char* vp = Vb + (32 * db + r) * 144 + (16 * kb + 4 * hi) * 2;
                    const s16x4 lo = *(const s16x4*)vp, hi4 = *(const s16x4*)(vp + 16);
                    const bf16x8 vf = (bf16x8){lo[0], lo[1], lo[2], lo[3], hi4[0], hi4[1], hi4[2], hi4[3]};
                    o[db] = MFMA32(pa[kb], vf, o[db]); }
        }
        { const bool wdone = __builtin_amdgcn_ballot_w64(R != 0.0f) == 0ull;
          if (lane == 0) FLG[cur * 8 + wid] = wdone ? 1u : 0u; }
        if (j > 0) ATT_STORE(lds + (cur ^ 1) * BUF);
        __syncthreads();
        unsigned alld = 1u;
#pragma unroll
        for (int w = 0; w < 8; ++w) alld &= FLG[cur * 8 + w];
        if (alld) break;
    }
#undef ATT_LOAD
#undef ATT_STORE
#pragma unroll
    for (int db = 0; db < 4; ++db)
#pragma unroll
        for (int reg = 0; reg < 16; ++reg)
            Y[(rowbase + qw0 + crow(reg, hi)) * 2048 + 512 + h * 128 + 32 * db + r] = (bf16_t)(cvt_pk_bf16(o[db][reg], 0.f) & 0xffff);
    __syncthreads();
}

__device__ __forceinline__ void hgrn_prep_unit(unsigned char* lds, int bh, int c, int L, const Args& a) {
    const float* ZF = (const float*)(a.ws + WS_ZF); const float* HQ = (const float*)(a.ws + WS_HQ); const bf16_t* HV = (const bf16_t*)(a.ws + WS_HV);
    bf16_t* HQD = (bf16_t*)(a.ws + WS_HQD); bf16_t* HKD = (bf16_t*)(a.ws + WS_HKD); bf16_t* HVT = (bf16_t*)(a.ws + WS_HVT);
    float* HDEC = (float*)(a.ws + WS_HDEC); float* HOI = (float*)(a.ws + WS_HOI);
    const int b = bh >> 2, h = bh & 3;
    const int tid = opaque_tid(), lane = tid & 63, wid = tid >> 6, r = lane & 31, hi = lane >> 5;
    float* TOT = (float*)lds; unsigned char* QD = lds + 2048; unsigned char* KT = QD + 32 * 272; unsigned char* VTl = KT + 32 * 272;
    const int k = tid & 127, tq = tid >> 7;
    float lbA, lbB, oml;
    { const int ch = h * 128 + k; const float h0 = a.in[6][ch], h1 = a.in[6][512 + ch]; const float mxv = fmaxf(h0, h1);
      const float e0 = __expf(h0 - mxv), e1 = __expf(h1 - mxv); float lb = (L == 0) ? 0.f : e1 / (e0 + e1);
      lb = fminf(fmaxf(lb, 0.f), 1.f); lbA = fmaxf(lb, 1e-20f); lbB = 1.0f - fminf(lb, 1.0f - 1e-6f); oml = 1.0f - lb; }
    const size_t row0 = (size_t)b * SEQ + c * 32;
    const size_t gbase = (row0 + tq * 8) * 512 + h * 128 + k;
    const size_t fidx = (size_t)(bh * 64 + c) * 4096 + (size_t)((((k >> 5) * 2 + (tq >> 1)) * 64 + (tq & 1) * 32 + (k & 31)) * 8);
    float kk[8], bl[8], qv[8]; float bs = 0.f;
#pragma unroll
    for (int i = 0; i < 8; ++i) { float zf = ZF[gbase + (size_t)i * 512]; qv[i] = HQ[gbase + (size_t)i * 512];
        zf = fminf(fmaxf(zf, -80.f), 80.f); const float e = __expf(-zf); const float sg = __builtin_amdgcn_rcpf(1.0f + e);
        const float f = lbA + lbB * sg; bs += logf(f); bl[i] = bs; kk[i] = oml * e * sg; }
    TOT[tq * 128 + k] = bs;
    { unsigned short x[8];
#pragma unroll
      for (int i = 0; i < 8; ++i) x[i] = HV[gbase + (size_t)i * 512];
      u32x4 w; w.x = x[0] | ((unsigned)x[1] << 16); w.y = x[2] | ((unsigned)x[3] << 16); w.z = x[4] | ((unsigned)x[5] << 16); w.w = x[6] | ((unsigned)x[7] << 16);
      *(u32x4*)(VTl + k * 80 + tq * 16) = w; *(u32x4*)(HVT + fidx) = w; }
    __syncthreads();
    float off = 0.f, tot = 0.f;
#pragma unroll
    for (int q = 0; q < 4; ++q) { const float v = TOT[q * 128 + k]; tot += v; if (q < tq) off += v; }
    float kd[8];
#pragma unroll
    for (int i = 0; i < 8; ++i) { const float bt = off + bl[i]; const int t = tq * 8 + i;
        *(bf16_t*)(QD + t * 272 + k * 2) = (bf16_t)(cvt_pk_bf16(qv[i] * __expf(bt), 0.f) & 0xffff);
        *(bf16_t*)(KT + t * 272 + k * 2) = (bf16_t)(cvt_pk_bf16(kk[i] * __expf(fminf(-bt, 80.f)), 0.f) & 0xffff);
        kd[i] = kk[i] * __expf(tot - bt); }
    *(bf16x8*)(HKD + fidx) = pack8(kd[0], kd[1], kd[2], kd[3], kd[4], kd[5], kd[6], kd[7]);
    if (tq == 0) HDEC[(size_t)(bh * 64 + c) * 128 + k] = __expf(tot);
    __syncthreads();
    { const int k0 = 32 * (wid >> 1) + 16 * (wid & 1) + 4 * hi; const unsigned char* p = QD + r * 272 + k0 * 2;
      const s16x4 lo = *(const s16x4*)p, hi4 = *(const s16x4*)(p + 16);
      *(bf16x8*)(HQD + (size_t)(bh * 64 + c) * 4096 + (wid * 64 + lane) * 8) = (bf16x8){lo[0], lo[1], lo[2], lo[3], hi4[0], hi4[1], hi4[2], hi4[3]}; }
    if (wid < 4) {
        const int w = wid;
        f32x16 pt;
#pragma unroll
        for (int j = 0; j < 16; ++j) pt[j] = 0.f;
#pragma unroll
        for (int ks = 0; ks < 8; ++ks) { const bf16x8 ka = *(const bf16x8*)(KT + r * 272 + (16 * ks + 8 * hi) * 2); const bf16x8 qa = *(const bf16x8*)(QD + r * 272 + (16 * ks + 8 * hi) * 2);
            pt = MFMA32(ka, qa, pt); }
#pragma unroll
        for (int reg = 0; reg < 16; ++reg) { if (crow(reg, hi) > r) pt[reg] = 0.f; }
        const bf16x8 pa0 = pack8(pt[0], pt[1], pt[2], pt[3], pt[4], pt[5], pt[6], pt[7]);
        const bf16x8 pa1 = pack8(pt[8], pt[9], pt[10], pt[11], pt[12], pt[13], pt[14], pt[15]);
        f32x16 o;
#pragma unroll
        for (int j = 0; j < 16; ++j) o[j] = 0.f;
#pragma unroll
        for (int s16 = 0; s16 < 2; ++s16) { const unsigned char* vp = VTl + (32 * w + r) * 80 + (16 * s16 + 4 * hi) * 2;
            const s16x4 lo = *(const s16x4*)vp, hi4 = *(const s16x4*)(vp + 16);
            const bf16x8 vf = (bf16x8){lo[0], lo[1], lo[2], lo[3], hi4[0], hi4[1], hi4[2], hi4[3]};
            o = MFMA32(s16 ? pa1 : pa0, vf, o); }
#pragma unroll
        for (int reg = 0; reg < 16; ++reg) HOI[(row0 + crow(reg, hi)) * 512 + h * 128 + 32 * w + r] = o[reg];
    }
    __syncthreads();
}

__device__ __forceinline__ float dpp_sum16(float v) {
    v += __int_as_float(__builtin_amdgcn_update_dpp(0, __float_as_int(v), 0xB1, 0xF, 0xF, true));
    v += __int_as_float(__builtin_amdgcn_update_dpp(0, __float_as_int(v), 0x4E, 0xF, 0xF, true));
    v += __int_as_float(__builtin_amdgcn_update_dpp(0, __float_as_int(v), 0x141, 0xF, 0xF, true));
    v += __int_as_float(__builtin_amdgcn_update_dpp(0, __float_as_int(v), 0x140, 0xF, 0xF, true));
    return v;
}
__device__ __forceinline__ void hgrn_chain_unit(unsigned char* lds, int bh, int L, const Args& a) {
    const bf16_t* HQD = (const bf16_t*)(a.ws + WS_HQD); const bf16_t* HKD = (const bf16_t*)(a.ws + WS_HKD); const bf16_t* HVT = (const bf16_t*)(a.ws + WS_HVT);
    const float* HDEC = (const float*)(a.ws + WS_HDEC); const float* HOI = (const float*)(a.ws + WS_HOI);
    const bf16_t* OG = (const bf16_t*)(a.ws + WS_OG); bf16_t* Y = (bf16_t*)(a.ws + WS_Y);
    const int b = bh >> 2, h = bh & 3;
    const int tid = opaque_tid(), lane = tid & 63, wid = tid >> 6, r = lane & 31, hi = lane >> 5;
    constexpr int BUFB = 25088;
    float* OB = (float*)(lds + 3 * BUFB);
    f32x16 Sacc[4];
#pragma unroll
    for (int i = 0; i < 4; ++i)
#pragma unroll
        for (int j = 0; j < 16; ++j) Sacc[i][j] = 0.f;
    const size_t cb = (size_t)bh * 64;
    const size_t rowb = (size_t)b * SEQ;
    u32x4 stA[3], stB[3]; f32x4 sdA = (f32x4){0.f, 0.f, 0.f, 0.f}, sdB = sdA;
#define HG_LOAD(cc, st, sd) do { const int cc_ = (cc) < 63 ? (cc) : 63; const size_t e_ = (cb + cc_) * 4096 + (size_t)tid * 8; st[0] = *(const u32x4*)(HQD + e_); st[1] = *(const u32x4*)(HKD + e_); st[2] = *(const u32x4*)(HVT + e_); \
        sd = *(const f32x4*)(HDEC + (cb + cc_) * 128 + (tid & 31) * 4); } while (0)
#define HG_STORE(bi, st, sd) do { unsigned char* B_ = lds + (bi) * BUFB; *(u32x4*)(B_ + tid * 16) = st[0]; *(u32x4*)(B_ + 8192 + tid * 16) = st[1]; *(u32x4*)(B_ + 16384 + tid * 16) = st[2]; \
        if (tid < 32) *(f32x4*)(B_ + 24576 + tid * 16) = sd; } while (0)
    HG_LOAD(0, stA, sdA); HG_STORE(0, stA, sdA); HG_LOAD(1, stA, sdA); HG_STORE(1, stA, sdA);
    HG_LOAD(2, stB, sdB);
    const int pt_ = tid >> 4, seg = tid & 15; const int ch = h * 128 + seg * 8;
    const float* gn = a.in[7] + (size_t)L * 512 + ch; const f32x4 g0 = *(const f32x4*)gn, g1 = *(const f32x4*)(gn + 4);
    f32x4 oiA0, oiA1, oiB0, oiB1; u32x4 ogA, ogB;
#define HG_PLOAD(cc, o0, o1, og_) do { const int cp_ = (cc) < 63 ? (cc) : 63; const size_t row_ = rowb + cp_ * 32 + pt_; o0 = *(const f32x4*)(HOI + row_ * 512 + ch); o1 = *(const f32x4*)(HOI + row_ * 512 + ch + 4); og_ = *(const u32x4*)(OG + row_ * 512 + ch); } while (0)
    HG_PLOAD(0, oiA0, oiA1, ogA);
    __syncthreads();
#define HG_ITER(c, stX, sdX, stY, sdY, oiC0, oiC1, ogC, oiN0, oiN1, ogN) do { \
        const int bi = (c) % 3; \
        HG_LOAD((c) + 3, stX, sdX); \
        HG_PLOAD((c) + 1, oiN0, oiN1, ogN); \
        if (wid < 4) { \
            const int w = wid; const unsigned char* B = lds + bi * BUFB; \
            f32x16 o, o2; \
            _Pragma("unroll") for (int j = 0; j < 16; ++j) { o[j] = 0.f; o2[j] = 0.f; } \
            _Pragma("unroll") for (int kb = 0; kb < 4; ++kb) \
                _Pragma("unroll") for (int s16 = 0; s16 < 2; ++s16) { const bf16x8 aq = *(const bf16x8*)(B + ((kb * 2 + s16) * 64 + lane) * 16); const int b8 = 8 * s16; \
                    const bf16x8 bsv = pack8(Sacc[kb][b8], Sacc[kb][b8 + 1], Sacc[kb][b8 + 2], Sacc[kb][b8 + 3], Sacc[kb][b8 + 4], Sacc[kb][b8 + 5], Sacc[kb][b8 + 6], Sacc[kb][b8 + 7]); \
                    if (kb < 2) o = MFMA32(aq, bsv, o); else o2 = MFMA32(aq, bsv, o2); } \
            _Pragma("unroll") for (int kb = 0; kb < 4; ++kb) { \
                _Pragma("unroll") for (int g = 0; g < 4; ++g) { const f32x4 dd = *(const f32x4*)(B + 24576 + (32 * kb + 8 * g + 4 * hi) * 4); \
                    _Pragma("unroll") for (int i = 0; i < 4; ++i) Sacc[kb][4 * g + i] *= dd[i]; } \
                _Pragma("unroll") for (int s16 = 0; s16 < 2; ++s16) { const bf16x8 ka = *(const bf16x8*)(B + 8192 + ((kb * 2 + s16) * 64 + lane) * 16); \
                    const bf16x8 va = *(const bf16x8*)(B + 16384 + ((w * 2 + s16) * 64 + lane) * 16); \
                    Sacc[kb] = MFMA32(ka, va, Sacc[kb]); } \
            } \
            _Pragma("unroll") for (int reg = 0; reg < 16; ++reg) OB[crow(reg, hi) * 132 + 32 * w + r] = o[reg] + o2[reg]; \
        } \
        __syncthreads(); \
        { const size_t row = rowb + (c) * 32 + pt_; const float* op = OB + pt_ * 132 + seg * 8; \
          const f32x4 x0 = *(const f32x4*)op + oiC0, x1 = *(const f32x4*)(op + 4) + oiC1; \
          float ss = (x0[0] * x0[0] + x0[1] * x0[1]) + (x0[2] * x0[2] + x0[3] * x0[3]) + (x1[0] * x1[0] + x1[1] * x1[1]) + (x1[2] * x1[2] + x1[3] * x1[3]); \
          ss = dpp_sum16(ss); \
          const float rstd = __builtin_amdgcn_rsqf(ss * (1.0f / 128.0f) + EPS); \
          f32x4 y0, y1; \
          y0[0] = x0[0] * rstd * g0[0] * bflo(ogC.x); y0[1] = x0[1] * rstd * g0[1] * bfhi(ogC.x); y0[2] = x0[2] * rstd * g0[2] * bflo(ogC.y); y0[3] = x0[3] * rstd * g0[3] * bfhi(ogC.y); \
          y1[0] = x1[0] * rstd * g1[0] * bflo(ogC.z); y1[1] = x1[1] * rstd * g1[1] * bfhi(ogC.z); y1[2] = x1[2] * rstd * g1[2] * bflo(ogC.w); y1[3] = x1[3] * rstd * g1[3] * bfhi(ogC.w); \
          *(u32x4*)(Y + row * 2048 + 1536 + ch) = pack8v(y0, y1); } \
        HG_STORE(((c) + 2) % 3, stY, sdY); \
        __syncthreads(); \
    } while (0)
    for (int c = 0; c < 64; c += 2) {
        HG_ITER(c, stA, sdA, stB, sdB, oiA0, oiA1, ogA, oiB0, oiB1, ogB);
        HG_ITER(c + 1, stB, sdB, stA, sdA, oiB0, oiB1, ogB, oiA0, oiA1, ogA);
    }
#undef HG_ITER
#undef HG_PLOAD
#undef HG_LOAD
#undef HG_STORE
}

#define WQ_NEXT(cw) ({ if (threadIdx.x == 0) sh[0] = atomicAdd((cw), 1u); __syncthreads(); const int u_ = (int)sh[0]; __syncthreads(); u_; })
constexpr int INP_MAIN_COLT = 32;
__device__ __forceinline__ void mixer_phase(const Args& a, unsigned char* lds, int L, int mp, int rep) {
    unsigned* ctr = (unsigned*)(a.ws + WS_CTL) + 64 * (L * 4 + mp * 2 + rep);
    volatile unsigned* sh = (volatile unsigned*)(lds + LDS_MISC);
    if (mp == 0) {
        for (;;) { const int u = WQ_NEXT(ctr); if (u >= 2048) break;
            if (u < 1024) hgrn_prep_unit(lds, u >> 6, u & 63, L, a);
            else { const int x = u - 1024; pool_unit(lds, x >> 2, x & 3, L, a); } }
    } else {
        { const int u = WQ_NEXT(ctr); if (u < 16) { hgrn_chain_unit(lds, u, L, a); if (CHAIN_TWICE) { __syncthreads(); hgrn_chain_unit(lds, u, L, a); } } }
        for (;;) { const int x = WQ_NEXT(ctr + 8); if (x >= 32 * (46 - INP_MAIN_COLT)) break;
            pg8::Gemm g{(const bf16_t*)(a.ws + WS_H), (const bf16_t*)(a.ws + WS_W0 + (size_t)L * WL_SIZE + WL_IN), TT, INC, DM, DM, 1, 0, 0, 0, DM / 64, 0, 0};
            pg8::OneUnit S1{x / (46 - INP_MAIN_COLT), INP_MAIN_COLT + x % (46 - INP_MAIN_COLT)};
            EpiIn E{a.ws, 3 * L * TT};
            pg8::gemm_phase((PG8_LAS unsigned char*)lds, g, S1, E); }
        for (;;) { const int x = WQ_NEXT(ctr + 16); if (x >= 256) break;
            attn_unit(lds, (x & 31) >> 3, x & 7, 7 - (x >> 5), a); }
    }
}
__device__ __forceinline__ void pp_queue(const Args& a, unsigned char* lds, int L) {
    unsigned* ctr = (unsigned*)(a.ws + WS_CTL) + 64 * (L * 4 + 2) + 24;
    volatile unsigned* sh = (volatile unsigned*)(lds + LDS_MISC);
    for (;;) { const int x = WQ_NEXT(ctr); if (x >= 256) break;
        pg8::Gemm g{(const bf16_t*)(a.ws + WS_PB) + (size_t)L * TT * PLE, (const bf16_t*)(a.ws + WS_W0 + (size_t)L * WL_SIZE + WL_PP), TT, DM, PLE, PLE, 1, 0, 0, 0, PLE / 64, 0, 0};
        pg8::OneUnit S1{x >> 3, x & 7};
        EpiBf16 E{a.ws};
        pg8::gemm_phase((PG8_LAS unsigned char*)lds, g, S1, E); }
}

#define LAS __attribute__((address_space(3)))
#define XB_TMO      128
#define XB_XCNT(j)  (256  + 64 * (j))
#define XB_XSUB(j)  (1280 + 64 * (j))
#define XB_XGEN(j)  (2304 + 64 * (j))
#define XB_TOP      3328
#define XB_TOPGEN   3392
#define XCD_BAR_WORDS 3456
#define XB_SPIN_CAP (1u << 20)
__device__ __forceinline__ unsigned xb_ld(unsigned* p)              { return __hip_atomic_load(p, __ATOMIC_RELAXED, __HIP_MEMORY_SCOPE_AGENT); }
__device__ __forceinline__ unsigned xb_add(unsigned* p, unsigned v) { return __hip_atomic_fetch_add(p, v, __ATOMIC_RELAXED, __HIP_MEMORY_SCOPE_AGENT); }
__device__ __forceinline__ unsigned xb_xcc_id() { return (unsigned)__builtin_amdgcn_s_getreg((3 << 11) | 20) & 0xFu; }
#define XB_SPIN(cond, bar) do { unsigned _sp = 0; while (cond) { __builtin_amdgcn_s_sleep(1); \
    if ((++_sp & 255u) == 0u) { if (xb_ld(&(bar)[XB_TMO])) break; if (_sp > XB_SPIN_CAP) { atomicAdd(&(bar)[XB_TMO], 1u); break; } } } } while (0)
struct XcdBarrier { unsigned* bar; unsigned x; volatile LAS unsigned* st; };
__device__ __forceinline__ XcdBarrier xcd_barrier_post(unsigned* bar, volatile LAS unsigned* st) {
    XcdBarrier b; b.bar = bar; b.x = xb_xcc_id(); b.st = st;
    if (threadIdx.x == 0) (void)xb_add(&bar[XB_XCNT(b.x)], 1u);
    return b;
}
__device__ __forceinline__ void xcd_barrier_complete(unsigned* bar, unsigned x, unsigned& nloc, unsigned& nx) {
    const unsigned G = gridDim.x * gridDim.y * gridDim.z;
    unsigned sum, cnt, mine, sp = 0u;
    for (;;) {
        sum = 0u; cnt = 0u; mine = 0u;
#pragma nounroll
        for (unsigned j = 0; j < 16; ++j) { const unsigned c = xb_ld(&bar[XB_XCNT(j)]); sum += c; cnt += (c > 0u) ? 1u : 0u; mine = (j == x) ? c : mine; }
        if (sum == G) break;
        __builtin_amdgcn_s_sleep(1);
        if ((++sp & 255u) == 0u) { if (xb_ld(&bar[XB_TMO])) break; if (sp > XB_SPIN_CAP) { atomicAdd(&bar[XB_TMO], 1u); break; } }
    }
    nloc = mine > 0u ? mine : 1u; nx = cnt > 0u ? cnt : 1u;
}
__device__ __forceinline__ void xcd_barrier(const XcdBarrier& b) {
    asm volatile("s_waitcnt vmcnt(0)" ::: "memory");
    __syncthreads();
    if (threadIdx.x == 0) {
        unsigned* bar = b.bar; asm volatile("" : "+s"(bar));
        __builtin_amdgcn_s_waitcnt(0);
        unsigned nloc = b.st[0], nx = b.st[1];
        if (nloc == 0u) { xcd_barrier_complete(bar, b.x, nloc, nx); b.st[0] = nloc; b.st[1] = nx; }
        const unsigned old = xb_add(&bar[XB_XSUB(b.x)], 1u);
        const unsigned gen = old / nloc;
        if (old + 1u == (gen + 1u) * nloc) {
            __builtin_amdgcn_fence(__ATOMIC_RELEASE, "agent");
            asm volatile("s_waitcnt vmcnt(0)" ::: "memory");
            const unsigned og = xb_add(&bar[XB_TOP], 1u);
            const unsigned tg = og / nx;
            if (og + 1u == (tg + 1u) * nx) xb_add(&bar[XB_TOPGEN], 1u);
            else XB_SPIN(xb_ld(&bar[XB_TOPGEN]) == tg, bar);
            __builtin_amdgcn_fence(__ATOMIC_ACQUIRE, "agent");
            xb_add(&bar[XB_XGEN(b.x)], 1u);
            asm volatile("s_waitcnt vmcnt(0)" ::: "memory");
        } else {
            XB_SPIN(xb_ld(&bar[XB_XGEN(b.x)]) == gen, bar);
            __builtin_amdgcn_fence(__ATOMIC_ACQUIRE, "agent");
            asm volatile("s_waitcnt vmcnt(0)" ::: "memory");
        }
    }
    __syncthreads();
}

typedef const Args __attribute__((address_space(4)))* KArgP;
#define LOAD_ARGS KArgP ap = (KArgP)__builtin_amdgcn_kernarg_segment_ptr(); asm volatile("" : "+s"(ap)); Args A; \
    _Pragma("unroll") for (int i_ = 0; i_ < 19; ++i_) A.in[i_] = ap->in[i_]; A.out = ap->out; A.ws = ap->ws; A.ph_lo = 0; A.ph_hi = 0;
__global__ void __launch_bounds__(512, 2) mega(Args a) {
    extern __shared__ __attribute__((aligned(16))) unsigned char lds[];
    cg::grid_group grid = cg::this_grid();
    PG8_LAS unsigned char* lds3 = (PG8_LAS unsigned char*)lds;
    const int G = gridDim.x, bx = blockIdx.x;
    if (threadIdx.x == 0) { ((volatile LAS unsigned*)((LAS unsigned char*)lds + LDS_MISC))[8] = 0u; ((volatile LAS unsigned*)((LAS unsigned char*)lds + LDS_MISC))[9] = 0u; }
    __syncthreads();
    XcdBarrier xbar = xcd_barrier_post((unsigned*)(a.ws + WS_CTL) + 1024, (volatile LAS unsigned*)((LAS unsigned char*)lds + LDS_MISC) + 8);
    constexpr int ph_hi_ = NPHASE;
#pragma nounroll
    for (int ph = 0; ph < ph_hi_; ++ph) {
      const int nrep = 1 + ((ph == 0 ? (REP_MASK >> 15) : (ph == NPHASE - 1 ? 0 : (REP_MASK >> ((ph - 1) % PPL)))) & 1);
      for (int rep = 0; rep < nrep; ++rep) {
        if (ph == 0) { if (PHMASK & 0x8000) { LOAD_ARGS prologue_phase(A, lds); } }
        else if (ph == NPHASE - 1) { if (PHMASK & 0x4000) { LOAD_ARGS final_norm_rows((const bf16_t*)(A.ws + WS_H), (const float*)(A.ws + WS_X) + (size_t)(3 * NLAYER) * TT * 8, A.in[18], A.out); } }
        else {
            const int L = (ph - 1) / PPL, s = (ph - 1) % PPL;
            if (s == 0) { if (PHMASK & (1 << 0)) {
                LOAD_ARGS unsigned char* wl = A.ws + WS_W0 + (size_t)L * WL_SIZE;
                pg8::Gemm g{(const bf16_t*)(A.ws + WS_H), (const bf16_t*)(wl + WL_IN), TT, INC, DM, DM, 1, 0, 0, 0, DM / 64, 0, 0};
                pg8::StaticOrder S; S.init(TT, INP_MAIN_COLT * 256, G, bx, 1);
                EpiIn E{A.ws, 3 * L * TT};
                pg8::gemm_phase(lds3, g, S, E);
            }} else if (s == 1) { if (PHMASK & (1 << 1)) {
                LOAD_ARGS mixer_phase(A, lds, L, 0, rep);
            }} else if (s == 2) { if (PHMASK & (1 << 2)) {
                LOAD_ARGS mixer_phase(A, lds, L, 1, rep);
            }} else if (s == 3) { if (PHMASK & (1 << 3)) {
                LOAD_ARGS unsigned char* wl = A.ws + WS_W0 + (size_t)L * WL_SIZE;
                pg8::Gemm g{(const bf16_t*)(A.ws + WS_Y), (const bf16_t*)(wl + WL_BR), TT, DM, DM, DM, 3, 0, 512, 1536, 8, 16, 8};
                pg8::StaticOrder S; S.init(TT, DM, G, bx, 3);
                EpiBranch E{A.ws};
                pg8::gemm_phase(lds3, g, S, E);
            }} else if (s == 4) { if (PHMASK & (1 << 4)) {
                LOAD_ARGS unsigned char* wl = A.ws + WS_W0 + (size_t)L * WL_SIZE;
                pg8::Gemm g{(const bf16_t*)(A.ws + WS_MIX), (const bf16_t*)(wl + WL_OUT), TT, DM, DM, DM, 1, 0, 0, 0, DM / 64, 0, 0};
                pg8::StaticOrder S; S.init(TT, DM, G, bx, 1);
                EpiResid E{A.ws, 0, 0, (3 * L + 1) * TT};
                pg8::gemm_phase(lds3, g, S, E);
            }} else if (s == 5) { if (PHMASK & (1 << 5)) {
                LOAD_ARGS unsigned char* wl = A.ws + WS_W0 + (size_t)L * WL_SIZE;
                pg8::Gemm g{(const bf16_t*)(A.ws + WS_H), (const bf16_t*)(wl + WL_GU), TT, 2 * DFF, DM, DM, 1, 0, 0, 0, DM / 64, 0, 0};
                pg8::StaticOrder S; S.init(TT, 2 * DFF, G, bx, 1);
                EpiSwiglu E{A.ws, (3 * L + 1) * TT};
                pg8::gemm_phase(lds3, g, S, E);
                if (rep == 0) pp_queue(A, lds, L);
            }} else if (s == 6) { if (PHMASK & (1 << 6)) {
                LOAD_ARGS unsigned char* wl = A.ws + WS_W0 + (size_t)L * WL_SIZE;
                pg8::Gemm g{(const bf16_t*)(A.ws + WS_ACT), (const bf16_t*)(wl + WL_DN), TT, DM, DFF, DFF, 1, 0, 0, 0, DFF / 64, 0, 0};
                pg8::StaticOrder S; S.init(TT, DM, G, bx, 1);
                EpiResid E{A.ws, 0, (int)(WS_HB - WS_H), (3 * L + 2) * TT};
                pg8::gemm_phase(lds3, g, S, E);
            }} else { if (PHMASK & (1 << 7)) {
                LOAD_ARGS unsigned char* wl = A.ws + WS_W0 + (size_t)L * WL_SIZE;
                pg8::Gemm g{(const bf16_t*)(A.ws + WS_HB), (const bf16_t*)(wl + WL_PG), TT, DM, DM, DM, 1, 0, 0, 0, DM / 64, 0, 0};
                pg8::StaticOrder S; S.init(TT, DM, G, bx, 1);
                EpiPle E{A.ws, (3 * L + 2) * TT};
                pg8::gemm_phase(lds3, g, S, E);
            }}
        }
        if (ph + 1 < ph_hi_ || rep + 1 < nrep) { if (ph == 0) grid.sync(); else xcd_barrier(xbar); }
      }
    }
    for (int i = 0; i < EXTRA_SYNCS; ++i) xcd_barrier(xbar);
}

extern "C" void kernel_launch(void* const* d_in, const int* in_sizes, int n_in, void* d_out, int out_size, void* d_ws, size_t ws_size, hipStream_t stream) {
    static int grid = 0;
    if (grid == 0) {
        if (n_in != 19 || out_size != TT * DM || ws_size < WS_END) { fprintf(stderr, "kernel_launch: unexpected problem (n_in %d out %d ws %zu need %zu)\n", n_in, out_size, ws_size, (size_t)WS_END); grid = -1; return; }
        int dev = 0, cus = 0, per_cu = 0;
        hipGetDevice(&dev); hipDeviceGetAttribute(&cus, hipDeviceAttributeMultiprocessorCount, dev);
        if (hipFuncSetAttribute((const void*)mega, hipFuncAttributeMaxDynamicSharedMemorySize, LDS_BYTES) != hipSuccess) { fprintf(stderr, "kernel_launch: hipFuncSetAttribute failed\n"); grid = -1; return; }
        if (hipOccupancyMaxActiveBlocksPerMultiprocessor(&per_cu, (const void*)mega, 512, LDS_BYTES) != hipSuccess || per_cu < 1) { fprintf(stderr, "kernel_launch: occupancy query gave %d\n", per_cu); per_cu = 1; }
        (void)hipGetLastError();
        grid = cus * per_cu;
        fprintf(stderr, "kernel_launch: grid %d (cus %d x %d)\n", grid, cus, per_cu);
    }
    if (grid < 0) return;
    (void)hipMemsetAsync((char*)d_ws + WS_CTL, 0, CTL_ZERO, stream);
    Args a{};
    for (int i = 0; i < 19; ++i) a.in[i] = (const float*)d_in[i];
    a.out = (float*)d_out; a.ws = (unsigned char*)d_ws;
#if MK_MULTI
    for (int ph = 0; ph < NPHASE; ++ph) { a.ph_lo = ph; a.ph_hi = ph + 1; hipLaunchKernelGGL(mega, dim3(grid), dim3(512), LDS_BYTES, stream, a); }
#else
    a.ph_lo = 0; a.ph_hi = NPHASE;
    void* args[] = {&a};
    hipError_t e = hipLaunchCooperativeKernel((const void*)mega, dim3(grid), dim3(512), args, LDS_BYTES, stream);
    if (e != hipSuccess) fprintf(stderr, "kernel_launch: cooperative launch failed: %s (grid %d)\n", hipGetErrorString(e), grid);
#endif
}
```

```cpp
#include <hip/hip_runtime.h>
#include <hip/hip_cooperative_groups.h>
#include <cstdio>
#include <cstdint>
namespace cg = cooperative_groups;

#ifndef PHMASK
#define PHMASK 0xFFFF
#endif
#ifndef REP_MASK
#define REP_MASK 0
#endif
#ifndef EXTRA_SYNCS
#define EXTRA_SYNCS 0
#endif
#ifndef CHAIN_TWICE
#define CHAIN_TWICE 0
#endif
#ifndef MK_MULTI
#define MK_MULTI 0
#endif

typedef unsigned short bf16_t;
typedef short bf16x8 __attribute__((ext_vector_type(8)));
typedef short s16x4 __attribute__((ext_vector_type(4)));
typedef float f32x4 __attribute__((ext_vector_type(4)));
typedef float f32x16 __attribute__((ext_vector_type(16)));
typedef unsigned u32x4 __attribute__((ext_vector_type(4)));
typedef unsigned u32x2 __attribute__((ext_vector_type(2)));

constexpr int TT = 8192, DM = 2048, SEQ = 2048, INC = 11776, DFF = 5632, PLE = 256, NLAYER = 2;
constexpr float EPS = 1e-6f;

typedef float f32x2_t __attribute__((ext_vector_type(2))); typedef __bf16 bf16x2_t __attribute__((ext_vector_type(2)));
__device__ __forceinline__ unsigned cvt_pk_bf16(float lo, float hi) { const f32x2_t v = {lo, hi}; const bf16x2_t b = __builtin_convertvector(v, bf16x2_t); return __builtin_bit_cast(unsigned, b); }
__device__ __forceinline__ float bf2f(unsigned short b) { return __uint_as_float(((unsigned)b) << 16); }
__device__ __forceinline__ float bflo(unsigned w) { return __uint_as_float(w << 16); }
__device__ __forceinline__ float bfhi(unsigned w) { return __uint_as_float(w & 0xffff0000u); }
__device__ __forceinline__ float sigmoidf_(float x) { return __builtin_amdgcn_rcpf(1.0f + __builtin_amdgcn_exp2f(x * -1.4426950408889634f)); }
__device__ __forceinline__ bf16x8 pack8(float a0, float a1, float a2, float a3, float a4, float a5, float a6, float a7) {
    u32x4 w; w.x = cvt_pk_bf16(a0, a1); w.y = cvt_pk_bf16(a2, a3); w.z = cvt_pk_bf16(a4, a5); w.w = cvt_pk_bf16(a6, a7);
    return __builtin_bit_cast(bf16x8, w);
}
__device__ __forceinline__ int crow(int r, int hi) { return (r & 3) + 8 * (r >> 2) + 4 * hi; }
__device__ __forceinline__ int opaque_tid() { int t = threadIdx.x; asm volatile("" : "+v"(t)); return t; }
__device__ __forceinline__ float shflx(float v, int m, int lane) { return __int_as_float(__builtin_amdgcn_ds_bpermute((lane ^ m) << 2, __float_as_int(v))); }
#define MFMA32(a, b, c) __builtin_amdgcn_mfma_f32_32x32x16_bf16((a), (b), (c), 0, 0, 0)

namespace pg8 {
#define PG8_LAS __attribute__((address_space(3)))
constexpr int BM = 256, BK = 64, HALF = 128, HTB = HALF * BK * 2, STAGE_BYTES = 8 * HTB, NXCD = 8, WGM = 8;
__host__ __device__ __forceinline__ int lds_byte(int r, int c) { const int st = (r >> 4) * 2 + (c >> 5), rr = r & 15, cc = c & 31, ob = rr * 64 + cc * 2; return st * 1024 + (ob ^ (((ob >> 9) & 1) << 5)); }
__host__ __device__ __forceinline__ void stage_rc(int b, int& R, int& C) { const int st = b / 1024, sb = b % 1024, swz = sb ^ (((sb >> 9) & 1) << 5); R = (st >> 1) * 16 + swz / 64; C = (st & 1) * 32 + (swz % 64) / 2; }
__host__ __device__ __forceinline__ int perm32(int rho) { const int n = rho >> 4, i = rho & 15; return 8 * (i >> 2) + 4 * n + (i & 3); }

struct Unit { int pm, pn, kind; };
struct Gemm { const bf16_t* A; const bf16_t* Bt; int M, N, lda, ldb; int nseg; int kofs0, kofs1, kofs2; int nt0, nt1, nt2; };

struct StaticOrder {
    int nM, nN, nwg, G, c, nseg;
    __device__ void init(int M, int N, int G_, int c_, int nseg_) { nM = M / BM; nN = N / BM; nwg = nM * nN; G = G_; c = c_; nseg = nseg_; }
    __device__ bool next(int i, Unit& u) const {
        int j = i, kd = 0; if (nseg == 3) { j = i / 3; kd = i - 3 * j; }
        u.kind = kd;
        const long L = (long)j * G + c; if (L >= nwg) return false;
        int wgid = (int)L; { const int q = nwg / NXCD, r = nwg % NXCD, xcd = wgid % NXCD, off = wgid / NXCD; wgid = (xcd < r ? xcd * (q + 1) : r * (q + 1) + (xcd - r) * q) + off; }
        const int nig = WGM * nN, gid = wgid / nig, fm = gid * WGM, gsz = (nM - fm) < WGM ? (nM - fm) : WGM;
        u.pm = fm + ((wgid % nig) % gsz); u.pn = (wgid % nig) / gsz; return true;
    }
};

struct OneUnit { int pm, pn; __device__ bool next(int i, Unit& u) const { u.pm = pm; u.pn = pn; u.kind = 0; return i == 0; } };
template <class Epi, class Sched>
__device__ __forceinline__ void gemm_phase(PG8_LAS unsigned char* lds, const Gemm g, const Sched& S, const Epi& E) {
    const int tid = opaque_tid(), wid = __builtin_amdgcn_readfirstlane(tid >> 6), lane = tid & 63, wr = wid >> 2, wc = wid & 3, fr = lane & 15, fq = lane >> 4;
    unsigned voffA, voffB;
    { int R, C; stage_rc(tid * 16, R, C); const int Rb = (R & ~31) + perm32(R & 31);
      voffA = (unsigned)(R * g.lda + C) * 2u; voffB = (unsigned)(Rb * g.ldb + C) * 2u; }
    const size_t qstepoffA = (size_t)64 * g.lda * 2, qstepoffB = (size_t)64 * g.ldb * 2;
    const size_t kstep = (size_t)(BK * 2);
    const size_t hstepA = (size_t)HALF * g.lda * 2, hstepB = (size_t)HALF * g.ldb * 2;
    const size_t tstepA = 2 * hstepA, tstepB = 2 * hstepB;
    const unsigned ldsw = (unsigned)wid * 1024u;
    const int aoff = lds_byte(wr * 64 + fr, fq * 8), boff = lds_byte(wc * 32 + fr, fq * 8);
#define PG8_SA(b, h) (((b) * 2 + (h)) * HTB)
#define PG8_SB(b, h) ((4 + (b) * 2 + (h)) * HTB)
#define PG8_STAGE(bufoff, gbase, voff) do { _Pragma("unroll") for (int _i = 0; _i < 2; ++_i) \
        __builtin_amdgcn_global_load_lds((const unsigned*)((const char*)(gbase) + (size_t)_i * qstep##voff + v##voff), (PG8_LAS unsigned*)(lds + (bufoff) + ldsw + _i * 8192), 16, 0, 0); } while (0)
#define PG8_LDA(dst, b, h) do { _Pragma("unroll") for (int m = 0; m < 4; ++m) _Pragma("unroll") for (int k = 0; k < 2; ++k) dst[m][k] = *(const PG8_LAS bf16x8*)(lds + PG8_SA(b, h) + aoff + m * 2048 + k * 1024); } while (0)
#define PG8_LDB(dst, b, h) do { _Pragma("unroll") for (int n = 0; n < 2; ++n) _Pragma("unroll") for (int k = 0; k < 2; ++k) dst[n][k] = *(const PG8_LAS bf16x8*)(lds + PG8_SB(b, h) + boff + n * 2048 + k * 1024); } while (0)
#define PG8_MMA(ai, bj, At, Bt) do { __builtin_amdgcn_s_setprio(1); _Pragma("unroll") for (int m = 0; m < 4; ++m) _Pragma("unroll") for (int n = 0; n < 2; ++n) _Pragma("unroll") for (int k = 0; k < 2; ++k) \
        acc[ai][bj][m][n] = __builtin_amdgcn_mfma_f32_16x16x32_bf16(Bt[n][k], At[m][k], acc[ai][bj][m][n], 0, 0, 0); __builtin_amdgcn_s_setprio(0); } while (0)
#define PG8_WAIT_V(n) asm volatile("s_waitcnt vmcnt(" #n ")" ::: "memory")
#define PG8_WAIT_L(n) asm volatile("s_waitcnt lgkmcnt(" #n ")" ::: "memory")
#define PG8_BAR __builtin_amdgcn_s_barrier()
#define PG8_SCHED __builtin_amdgcn_sched_barrier(0)
#define PG8_KOFS(u) ((u).kind == 0 ? g.kofs0 : ((u).kind == 1 ? g.kofs1 : g.kofs2))
#define PG8_NT(u) ((u).kind == 0 ? g.nt0 : ((u).kind == 1 ? g.nt1 : g.nt2))
    Unit cur, nxt; int ui = 0;
    if (!S.next(0, cur)) return;
    f32x4 acc[2][2][4][2];
#pragma unroll
    for (int a = 0; a < 2; ++a)
#pragma unroll
        for (int b = 0; b < 2; ++b)
#pragma unroll
            for (int m = 0; m < 4; ++m)
#pragma unroll
                for (int n = 0; n < 2; ++n) acc[a][b][m][n] = (f32x4){0.f, 0.f, 0.f, 0.f};
    bf16x8 At[4][2], B0[2][2], B1[2][2];
    const char* cA = (const char*)g.A + (size_t)cur.pm * tstepA + (size_t)PG8_KOFS(cur) * 2; const char* cB = (const char*)g.Bt + (size_t)cur.pn * tstepB + (size_t)PG8_KOFS(cur) * 2;
    PG8_STAGE(PG8_SB(0, 0), cB, offB); PG8_STAGE(PG8_SB(0, 1), cB + hstepB, offB); PG8_STAGE(PG8_SA(0, 0), cA, offA); PG8_STAGE(PG8_SA(0, 1), cA + hstepA, offA);
    if (wr == 1) PG8_BAR;
    PG8_WAIT_V(2); PG8_BAR;
    PG8_STAGE(PG8_SB(1, 0), cB + kstep, offB); PG8_STAGE(PG8_SA(1, 0), cA + kstep, offA); PG8_STAGE(PG8_SB(1, 1), cB + hstepB + kstep, offB);
    PG8_WAIT_V(6); PG8_BAR;
    for (;;) {
        const bool has_next = S.next(ui + 1, nxt);
        const char* nA = has_next ? (const char*)g.A + (size_t)nxt.pm * tstepA + (size_t)PG8_KOFS(nxt) * 2 : cA;
        const char* nB = has_next ? (const char*)g.Bt + (size_t)nxt.pn * tstepB + (size_t)PG8_KOFS(nxt) * 2 : cB;
        const int nt = PG8_NT(cur);
        for (int t = 0; t < nt; t += 2) {
            const bool last = (t == nt - 2);
            const char* a1 = cA + (size_t)(t + 1) * kstep;
            const char* a2 = last ? nA : cA + (size_t)(t + 2) * kstep; const char* b2 = last ? nB : cB + (size_t)(t + 2) * kstep;
            const char* a3 = a2 + kstep; const char* b3 = b2 + kstep;
            PG8_LDB(B0, 0, 0); PG8_LDB(B1, 0, 1); PG8_SCHED; PG8_LDA(At, 0, 0); PG8_STAGE(PG8_SA(1, 1), a1 + hstepA, offA);
            PG8_WAIT_V(8); PG8_WAIT_L(0); PG8_BAR; PG8_MMA(0, 0, At, B0); PG8_MMA(0, 1, At, B1); PG8_BAR; PG8_SCHED;
            PG8_LDA(At, 0, 1); PG8_STAGE(PG8_SB(0, 0), b2, offB); PG8_STAGE(PG8_SB(0, 1), b2 + hstepB, offB); PG8_STAGE(PG8_SA(0, 0), a2, offA);
            PG8_WAIT_V(8); PG8_WAIT_L(0); PG8_BAR; PG8_MMA(1, 0, At, B0); PG8_MMA(1, 1, At, B1); PG8_BAR; PG8_SCHED;
            PG8_LDB(B0, 1, 0); PG8_LDB(B1, 1, 1); PG8_SCHED; PG8_LDA(At, 1, 0); PG8_STAGE(PG8_SA(0, 1), a2 + hstepA, offA);
            PG8_WAIT_V(8); PG8_WAIT_L(0); PG8_BAR; PG8_MMA(0, 0, At, B0); PG8_MMA(0, 1, At, B1); PG8_BAR; PG8_SCHED;
            PG8_LDA(At, 1, 1); PG8_STAGE(PG8_SB(1, 0), b3, offB); PG8_STAGE(PG8_SB(1, 1), b3 + hstepB, offB); PG8_STAGE(PG8_SA(1, 0), a3, offA);
            PG8_WAIT_V(8); PG8_WAIT_L(0); PG8_BAR; PG8_MMA(1, 0, At, B0); PG8_MMA(1, 1, At, B1); PG8_BAR; PG8_SCHED;
        }
        if (wr == 0) PG8_BAR;
        const bool keep = E(acc, cur, wr, wc, fr, fq);
        if (!has_next) break;
        if (!keep) {
#pragma unroll
        for (int a = 0; a < 2; ++a)
#pragma unroll
            for (int b = 0; b < 2; ++b)
#pragma unroll
                for (int m = 0; m < 4; ++m)
#pragma unroll
                    for (int n = 0; n < 2; ++n) acc[a][b][m][n] = (f32x4){0.f, 0.f, 0.f, 0.f};
        }
        cur = nxt; cA = nA; cB = nB; ++ui;
        if (wr == 1) PG8_BAR;
    }
    PG8_WAIT_V(0);
    PG8_BAR;
#undef PG8_SA
#undef PG8_SB
#undef PG8_STAGE
#undef PG8_LDA
#undef PG8_LDB
#undef PG8_MMA
#undef PG8_WAIT_V
#undef PG8_WAIT_L
#undef PG8_BAR
#undef PG8_SCHED
#undef PG8_KOFS
#undef PG8_NT
}
}

constexpr size_t MiB = 1u << 20;
constexpr size_t WS_CTL = 0;
constexpr size_t WS_W0 = 1 * MiB;
constexpr size_t WL_IN = 0, WL_BR = 46 * MiB, WL_OUT = 54 * MiB, WL_GU = 62 * MiB, WL_DN = 106 * MiB, WL_PG = 128 * MiB, WL_PP = 136 * MiB, WL_SIZE = 137 * MiB;
constexpr size_t WS_H = WS_W0 + 2 * WL_SIZE;
constexpr size_t WS_X = WS_H + 32 * MiB;
constexpr size_t WS_U = WS_X + 64 * MiB;
constexpr size_t WS_SQ = WS_U + 16 * MiB;
constexpr size_t WS_SK = WS_SQ + 16 * MiB;
constexpr size_t WS_VT = WS_SK + 16 * MiB;
constexpr size_t WS_ZF = WS_VT + 16 * MiB;
constexpr size_t WS_HV = WS_ZF + 16 * MiB;
constexpr size_t WS_HQ = WS_HV + 8 * MiB;
constexpr size_t WS_OG = WS_HQ + 16 * MiB;
constexpr size_t WS_GT = WS_OG + 8 * MiB;
constexpr size_t WS_ACT = WS_GT;
constexpr size_t WS_Y = WS_GT + 96 * MiB;
constexpr size_t WS_MIX = WS_Y + 32 * MiB;
constexpr size_t WS_PB = WS_MIX + 32 * MiB;
constexpr size_t WS_HVT = WS_PB + 8 * MiB;
constexpr size_t WS_HDEC = WS_HVT + 8 * MiB;
constexpr size_t WS_HB = WS_HDEC + 1 * MiB;
constexpr size_t WS_PPB = WS_HB + 32 * MiB;
constexpr size_t WS_END = WS_PPB + 32 * MiB;
constexpr size_t WS_HOI = WS_MIX;
constexpr size_t WS_HQD = WS_MIX + 16 * MiB;
constexpr size_t WS_HKD = WS_MIX + 24 * MiB;
constexpr size_t CTL_SS = 65536;
constexpr size_t CTL_ZERO = CTL_SS + 7 * TT * 4;

constexpr int LDS_PSUM_OFF = 132096;
typedef f32x4 AccT[2][2][4][2];
#define EPI_LOOP_BEGIN  const int row0_ = u.pm * 256 + wr * 64 + fr; \
    _Pragma("unroll") for (int ai = 0; ai < 2; ++ai) _Pragma("unroll") for (int m = 0; m < 4; ++m) { const int row = row0_ + ai * 128 + m * 16; \
    _Pragma("unroll") for (int bj = 0; bj < 2; ++bj) { const int col = u.pn * 256 + bj * 128 + wc * 32 + 8 * fq; f32x4 v0 = acc[ai][bj][m][0], v1 = acc[ai][bj][m][1];
#define EPI_LOOP_END }}
__device__ __forceinline__ float rstd_of(float ss) { return __builtin_amdgcn_rsqf(ss * (1.0f / DM) + EPS); }
__device__ __forceinline__ float rstd_row(const float* SSP, int row) { const f32x4 a = *(const f32x4*)(SSP + (size_t)row * 8), b = *(const f32x4*)(SSP + (size_t)row * 8 + 4);
    return rstd_of(((a[0] + a[1]) + (a[2] + a[3])) + ((b[0] + b[1]) + (b[2] + b[3]))); }
__device__ __forceinline__ void ps_write(int rit, int wc, float sq) {
    extern __shared__ __attribute__((aligned(16))) unsigned char lds_e_[];
    ((float*)(lds_e_ + LDS_PSUM_OFF))[rit * 4 + wc] = sq;
}
__device__ __forceinline__ void ps_finish(float* SSP, const pg8::Unit& u, int wr, int wc, int fr, int fq) {
    extern __shared__ __attribute__((aligned(16))) unsigned char lds_e_[];
    const float* PS = (const float*)(lds_e_ + LDS_PSUM_OFF);
    asm volatile("s_waitcnt lgkmcnt(0)" ::: "memory"); __builtin_amdgcn_s_barrier(); asm volatile("" ::: "memory");
    const int t_ = (wr * 4 + wc) * 64 + fq * 16 + fr;
    if (t_ < 256) { const f32x4 p = *(const f32x4*)(PS + t_ * 4); SSP[(size_t)(u.pm * 256 + t_) * 8 + u.pn] = (p[0] + p[1]) + (p[2] + p[3]); }
}
__device__ __forceinline__ void load_rstd4(const float* SSP, int row0, float (&rs)[4]) {
    f32x4 pa[4], pb[4];
#pragma unroll
    for (int m = 0; m < 4; ++m) { const float* p = SSP + (size_t)(row0 + m * 16) * 8; pa[m] = *(const f32x4*)p; pb[m] = *(const f32x4*)(p + 4); }
#pragma unroll
    for (int m = 0; m < 4; ++m) rs[m] = rstd_of(((pa[m][0] + pa[m][1]) + (pa[m][2] + pa[m][3])) + ((pb[m][0] + pb[m][1]) + (pb[m][2] + pb[m][3])));
    __builtin_amdgcn_sched_barrier(0);
}
#define EPI_LOOP_END_R }}}
#define EPI_LOOP_BEGIN_R(SSP)  const int row0_ = u.pm * 256 + wr * 64 + fr; \
    _Pragma("unroll") for (int ai = 0; ai < 2; ++ai) { float rs4_[4]; load_rstd4((SSP), row0_ + ai * 128, rs4_); \
    _Pragma("unroll") for (int m = 0; m < 4; ++m) { const int row = row0_ + ai * 128 + m * 16; const float rs_ = rs4_[m]; \
    _Pragma("unroll") for (int bj = 0; bj < 2; ++bj) { const int col = u.pn * 256 + bj * 128 + wc * 32 + 8 * fq; f32x4 v0 = acc[ai][bj][m][0] * rs_, v1 = acc[ai][bj][m][1] * rs_;

__device__ __forceinline__ u32x4 pack8v(f32x4 v0, f32x4 v1) { u32x4 w; w.x = cvt_pk_bf16(v0[0], v0[1]); w.y = cvt_pk_bf16(v0[2], v0[3]); w.z = cvt_pk_bf16(v1[0], v1[1]); w.w = cvt_pk_bf16(v1[2], v1[3]); return w; }

struct EpiIn {
    unsigned char* ws; int ssofs;
    __device__ __forceinline__ bool operator()(AccT& acc, const pg8::Unit& u, int wr, int wc, int fr, int fq) const {
        float* U = (float*)(ws + WS_U); bf16_t* SQ = (bf16_t*)(ws + WS_SQ); bf16_t* SK = (bf16_t*)(ws + WS_SK); bf16_t* VT = (bf16_t*)(ws + WS_VT); float* ZF = (float*)(ws + WS_ZF);
        bf16_t* HV = (bf16_t*)(ws + WS_HV); float* HQ = (float*)(ws + WS_HQ); bf16_t* OG = (bf16_t*)(ws + WS_OG); bf16_t* GT = (bf16_t*)(ws + WS_GT);
        const float* SS = (const float*)(ws + WS_X) + (size_t)ssofs * 8; const float qscale = 0.08838834764831845f * 1.4426950408889634f;
        const int colt = u.pn * 256;
        if (colt < 512) {
            EPI_LOOP_BEGIN_R(SS) float* p = U + (size_t)row * 512 + col; *(f32x4*)p = v0; *(f32x4*)(p + 4) = v1; EPI_LOOP_END_R
        } else if (colt < 1536) {
            const float s = qscale;
            EPI_LOOP_BEGIN_R(SS) *(u32x4*)(SQ + (size_t)row * 1024 + (col - 512)) = pack8v(v0 * s, v1 * s); EPI_LOOP_END_R
        } else if (colt < 2560) {
            EPI_LOOP_BEGIN_R(SS) *(u32x4*)(SK + (size_t)row * 1024 + (col - 1536)) = pack8v(v0, v1); EPI_LOOP_END_R
        } else if (colt < 3584) {
            EPI_LOOP_BEGIN_R(SS) const int cc = col - 2560, hh = cc >> 7, d = cc & 127, b = row >> 11, s = row & 2047;
                bf16_t* p = VT + (((size_t)(b * 8 + hh) * 128 + d) << 11) + s; const u32x4 w = pack8v(v0, v1);
                p[0] = (bf16_t)(w.x & 0xffff); p[2048] = (bf16_t)(w.x >> 16); p[2 * 2048] = (bf16_t)(w.y & 0xffff); p[3 * 2048] = (bf16_t)(w.y >> 16);
                p[4 * 2048] = (bf16_t)(w.z & 0xffff); p[5 * 2048] = (bf16_t)(w.z >> 16); p[6 * 2048] = (bf16_t)(w.w & 0xffff); p[7 * 2048] = (bf16_t)(w.w >> 16); EPI_LOOP_END_R
        } else if (colt < 4096) {
            EPI_LOOP_BEGIN_R(SS) float* p = ZF + (size_t)row * 512 + (col - 3584); *(f32x4*)p = v0; *(f32x4*)(p + 4) = v1; EPI_LOOP_END_R
        } else if (colt < 4608) {
            EPI_LOOP_BEGIN_R(SS) *(u32x4*)(HV + (size_t)row * 512 + (col - 4096)) = pack8v(v0, v1); EPI_LOOP_END_R
        } else if (colt < 5120) {
            EPI_LOOP_BEGIN_R(SS)
#pragma unroll
                for (int j = 0; j < 4; ++j) { v0[j] = v0[j] * sigmoidf_(v0[j]); v1[j] = v1[j] * sigmoidf_(v1[j]); }
                float* p = HQ + (size_t)row * 512 + (col - 4608); *(f32x4*)p = v0; *(f32x4*)(p + 4) = v1; EPI_LOOP_END_R
        } else if (colt < 5632) {
            EPI_LOOP_BEGIN_R(SS)
#pragma unroll
                for (int j = 0; j < 4; ++j) { v0[j] = v0[j] * sigmoidf_(v0[j]); v1[j] = v1[j] * sigmoidf_(v1[j]); }
                *(u32x4*)(OG + (size_t)row * 512 + (col - 5120)) = pack8v(v0, v1); EPI_LOOP_END_R
        } else {
            EPI_LOOP_BEGIN_R(SS)
#pragma unroll
                for (int j = 0; j < 4; ++j) { v0[j] = sigmoidf_(v0[j]); v1[j] = sigmoidf_(v1[j]); }
                *(u32x4*)(GT + (size_t)row * 6144 + (col - 5632)) = pack8v(v0, v1); EPI_LOOP_END_R
        }
        return false;
    }
};
struct EpiBranch {
    unsigned char* ws;
    __device__ __forceinline__ bool operator()(AccT& acc, const pg8::Unit& u, int wr, int wc, int fr, int fq) const {
        const bf16_t* GT = (const bf16_t*)(ws + WS_GT); bf16_t* MIX = (bf16_t*)(ws + WS_MIX);
        const int kind = u.kind;
        const int row0_ = u.pm * 256 + wr * 64 + fr;
#pragma unroll
        for (int ai = 0; ai < 2; ++ai) {
            u32x4 ga[4][2], gb[4][2];
#pragma unroll
            for (int m = 0; m < 4; ++m)
#pragma unroll
                for (int bj = 0; bj < 2; ++bj) { const size_t go = (size_t)(row0_ + ai * 128 + m * 16) * 6144 + u.pn * 256 + bj * 128 + wc * 32 + 8 * fq;
                    ga[m][bj] = *(const u32x4*)(GT + go + kind * 2048); gb[m][bj] = *(const u32x4*)(GT + go + (kind < 2 ? kind + 1 : 2) * 2048); }
            __builtin_amdgcn_sched_barrier(0);
#pragma unroll
            for (int m = 0; m < 4; ++m) { const int row = row0_ + ai * 128 + m * 16;
#pragma unroll
                for (int bj = 0; bj < 2; ++bj) { const int col = u.pn * 256 + bj * 128 + wc * 32 + 8 * fq;
                    const u32x4 gaw = ga[m][bj], gbw = gb[m][bj];
                    float a[8] = {bflo(gaw.x), bfhi(gaw.x), bflo(gaw.y), bfhi(gaw.y), bflo(gaw.z), bfhi(gaw.z), bflo(gaw.w), bfhi(gaw.w)};
#pragma unroll
                    for (int j = 0; j < 8; ++j) a[j] = fmaxf(a[j], 1e-30f);
                    if (kind < 2) {
                        float b[8] = {bflo(gbw.x), bfhi(gbw.x), bflo(gbw.y), bfhi(gbw.y), bflo(gbw.z), bfhi(gbw.z), bflo(gbw.w), bfhi(gbw.w)};
#pragma unroll
                        for (int j = 0; j < 8; ++j) { const float rr = a[j] * __builtin_amdgcn_rcpf(fmaxf(b[j], 1e-30f)); if (j < 4) acc[ai][bj][m][0][j] *= rr; else acc[ai][bj][m][1][j - 4] *= rr; }
                    } else {
                        f32x4 v0 = acc[ai][bj][m][0], v1 = acc[ai][bj][m][1];
#pragma unroll
                        for (int j = 0; j < 4; ++j) { v0[j] *= a[j]; v1[j] *= a[j + 4]; }
                        *(u32x4*)(MIX + (size_t)row * 2048 + col) = pack8v(v0, v1);
                    }
                } }
            __builtin_amdgcn_sched_barrier(0);
        }
        return kind < 2;
    }
};
struct EpiResid {
    unsigned char* ws; int rboff, xboff, ssofs;
    __device__ __forceinline__ bool operator()(AccT& acc, const pg8::Unit& u, int wr, int wc, int fr, int fq) const {
        const bf16_t* RB = (const bf16_t*)(ws + WS_H + (size_t)rboff); bf16_t* XB = (bf16_t*)(ws + WS_H + (size_t)xboff); float* SSO = (float*)(ws + WS_X) + (size_t)ssofs * 8;
        const int row0_ = u.pm * 256 + wr * 64 + fr;
#pragma unroll
        for (int ai = 0; ai < 2; ++ai) {
            u32x4 rwv[4][2];
#pragma unroll
            for (int m = 0; m < 4; ++m)
#pragma unroll
                for (int bj = 0; bj < 2; ++bj) rwv[m][bj] = *(const u32x4*)(RB + (size_t)(row0_ + ai * 128 + m * 16) * 2048 + u.pn * 256 + bj * 128 + wc * 32 + 8 * fq);
            __builtin_amdgcn_sched_barrier(0);
#pragma unroll
            for (int m = 0; m < 4; ++m) { const int row = row0_ + ai * 128 + m * 16; float sq = 0.f;
#pragma unroll
                for (int bj = 0; bj < 2; ++bj) { const int col = u.pn * 256 + bj * 128 + wc * 32 + 8 * fq; const size_t o = (size_t)row * 2048 + col;
                    const u32x4 rw = rwv[m][bj]; f32x4 v0 = acc[ai][bj][m][0], v1 = acc[ai][bj][m][1];
                    v0[0] += bflo(rw.x); v0[1] += bfhi(rw.x); v0[2] += bflo(rw.y); v0[3] += bfhi(rw.y); v1[0] += bflo(rw.z); v1[1] += bfhi(rw.z); v1[2] += bflo(rw.w); v1[3] += bfhi(rw.w);
                    *(u32x4*)(XB + o) = pack8v(v0, v1);
                    sq += (v0[0] * v0[0] + v0[1] * v0[1]) + (v0[2] * v0[2] + v0[3] * v0[3]) + (v1[0] * v1[0] + v1[1] * v1[1]) + (v1[2] * v1[2] + v1[3] * v1[3]); }
                sq += shflx(sq, 16, fr + 16 * fq); sq += shflx(sq, 32, fr + 16 * fq); if (fq == 0) ps_write(ai * 128 + wr * 64 + m * 16 + fr, wc, sq); }
            __builtin_amdgcn_sched_barrier(0);
        }
        ps_finish(SSO, u, wr, wc, fr, fq);
        return false;
    }
};
struct EpiSwiglu {
    unsigned char* ws; int ssofs;
    __device__ __forceinline__ bool operator()(AccT& acc, const pg8::Unit& u, int wr, int wc, int fr, int fq) const {
        bf16_t* ACT = (bf16_t*)(ws + WS_ACT); const float* SS = (const float*)(ws + WS_X) + (size_t)ssofs * 8;
        const int row0_ = u.pm * 256 + wr * 64 + fr;
#pragma unroll
        for (int ai = 0; ai < 2; ++ai) { float rs4_[4]; load_rstd4(SS, row0_ + ai * 128, rs4_);
#pragma unroll
            for (int m = 0; m < 4; ++m) { const int row = row0_ + ai * 128 + m * 16; const int col = u.pn * 128 + wc * 32 + 8 * fq; const float rs_ = rs4_[m];
                f32x4 g0 = acc[ai][0][m][0] * rs_, g1 = acc[ai][0][m][1] * rs_; const f32x4 u0 = acc[ai][1][m][0] * rs_, u1 = acc[ai][1][m][1] * rs_;
#pragma unroll
                for (int j = 0; j < 4; ++j) { g0[j] = g0[j] * sigmoidf_(g0[j]) * u0[j]; g1[j] = g1[j] * sigmoidf_(g1[j]) * u1[j]; }
                *(u32x4*)(ACT + (size_t)row * DFF + col) = pack8v(g0, g1); } }
        return false;
    }
};
struct EpiBf16 {
    unsigned char* ws;
    __device__ __forceinline__ bool operator()(AccT& acc, const pg8::Unit& u, int wr, int wc, int fr, int fq) const {
        bf16_t* OUT = (bf16_t*)(ws + WS_PPB);
        EPI_LOOP_BEGIN *(u32x4*)(OUT + (size_t)row * 2048 + col) = pack8v(v0, v1); EPI_LOOP_END
        return false;
    }
};
struct EpiPle {
    unsigned char* ws; int ssofs;
    __device__ __forceinline__ bool operator()(AccT& acc, const pg8::Unit& u, int wr, int wc, int fr, int fq) const {
        const bf16_t* RB = (const bf16_t*)(ws + WS_HB); const bf16_t* PP = (const bf16_t*)(ws + WS_PPB); bf16_t* XB = (bf16_t*)(ws + WS_H);
        const float* SS = (const float*)(ws + WS_X) + (size_t)ssofs * 8; float* SSO = (float*)(ws + WS_X) + (size_t)(ssofs + TT) * 8;
        const int row0_ = u.pm * 256 + wr * 64 + fr;
#pragma unroll
        for (int ai = 0; ai < 2; ++ai) { float rs4_[4]; load_rstd4(SS, row0_ + ai * 128, rs4_);
#pragma unroll
          for (int mh = 0; mh < 2; ++mh) {
            u32x4 rwv[2][2], pwv[2][2];
#pragma unroll
            for (int mm = 0; mm < 2; ++mm)
#pragma unroll
                for (int bj = 0; bj < 2; ++bj) { const size_t o = (size_t)(row0_ + ai * 128 + (2 * mh + mm) * 16) * 2048 + u.pn * 256 + bj * 128 + wc * 32 + 8 * fq;
                    rwv[mm][bj] = *(const u32x4*)(RB + o); pwv[mm][bj] = *(const u32x4*)(PP + o); }
            __builtin_amdgcn_sched_barrier(0);
#pragma unroll
            for (int mm = 0; mm < 2; ++mm) { const int m = 2 * mh + mm; const int row = row0_ + ai * 128 + m * 16; const float rs_ = rs4_[m]; float sq = 0.f;
#pragma unroll
                for (int bj = 0; bj < 2; ++bj) { const int col = u.pn * 256 + bj * 128 + wc * 32 + 8 * fq; const size_t o = (size_t)row * 2048 + col;
                    const u32x4 rw = rwv[mm][bj], pw = pwv[mm][bj];
                    f32x4 v0 = acc[ai][bj][m][0] * rs_, v1 = acc[ai][bj][m][1] * rs_;
                    v0[0] = bflo(rw.x) + sigmoidf_(v0[0]) * bflo(pw.x); v0[1] = bfhi(rw.x) + sigmoidf_(v0[1]) * bfhi(pw.x); v0[2] = bflo(rw.y) + sigmoidf_(v0[2]) * bflo(pw.y); v0[3] = bfhi(rw.y) + sigmoidf_(v0[3]) * bfhi(pw.y);
                    v1[0] = bflo(rw.z) + sigmoidf_(v1[0]) * bflo(pw.z); v1[1] = bfhi(rw.z) + sigmoidf_(v1[1]) * bfhi(pw.z); v1[2] = bflo(rw.w) + sigmoidf_(v1[2]) * bflo(pw.w); v1[3] = bfhi(rw.w) + sigmoidf_(v1[3]) * bfhi(pw.w);
                    *(u32x4*)(XB + o) = pack8v(v0, v1);
                    sq += (v0[0] * v0[0] + v0[1] * v0[1]) + (v0[2] * v0[2] + v0[3] * v0[3]) + (v1[0] * v1[0] + v1[1] * v1[1]) + (v1[2] * v1[2] + v1[3] * v1[3]); }
                sq += shflx(sq, 16, fr + 16 * fq); sq += shflx(sq, 32, fr + 16 * fq); if (fq == 0) ps_write(ai * 128 + wr * 64 + m * 16 + fr, wc, sq); }
            __builtin_amdgcn_sched_barrier(0);
          } }
        ps_finish(SSO, u, wr, wc, fr, fq);
        return false;
    }
};

constexpr int LDS_MISC = 131072, LDS_PSUM = 132096, LDS_BYTES = 132096 + 4096;
constexpr int PPL = 8;
constexpr int NPHASE = 2 + PPL * NLAYER;

struct Args { const float* in[19]; float* out; unsigned char* ws; int ph_lo, ph_hi; };

__device__ __forceinline__ float wave_sum(float v, int lane) {
#pragma unroll
    for (int o = 1; o < 64; o <<= 1) v += shflx(v, o, lane);
    return v;
}
template <bool F32OUT>
__device__ __forceinline__ void rmsnorm_rows(const float* X, const float* G, bf16_t* OB, float* OF) {
    const int tid_ = opaque_tid(); const int lane = tid_ & 63, gw = blockIdx.x * 8 + (tid_ >> 6), ngw = gridDim.x * 8;
    for (int row = gw; row < TT; row += ngw) {
        const f32x4* xr = (const f32x4*)(X + (size_t)row * DM) + lane;
        f32x4 v[8]; float s = 0.f;
#pragma unroll
        for (int j = 0; j < 8; ++j) { v[j] = xr[64 * j]; s += (v[j][0] * v[j][0] + v[j][1] * v[j][1]) + (v[j][2] * v[j][2] + v[j][3] * v[j][3]); }
        const float rstd = 1.0f / sqrtf(wave_sum(s, lane) * (1.0f / DM) + EPS);
#pragma unroll
        for (int j = 0; j < 8; ++j) { const f32x4 gg = ((const f32x4*)G)[lane + 64 * j]; const f32x4 y = v[j] * rstd * gg;
            if (F32OUT) ((f32x4*)(OF + (size_t)row * DM))[lane + 64 * j] = y;
            else { u32x2 w; w.x = cvt_pk_bf16(y[0], y[1]); w.y = cvt_pk_bf16(y[2], y[3]); ((u32x2*)(OB + (size_t)row * DM))[lane + 64 * j] = w; } }
    }
}

__device__ __forceinline__ void final_norm_rows(const bf16_t* XB, const float* SS, const float* G, float* OF) {
    const int tid_ = opaque_tid(); const int lane = tid_ & 63, gw = blockIdx.x * 8 + (tid_ >> 6), ngw = gridDim.x * 8;
    for (int row = gw; row < TT; row += ngw) {
        const float rstd = rstd_row(SS, row);
#pragma unroll
        for (int j = 0; j < 4; ++j) { const u32x4 w = ((const u32x4*)(XB + (size_t)row * DM))[lane + 64 * j];
            const f32x4 ga = ((const f32x4*)G)[2 * (lane + 64 * j)], gb = ((const f32x4*)G)[2 * (lane + 64 * j) + 1];
            f32x4 y0, y1; y0[0] = bflo(w.x) * rstd * ga[0]; y0[1] = bfhi(w.x) * rstd * ga[1]; y0[2] = bflo(w.y) * rstd * ga[2]; y0[3] = bfhi(w.y) * rstd * ga[3];
            y1[0] = bflo(w.z) * rstd * gb[0]; y1[1] = bfhi(w.z) * rstd * gb[1]; y1[2] = bflo(w.w) * rstd * gb[2]; y1[3] = bfhi(w.w) * rstd * gb[3];
            ((f32x4*)(OF + (size_t)row * DM))[2 * (lane + 64 * j)] = y0; ((f32x4*)(OF + (size_t)row * DM))[2 * (lane + 64 * j) + 1] = y1; }
    }
}
__device__ __forceinline__ void rows_bf16_ss(const float* X, bf16_t* OB, float* SSO) {
    const int tid_ = opaque_tid(); const int lane = tid_ & 63, gw = blockIdx.x * 8 + (tid_ >> 6), ngw = gridDim.x * 8;
    for (int row = gw; row < TT; row += ngw) {
        const f32x4* xr = (const f32x4*)(X + (size_t)row * DM) + lane; float s = 0.f;
#pragma unroll
        for (int j = 0; j < 8; ++j) { const f32x4 v = xr[64 * j]; s += (v[0] * v[0] + v[1] * v[1]) + (v[2] * v[2] + v[3] * v[3]);
            u32x2 w; w.x = cvt_pk_bf16(v[0], v[1]); w.y = cvt_pk_bf16(v[2], v[3]); ((u32x2*)(OB + (size_t)row * DM))[lane + 64 * j] = w; }
        s = wave_sum(s, lane); if (lane == 0) { float z = 0.f; asm volatile("" : "+v"(z)); *(f32x4*)(SSO + (size_t)row * 8) = (f32x4){s, z, z, z}; *(f32x4*)(SSO + (size_t)row * 8 + 4) = (f32x4){z, z, z, z}; }
    }
}
struct TJob { const float* src; const float* gain; bf16_t* dst; int N, ldd, k0, n0, drow0, dk0; };
__device__ __forceinline__ TJob tjob_decode(const Args& a, int it) {
    constexpr int C_IN = 16 * 92, C_BP = 4 * 16, C_BS = 8 * 16, C_BH = 4 * 16, C_OUT = 256, C_GU = 16 * 88, C_DN = 44 * 16, C_PG = 256, C_PP = 2 * 16;
    constexpr int PER_L = C_IN + C_BP + C_BS + C_BH + C_OUT + C_GU + C_DN + C_PG + C_PP;
    const int L = it / PER_L; int r = it - L * PER_L;
    unsigned char* wl = a.ws + WS_W0 + (size_t)L * WL_SIZE;
    TJob J; J.gain = nullptr; J.dk0 = 0; int nkb, gu = 0;
    if (r < C_IN) { J.src = a.in[3] + (size_t)L * DM * INC; J.N = INC; J.dst = (bf16_t*)(wl + WL_IN); J.ldd = DM; nkb = 16; J.gain = a.in[2] + (size_t)L * DM; }
    else if ((r -= C_IN) < C_BP) { J.src = a.in[8] + (size_t)L * 512 * DM; J.N = DM; J.dst = (bf16_t*)(wl + WL_BR); J.ldd = DM; nkb = 4; }
    else if ((r -= C_BP) < C_BS) { J.src = a.in[9] + (size_t)L * 1024 * DM; J.N = DM; J.dst = (bf16_t*)(wl + WL_BR); J.ldd = DM; J.dk0 = 512; nkb = 8; }
    else if ((r -= C_BS) < C_BH) { J.src = a.in[10] + (size_t)L * 512 * DM; J.N = DM; J.dst = (bf16_t*)(wl + WL_BR); J.ldd = DM; J.dk0 = 1536; nkb = 4; }
    else if ((r -= C_BH) < C_OUT) { J.src = a.in[11] + (size_t)L * DM * DM; J.N = DM; J.dst = (bf16_t*)(wl + WL_OUT); J.ldd = DM; nkb = 16; }
    else if ((r -= C_OUT) < C_GU) { J.src = a.in[13] + (size_t)L * DM * 2 * DFF; J.N = 2 * DFF; J.dst = (bf16_t*)(wl + WL_GU); J.ldd = DM; nkb = 16; gu = 1; J.gain = a.in[12] + (size_t)L * DM; }
    else if ((r -= C_GU) < C_DN) { J.src = a.in[14] + (size_t)L * DFF * DM; J.N = DM; J.dst = (bf16_t*)(wl + WL_DN); J.ldd = DFF; nkb = 44; }
    else if ((r -= C_DN) < C_PG) { J.src = a.in[16] + (size_t)L * DM * DM; J.N = DM; J.dst = (bf16_t*)(wl + WL_PG); J.ldd = DM; nkb = 16; J.gain = a.in[15] + (size_t)L * DM; }
    else { r -= C_PG; J.src = a.in[17] + (size_t)L * PLE * DM; J.N = DM; J.dst = (bf16_t*)(wl + WL_PP); J.ldd = PLE; nkb = 2; }
    const int nb = r / nkb, kb = r - nb * nkb;
    J.drow0 = nb * 128; if (gu) J.drow0 = nb < 44 ? 256 * nb : 256 * (nb - 44) + 128;
    J.k0 = kb * 128; J.n0 = nb * 128;
    return J;
}
__device__ __forceinline__ void tjob_load(const TJob& J, int tid, f32x4 (&v)[8]) {
#pragma unroll
    for (int p = 0; p < 8; ++p) { const int k = p * 16 + (tid >> 5), c = (tid & 31) * 4;
        v[p] = __builtin_nontemporal_load((const f32x4*)(J.src + (size_t)(J.k0 + k) * J.N + J.n0 + c)); if (J.gain) v[p] = v[p] * J.gain[J.k0 + k]; }
}
__device__ __forceinline__ void tjob_finish(const TJob& J, int tid, const f32x4 (&v)[8], float* sm) {
#pragma unroll
    for (int p = 0; p < 8; ++p) { const int k = p * 16 + (tid >> 5), c = (tid & 31) * 4; float* s = sm + k * 129 + c; s[0] = v[p][0]; s[1] = v[p][1]; s[2] = v[p][2]; s[3] = v[p][3]; }
    __syncthreads();
#pragma unroll
    for (int i = 0; i < 4; ++i) { const int item = tid + 512 * i, c = item & 15, n = item >> 4; const float* s = sm + (8 * c) * 129 + n;
        u32x4 w; w.x = cvt_pk_bf16(s[0], s[129]); w.y = cvt_pk_bf16(s[2 * 129], s[3 * 129]); w.z = cvt_pk_bf16(s[4 * 129], s[5 * 129]); w.w = cvt_pk_bf16(s[6 * 129], s[7 * 129]);
        *(u32x4*)(J.dst + (size_t)(J.drow0 + n) * J.ldd + J.dk0 + J.k0 + 8 * c) = w; }
    __syncthreads();
}

__device__ __forceinline__ void prologue_phase(const Args& a, unsigned char* lds) {
    float* sm = (float*)lds;
    constexpr int N_ITEMS = NLAYER * (16 * 92 + 4 * 16 + 8 * 16 + 4 * 16 + 256 + 16 * 88 + 44 * 16 + 256 + 2 * 16);
    {   const int tid = opaque_tid();
        int it = blockIdx.x;
        if (it < N_ITEMS) {
            TJob J = tjob_decode(a, it); f32x4 v[8]; tjob_load(J, tid, v);
            for (;;) {
                const int itn = it + gridDim.x; const bool more = itn < N_ITEMS;
                TJob Jn = J; f32x4 vn[8];
#pragma unroll
                for (int p = 0; p < 8; ++p) vn[p] = v[p];
                if (more) { Jn = tjob_decode(a, itn); tjob_load(Jn, tid, vn); }
                tjob_finish(J, tid, v, sm);
                if (!more) break;
                J = Jn; it = itn;
#pragma unroll
                for (int p = 0; p < 8; ++p) v[p] = vn[p];
            }
        }
    }
    { const f32x4* ps = (const f32x4*)a.in[1]; u32x2* pd = (u32x2*)(a.ws + WS_PB); const int n4 = NLAYER * TT * PLE / 4;
      for (int i = blockIdx.x * 512 + opaque_tid(); i < n4; i += gridDim.x * 512) { const f32x4 v = ps[i]; u32x2 w; w.x = cvt_pk_bf16(v[0], v[1]); w.y = cvt_pk_bf16(v[2], v[3]); pd[i] = w; } }
    rows_bf16_ss(a.in[0], (bf16_t*)(a.ws + WS_H), (float*)(a.ws + WS_X));
}

__device__ __forceinline__ void pool_unit(unsigned char* lds, int tile, int gi, int L, const Args& a) {
    float* Wl = (float*)lds; float* uw = Wl + 128 * 128; float* mx = uw + 47 * 128;
    const int tid = opaque_tid();
    const float* U = (const float*)(a.ws + WS_U);
    const float* PW = a.in[4] + ((size_t)L * 4 + gi) * 128 * 128;
    const int t0 = tile * 32, s0 = t0 & (SEQ - 1);
#pragma unroll
    for (int i = 0; i < 8; ++i) ((f32x4*)Wl)[tid + 512 * i] = ((const f32x4*)PW)[tid + 512 * i];
    for (int i = tid; i < 47 * 32; i += 512) { const int rr = i >> 5, c4 = i & 31; const int sp = s0 - 15 + rr;
        f32x4 v = (f32x4){0.f, 0.f, 0.f, 0.f};
        if (sp >= 0) v = *(const f32x4*)(U + (size_t)(t0 - 15 + rr) * 512 + gi * 128 + c4 * 4);
        ((f32x4*)uw)[i] = v; }
    __syncthreads();
    const int w = 2 << gi;
    for (int i = tid; i < 32 * 128; i += 512) { const int tt = i >> 7, c = i & 127; float s = 0.f;
        for (int j = 0; j < w; ++j) s += uw[(15 + tt - j) * 128 + c];
        const int cnt = min(s0 + tt + 1, w);
        mx[i] = s / (float)cnt - uw[(15 + tt) * 128 + c]; }
    __syncthreads();
    const int d = tid & 127, tg = tid >> 7;
    float acc[8];
#pragma unroll
    for (int j = 0; j < 8; ++j) acc[j] = 0.f;
    for (int c = 0; c < 128; c += 4) {
        const float w0 = Wl[c * 128 + d], w1 = Wl[(c + 1) * 128 + d], w2 = Wl[(c + 2) * 128 + d], w3 = Wl[(c + 3) * 128 + d];
#pragma unroll
        for (int j = 0; j < 8; ++j) { const f32x4 mv = *(const f32x4*)(mx + (tg * 8 + j) * 128 + c); acc[j] += mv[0] * w0 + mv[1] * w1 + mv[2] * w2 + mv[3] * w3; }
    }
    const float sc = a.in[5][(size_t)L * 512 + gi * 128 + d];
    bf16_t* Y = (bf16_t*)(a.ws + WS_Y);
#pragma unroll
    for (int j = 0; j < 8; ++j) Y[(size_t)(t0 + tg * 8 + j) * 2048 + gi * 128 + d] = (bf16_t)(cvt_pk_bf16(acc[j] * sc, 0.f) & 0xffff);
    __syncthreads();
}

__device__ __forceinline__ void attn_unit(unsigned char* lds, int b, int h, int qb, const Args& a) {
    const bf16_t* SQ = (const bf16_t*)(a.ws + WS_SQ); const bf16_t* SK = (const bf16_t*)(a.ws + WS_SK); const bf16_t* VT = (const bf16_t*)(a.ws + WS_VT);
    bf16_t* Y = (bf16_t*)(a.ws + WS_Y);
    const int tid = opaque_tid(), lane = tid & 63, wid = tid >> 6, r = lane & 31, hi = lane >> 5;
    const int q0 = qb * 256, qw0 = q0 + wid * 32;
    const size_t rowbase = (size_t)b * SEQ;
    constexpr int KBY = 64 * 272, VBY = 128 * 144, BUF = KBY + VBY;
    volatile unsigned* FLG = (volatile unsigned*)(lds + 2 * BUF);
    bf16x8 qf[8];
    { const bf16_t* qp = SQ + (rowbase + qw0 + r) * 1024 + h * 128 + hi * 8;
#pragma unroll
      for (int ds = 0; ds < 8; ++ds) qf[ds] = *(const bf16x8*)(qp + ds * 16); }
    f32x16 o[4];
#pragma unroll
    for (int i = 0; i < 4; ++i)
#pragma unroll
        for (int j = 0; j < 16; ++j) o[i][j] = 0.f;
    float R = 1.f;
    const int jmax = qb * 4 + 3;
    u32x4 st[4];
#define ATT_LOAD(jj) do { _Pragma("unroll") for (int i = 0; i < 2; ++i) { const int ch = tid + 512 * i; \
        st[i] = *(const u32x4*)(SK + (rowbase + 64 * (jj) + (ch >> 4)) * 1024 + h * 128 + (ch & 15) * 8); \
        st[2 + i] = *(const u32x4*)(VT + (((size_t)(b * 8 + h) * 128 + (ch >> 3)) << 11) + 64 * (jj) + (ch & 7) * 8); } } while (0)
#define ATT_STORE(bufp) do { _Pragma("unroll") for (int i = 0; i < 2; ++i) { const int ch = tid + 512 * i; \
        *(u32x4*)((bufp) + (ch >> 4) * 272 + (ch & 15) * 16) = st[i]; *(u32x4*)((bufp) + KBY + (ch >> 3) * 144 + (ch & 7) * 16) = st[2 + i]; } } while (0)
    ATT_LOAD(jmax); ATT_STORE(lds);
    __syncthreads();
    for (int j = jmax; j >= 0; --j) {
        const int cur = (jmax - j) & 1;
        if (j > 0) ATT_LOAD(j - 1);
        if (64 * j <= qw0 + 31) {
            const unsigned char* Kb = lds + cur * BUF; const unsigned char* Vb = Kb + KBY;
            f32x16 p[2];
#pragma unroll
            for (int hh = 0; hh < 2; ++hh) {
#pragma unroll
                for (int jj = 0; jj < 16; ++jj) p[hh][jj] = 0.f;
#pragma unroll
                for (int ds = 0; ds < 8; ++ds) { const bf16x8 ka = *(const bf16x8*)(Kb + (32 * hh + r) * 272 + (16 * ds + 8 * hi) * 2); p[hh] = MFMA32(ka, qf[ds], p[hh]); }
            }
            const int t = qw0 + r; const int sbase = 64 * j + 4 * hi;
            float G[8];
#define ATT_ELEM(MASKED) \
            _Pragma("unroll") for (int hh = 0; hh < 2; ++hh) \
                _Pragma("unroll") for (int g = 0; g < 4; ++g) { \
                    float mm[4], bb[4]; \
                    _Pragma("unroll") for (int i = 0; i < 4; ++i) { const float uu = __builtin_amdgcn_exp2f(p[hh][4 * g + i]); \
                        const float mi = __builtin_amdgcn_rcpf(1.0f + uu); \
                        if (MASKED) { const int s = sbase + 32 * hh + 8 * g + i; const bool valid = s < t; mm[i] = valid ? mi : 1.0f; bb[i] = valid ? 1.0f - mi : 0.0f; } \
                        else { mm[i] = mi; bb[i] = 1.0f - mi; } } \
                    const float e2 = mm[3], e1 = mm[2] * e2, e0 = mm[1] * e1; \
                    G[hh * 4 + g] = mm[0] * e0; \
                    p[hh][4 * g + 0] = bb[0] * e0; p[hh][4 * g + 1] = bb[1] * e1; p[hh][4 * g + 2] = bb[2] * e2; p[hh][4 * g + 3] = bb[3]; \
                }
            if (64 * j + 63 < qw0) { ATT_ELEM(false) } else { ATT_ELEM(true) }
#undef ATT_ELEM
            float X = 1.0f;
#pragma unroll
            for (int idx = 7; idx >= 0; --idx) { const float gp = shflx(G[idx], 32, lane); const float f = X * (hi == 0 ? gp : 1.0f) * R;
                const int hh = idx >> 2, g = idx & 3;
#pragma unroll
                for (int i = 0; i < 4; ++i) p[hh][4 * g + i] *= f;
                X *= G[idx] * gp; }
            R *= X;
            bf16x8 pa[4];
#pragma unroll
            for (int kb = 0; kb < 4; ++kb) { const int hh = kb >> 1, b8 = (kb & 1) * 8;
                pa[kb] = pack8(p[hh][b8], p[hh][b8 + 1], p[hh][b8 + 2], p[hh][b8 + 3], p[hh][b8 + 4], p[hh][b8 + 5], p[hh][b8 + 6], p[hh][b8 + 7]); }
#pragma unroll
            for (int kb = 0; kb < 4; ++kb)
#pragma unroll
                for (int db = 0; db < 4; ++db) { const unsigned char* vp = Vb + (32 * db + r) * 144 + (16 * kb + 4 * hi) * 2;
                    const s16x4 lo = *(const s16x4*)vp, hi4 = *(const s16x4*)(vp + 16);
                    const bf16x8 vf = (bf16x8){lo[0], lo[1], lo[2], lo[3], hi4[0], hi4[1], hi4[2], hi4[3]};
                    o[db] = MFMA32(pa[kb], vf, o[db]); }
        }
        { const bool wdone = __builtin_amdgcn_ballot_w64(R != 0.0f) == 0ull;
          if (lane == 0) FLG[cur * 8 + wid] = wdone ? 1u : 0u; }
        if (j > 0) ATT_STORE(lds + (cur ^ 1) * BUF);
        __syncthreads();
        unsigned alld = 1u;
#pragma unroll
        for (int w = 0; w < 8; ++w) alld &= FLG[cur * 8 + w];
        if (alld) break;
    }
#undef ATT_LOAD
#undef ATT_STORE
#pragma unroll
    for (int db = 0; db < 4; ++db)
#pragma unroll
        for (int reg = 0; reg < 16; ++reg)
            Y[(rowbase + qw0 + crow(reg, hi)) * 2048 + 512 + h * 128 + 32 * db + r] = (bf16_t)(cvt_pk_bf16(o[db][reg], 0.f) & 0xffff);
    __syncthreads();
}

__device__ __forceinline__ void hgrn_prep_unit(unsigned char* lds, int bh, int c, int L, const Args& a) {
    const float* ZF = (const float*)(a.ws + WS_ZF); const float* HQ = (const float*)(a.ws + WS_HQ); const bf16_t* HV = (const bf16_t*)(a.ws + WS_HV);
    bf16_t* HQD = (bf16_t*)(a.ws + WS_HQD); bf16_t* HKD = (bf16_t*)(a.ws + WS_HKD); bf16_t* HVT = (bf16_t*)(a.ws + WS_HVT);
    float* HDEC = (float*)(a.ws + WS_HDEC); float* HOI = (float*)(a.ws + WS_HOI);
    const int b = bh >> 2, h = bh & 3;
    const int tid = opaque_tid(), lane = tid & 63, wid = tid >> 6, r = lane & 31, hi = lane >> 5;
    float* TOT = (float*)lds; unsigned char* QD = lds + 2048; unsigned char* KT = QD + 32 * 272; unsigned char* VTl = KT + 32 * 272;
    const int k = tid & 127, tq = tid >> 7;
    float lbA, lbB, oml;
    { const int ch = h * 128 + k; const float h0 = a.in[6][ch], h1 = a.in[6][512 + ch]; const float mxv = fmaxf(h0, h1);
      const float e0 = __expf(h0 - mxv), e1 = __expf(h1 - mxv); float lb = (L == 0) ? 0.f : e1 / (e0 + e1);
      lb = fminf(fmaxf(lb, 0.f), 1.f); lbA = fmaxf(lb, 1e-20f); lbB = 1.0f - fminf(lb, 1.0f - 1e-6f); oml = 1.0f - lb; }
    const size_t row0 = (size_t)b * SEQ + c * 32;
    const size_t gbase = (row0 + tq * 8) * 512 + h * 128 + k;
    const size_t fidx = (size_t)(bh * 64 + c) * 4096 + (size_t)((((k >> 5) * 2 + (tq >> 1)) * 64 + (tq & 1) * 32 + (k & 31)) * 8);
    float kk[8], bl[8], qv[8]; float bs = 0.f;
#pragma unroll
    for (int i = 0; i < 8; ++i) { float zf = ZF[gbase + (size_t)i * 512]; qv[i] = HQ[gbase + (size_t)i * 512];
        zf = fminf(fmaxf(zf, -80.f), 80.f); const float e = __expf(-zf); const float sg = __builtin_amdgcn_rcpf(1.0f + e);
        const float f = lbA + lbB * sg; bs += logf(f); bl[i] = bs; kk[i] = oml * e * sg; }
    TOT[tq * 128 + k] = bs;
    { unsigned short x[8];
#pragma unroll
      for (int i = 0; i < 8; ++i) x[i] = HV[gbase + (size_t)i * 512];
      u32x4 w; w.x = x[0] | ((unsigned)x[1] << 16); w.y = x[2] | ((unsigned)x[3] << 16); w.z = x[4] | ((unsigned)x[5] << 16); w.w = x[6] | ((unsigned)x[7] << 16);
      *(u32x4*)(VTl + k * 80 + tq * 16) = w; *(u32x4*)(HVT + fidx) = w; }
    __syncthreads();
    float off = 0.f, tot = 0.f;
#pragma unroll
    for (int q = 0; q < 4; ++q) { const float v = TOT[q * 128 + k]; tot += v; if (q < tq) off += v; }
    float kd[8];
#pragma unroll
    for (int i = 0; i < 8; ++i) { const float bt = off + bl[i]; const int t = tq * 8 + i;
        *(bf16_t*)(QD + t * 272 + k * 2) = (bf16_t)(cvt_pk_bf16(qv[i] * __expf(bt), 0.f) & 0xffff);
        *(bf16_t*)(KT + t * 272 + k * 2) = (bf16_t)(cvt_pk_bf16(kk[i] * __expf(fminf(-bt, 80.f)), 0.f) & 0xffff);
        kd[i] = kk[i] * __expf(tot - bt); }
    *(bf16x8*)(HKD + fidx) = pack8(kd[0], kd[1], kd[2], kd[3], kd[4], kd[5], kd[6], kd[7]);
    if (tq == 0) HDEC[(size_t)(bh * 64 + c) * 128 + k] = __expf(tot);
    __syncthreads();
    { const int k0 = 32 * (wid >> 1) + 16 * (wid & 1) + 4 * hi; const unsigned char* p = QD + r * 272 + k0 * 2;
      const s16x4 lo = *(const s16x4*)p, hi4 = *(const s16x4*)(p + 16);
      *(bf16x8*)(HQD + (size_t)(bh * 64 + c) * 4096 + (wid * 64 + lane) * 8) = (bf16x8){lo[0], lo[1], lo[2], lo[3], hi4[0], hi4[1], hi4[2], hi4[3]}; }
    if (wid < 4) {
        const int w = wid;
        f32x16 pt;
#pragma unroll
        for (int j = 0; j < 16; ++j) pt[j] = 0.f;
#pragma unroll
        for (int ks = 0; ks < 8; ++ks) { const bf16x8 ka = *(const bf16x8*)(KT + r * 272 + (16 * ks + 8 * hi) * 2); const bf16x8 qa = *(const bf16x8*)(QD + r * 272 + (16 * ks + 8 * hi) * 2);
            pt = MFMA32(ka, qa, pt); }
#pragma unroll
        for (int reg = 0; reg < 16; ++reg) { if (crow(reg, hi) > r) pt[reg] = 0.f; }
        const bf16x8 pa0 = pack8(pt[0], pt[1], pt[2], pt[3], pt[4], pt[5], pt[6], pt[7]);
        const bf16x8 pa1 = pack8(pt[8], pt[9], pt[10], pt[11], pt[12], pt[13], pt[14], pt[15]);
        f32x16 o;
#pragma unroll
        for (int j = 0; j < 16; ++j) o[j] = 0.f;
#pragma unroll
        for (int s16 = 0; s16 < 2; ++s16) { const unsigned char* vp = VTl + (32 * w + r) * 80 + (16 * s16 + 4 * hi) * 2;
            const s16x4 lo = *(const s16x4*)vp, hi4 = *(const s16x4*)(vp + 16);
            const bf16x8 vf = (bf16x8){lo[0], lo[1], lo[2], lo[3], hi4[0], hi4[1], hi4[2], hi4[3]};
            o = MFMA32(s16 ? pa1 : pa0, vf, o); }
#pragma unroll
        for (int reg = 0; reg < 16; ++reg) HOI[(row0 + crow(reg, hi)) * 512 + h * 128 + 32 * w + r] = o[reg];
    }
    __syncthreads();
}

__device__ __forceinline__ float dpp_sum16(float v) {
    v += __int_as_float(__builtin_amdgcn_update_dpp(0, __float_as_int(v), 0xB1, 0xF, 0xF, true));
    v += __int_as_float(__builtin_amdgcn_update_dpp(0, __float_as_int(v), 0x4E, 0xF, 0xF, true));
    v += __int_as_float(__builtin_amdgcn_update_dpp(0, __float_as_int(v), 0x141, 0xF, 0xF, true));
    v += __int_as_float(__builtin_amdgcn_update_dpp(0, __float_as_int(v), 0x140, 0xF, 0xF, true));
    return v;
}
__device__ __forceinline__ void hgrn_chain_unit(unsigned char* lds, int bh, int L, const Args& a) {
    const bf16_t* HQD = (const bf16_t*)(a.ws + WS_HQD); const bf16_t* HKD = (const bf16_t*)(a.ws + WS_HKD); const bf16_t* HVT = (const bf16_t*)(a.ws + WS_HVT);
    const float* HDEC = (const float*)(a.ws + WS_HDEC); const float* HOI = (const float*)(a.ws + WS_HOI);
    const bf16_t* OG = (const bf16_t*)(a.ws + WS_OG); bf16_t* Y = (bf16_t*)(a.ws + WS_Y);
    const int b = bh >> 2, h = bh & 3;
    const int tid = opaque_tid(), lane = tid & 63, wid = tid >> 6, r = lane & 31, hi = lane >> 5;
    constexpr int BUFB = 25088;
    float* OB = (float*)(lds + 3 * BUFB);
    f32x16 Sacc[4];
#pragma unroll
    for (int i = 0; i < 4; ++i)
#pragma unroll
        for (int j = 0; j < 16; ++j) Sacc[i][j] = 0.f;
    const size_t cb = (size_t)bh * 64;
    const size_t rowb = (size_t)b * SEQ;
    u32x4 stA[3], stB[3]; f32x4 sdA = (f32x4){0.f, 0.f, 0.f, 0.f}, sdB = sdA;
#define HG_LOAD(cc, st, sd) do { const int cc_ = (cc) < 63 ? (cc) : 63; const size_t e_ = (cb + cc_) * 4096 + (size_t)tid * 8; st[0] = *(const u32x4*)(HQD + e_); st[1] = *(const u32x4*)(HKD + e_); st[2] = *(const u32x4*)(HVT + e_); \
        sd = *(const f32x4*)(HDEC + (cb + cc_) * 128 + (tid & 31) * 4); } while (0)
#define HG_STORE(bi, st, sd) do { unsigned char* B_ = lds + (bi) * BUFB; *(u32x4*)(B_ + tid * 16) = st[0]; *(u32x4*)(B_ + 8192 + tid * 16) = st[1]; *(u32x4*)(B_ + 16384 + tid * 16) = st[2]; \
        if (tid < 32) *(f32x4*)(B_ + 24576 + tid * 16) = sd; } while (0)
    HG_LOAD(0, stA, sdA); HG_STORE(0, stA, sdA); HG_LOAD(1, stA, sdA); HG_STORE(1, stA, sdA);
    HG_LOAD(2, stB, sdB);
    const int pt_ = tid >> 4, seg = tid & 15; const int ch = h * 128 + seg * 8;
    const float* gn = a.in[7] + (size_t)L * 512 + ch; const f32x4 g0 = *(const f32x4*)gn, g1 = *(const f32x4*)(gn + 4);
    f32x4 oiA0, oiA1, oiB0, oiB1; u32x4 ogA, ogB;
#define HG_PLOAD(cc, o0, o1, og_) do { const int cp_ = (cc) < 63 ? (cc) : 63; const size_t row_ = rowb + cp_ * 32 + pt_; o0 = *(const f32x4*)(HOI + row_ * 512 + ch); o1 = *(const f32x4*)(HOI + row_ * 512 + ch + 4); og_ = *(const u32x4*)(OG + row_ * 512 + ch); } while (0)
    HG_PLOAD(0, oiA0, oiA1, ogA);
    __syncthreads();
#define HG_ITER(c, stX, sdX, stY, sdY, oiC0, oiC1, ogC, oiN0, oiN1, ogN) do { \
        const int bi = (c) % 3; \
        HG_LOAD((c) + 3, stX, sdX); \
        HG_PLOAD((c) + 1, oiN0, oiN1, ogN); \
        if (wid < 4) { \
            const int w = wid; const unsigned char* B = lds + bi * BUFB; \
            f32x16 o, o2; \
            _Pragma("unroll") for (int j = 0; j < 16; ++j) { o[j] = 0.f; o2[j] = 0.f; } \
            _Pragma("unroll") for (int kb = 0; kb < 4; ++kb) \
                _Pragma("unroll") for (int s16 = 0; s16 < 2; ++s16) { const bf16x8 aq = *(const bf16x8*)(B + ((kb * 2 + s16) * 64 + lane) * 16); const int b8 = 8 * s16; \
                    const bf16x8 bsv = pack8(Sacc[kb][b8], Sacc[kb][b8 + 1], Sacc[kb][b8 + 2], Sacc[kb][b8 + 3], Sacc[kb][b8 + 4], Sacc[kb][b8 + 5], Sacc[kb][b8 + 6], Sacc[kb][b8 + 7]); \
                    if (kb < 2) o = MFMA32(aq, bsv, o); else o2 = MFMA32(aq, bsv, o2); } \
            _Pragma("unroll") for (int kb = 0; kb < 4; ++kb) { \
                _Pragma("unroll") for (int g = 0; g < 4; ++g) { const f32x4 dd = *(const f32x4*)(B + 24576 + (32 * kb + 8 * g + 4 * hi) * 4); \
                    _Pragma("unroll") for (int i = 0; i < 4; ++i) Sacc[kb][4 * g + i] *= dd[i]; } \
                _Pragma("unroll") for (int s16 = 0; s16 < 2; ++s16) { const bf16x8 ka = *(const bf16x8*)(B + 8192 + ((kb * 2 + s16) * 64 + lane) * 16); \
                    const bf16x8 va = *(const bf16x8*)(B + 16384 + ((w * 2 + s16) * 64 + lane) * 16); \
                    Sacc[kb] = MFMA32(ka, va, Sacc[kb]); } \
            } \
            _Pragma("unroll") for (int reg = 0; reg < 16; ++reg) OB[crow(reg, hi) * 132 + 32 * w + r] = o[reg] + o2[reg]; \
        } \
        __syncthreads(); \
        { const size_t row = rowb + (c) * 32 + pt_; const float* op = OB + pt_ * 132 + seg * 8; \
          const f32x4 x0 = *(const f32x4*)op + oiC0, x1 = *(const f32x4*)(op + 4) + oiC1; \
          float ss = (x0[0] * x0[0] + x0[1] * x0[1]) + (x0[2] * x0[2] + x0[3] * x0[3]) + (x1[0] * x1[0] + x1[1] * x1[1]) + (x1[2] * x1[2] + x1[3] * x1[3]); \
          ss = dpp_sum16(ss); \
          const float rstd = __builtin_amdgcn_rsqf(ss * (1.0f / 128.0f) + EPS); \
          f32x4 y0, y1; \
          y0[0] = x0[0] * rstd * g0[0] * bflo(ogC.x); y0[1] = x0[1] * rstd * g0[1] * bfhi(ogC.x); y0[2] = x0[2] * rstd * g0[2] * bflo(ogC.y); y0[3] = x0[3] * rstd * g0[3] * bfhi(ogC.y); \
          y1[0] = x1[0] * rstd * g1[0] * bflo(ogC.z); y1[1] = x1[1] * rstd * g1[1] * bfhi(ogC.z); y1[2] = x1[2] * rstd * g1[2] * bflo(ogC.w); y1[3] = x1[3] * rstd * g1[3] * bfhi(ogC.w); \
          *(u32x4*)(Y + row * 2048 + 1536 + ch) = pack8v(y0, y1); } \
        HG_STORE(((c) + 2) % 3, stY, sdY); \
        __syncthreads(); \
    } while (0)
    for (int c = 0; c < 64; c += 2) {
        HG_ITER(c, stA, sdA, stB, sdB, oiA0, oiA1, ogA, oiB0, oiB1, ogB);
        HG_ITER(c + 1, stB, sdB, stA, sdA, oiB0, oiB1, ogB, oiA0, oiA1, ogA);
    }
#undef HG_ITER
#undef HG_PLOAD
#undef HG_LOAD
#undef HG_STORE
}

#define WQ_NEXT(cw) ({ if (threadIdx.x == 0) sh[0] = atomicAdd((cw), 1u); __syncthreads(); const int u_ = (int)sh[0]; __syncthreads(); u_; })
constexpr int INP_MAIN_COLT = 32;
__device__ __forceinline__ void mixer_phase(const Args& a, unsigned char* lds, int L, int mp, int rep) {
    unsigned* ctr = (unsigned*)(a.ws + WS_CTL) + 64 * (L * 4 + mp * 2 + rep);
    volatile unsigned* sh = (volatile unsigned*)(lds + LDS_MISC);
    if (mp == 0) {
        for (;;) { const int u = WQ_NEXT(ctr); if (u >= 2048) break;
            if (u < 1024) hgrn_prep_unit(lds, u >> 6, u & 63, L, a);
            else { const int x = u - 1024; pool_unit(lds, x >> 2, x & 3, L, a); } }
    } else {
        { const int u = WQ_NEXT(ctr); if (u < 16) { hgrn_chain_unit(lds, u, L, a); if (CHAIN_TWICE) { __syncthreads(); hgrn_chain_unit(lds, u, L, a); } } }
        for (;;) { const int x = WQ_NEXT(ctr + 8); if (x >= 32 * (46 - INP_MAIN_COLT)) break;
            pg8::Gemm g{(const bf16_t*)(a.ws + WS_H), (const bf16_t*)(a.ws + WS_W0 + (size_t)L * WL_SIZE + WL_IN), TT, INC, DM, DM, 1, 0, 0, 0, DM / 64, 0, 0};
            pg8::OneUnit S1{x / (46 - INP_MAIN_COLT), INP_MAIN_COLT + x % (46 - INP_MAIN_COLT)};
            EpiIn E{a.ws, 3 * L * TT};
            pg8::gemm_phase((PG8_LAS unsigned char*)lds, g, S1, E); }
        for (;;) { const int x = WQ_NEXT(ctr + 16); if (x >= 256) break;
            attn_unit(lds, (x & 31) >> 3, x & 7, 7 - (x >> 5), a); }
    }
}
__device__ __forceinline__ void pp_queue(const Args& a, unsigned char* lds, int L) {
    unsigned* ctr = (unsigned*)(a.ws + WS_CTL) + 64 * (L * 4 + 2) + 24;
    volatile unsigned* sh = (volatile unsigned*)(lds + LDS_MISC);
    for (;;) { const int x = WQ_NEXT(ctr); if (x >= 256) break;
        pg8::Gemm g{(const bf16_t*)(a.ws + WS_PB) + (size_t)L * TT * PLE, (const bf16_t*)(a.ws + WS_W0 + (size_t)L * WL_SIZE + WL_PP), TT, DM, PLE, PLE, 1, 0, 0, 0, PLE / 64, 0, 0};
        pg8::OneUnit S1{x >> 3, x & 7};
        EpiBf16 E{a.ws};
        pg8::gemm_phase((PG8_LAS unsigned char*)lds, g, S1, E); }
}

#define LAS __attribute__((address_space(3)))
#define XB_TMO      128
#define XB_XCNT(j)  (256  + 64 * (j))
#define XB_XSUB(j)  (1280 + 64 * (j))
#define XB_XGEN(j)  (2304 + 64 * (j))
#define XB_TOP      3328
#define XB_TOPGEN   3392
#define XCD_BAR_WORDS 3456
#define XB_SPIN_CAP (1u << 20)
__device__ __forceinline__ unsigned xb_ld(unsigned* p)              { return __hip_atomic_load(p, __ATOMIC_RELAXED, __HIP_MEMORY_SCOPE_AGENT); }
__device__ __forceinline__ unsigned xb_add(unsigned* p, unsigned v) { return __hip_atomic_fetch_add(p, v, __ATOMIC_RELAXED, __HIP_MEMORY_SCOPE_AGENT); }
__device__ __forceinline__ unsigned xb_xcc_id() { return (unsigned)__builtin_amdgcn_s_getreg((3 << 11) | 20) & 0xFu; }
#define XB_SPIN(cond, bar) do { unsigned _sp = 0; while (cond) { __builtin_amdgcn_s_sleep(1); \
    if ((++_sp & 255u) == 0u) { if (xb_ld(&(bar)[XB_TMO])) break; if (_sp > XB_SPIN_CAP) { atomicAdd(&(bar)[XB_TMO], 1u); break; } } } } while (0)
struct XcdBarrier { unsigned* bar; unsigned x; volatile LAS unsigned* st; };
__device__ __forceinline__ XcdBarrier xcd_barrier_post(unsigned* bar, volatile LAS unsigned* st) {
    XcdBarrier b; b.bar = bar; b.x = xb_xcc_id(); b.st = st;
    if (threadIdx.x == 0) (void)xb_add(&bar[XB_XCNT(b.x)], 1u);
    return b;
}
__device__ __forceinline__ void xcd_barrier_complete(unsigned* bar, unsigned x, unsigned& nloc, unsigned& nx) {
    const unsigned G = gridDim.x * gridDim.y * gridDim.z;
    unsigned sum, cnt, mine, sp = 0u;
    for (;;) {
        sum = 0u; cnt = 0u; mine = 0u;
#pragma nounroll
        for (unsigned j = 0; j < 16; ++j) { const unsigned c = xb_ld(&bar[XB_XCNT(j)]); sum += c; cnt += (c > 0u) ? 1u : 0u; mine = (j == x) ? c : mine; }
        if (sum == G) break;
        __builtin_amdgcn_s_sleep(1);
        if ((++sp & 255u) == 0u) { if (xb_ld(&bar[XB_TMO])) break; if (sp > XB_SPIN_CAP) { atomicAdd(&bar[XB_TMO], 1u); break; } }
    }
    nloc = mine > 0u ? mine : 1u; nx = cnt > 0u ? cnt : 1u;
}
__device__ __forceinline__ void xcd_barrier(const XcdBarrier& b) {
    asm volatile("s_waitcnt vmcnt(0)" ::: "memory");
    __syncthreads();
    if (threadIdx.x == 0) {
        unsigned* bar = b.bar; asm volatile("" : "+s"(bar));
        __builtin_amdgcn_s_waitcnt(0);
        unsigned nloc = b.st[0], nx = b.st[1];
        if (nloc == 0u) { xcd_barrier_complete(bar, b.x, nloc, nx); b.st[0] = nloc; b.st[1] = nx; }
        const unsigned old = xb_add(&bar[XB_XSUB(b.x)], 1u);
        const unsigned gen = old / nloc;
        if (old + 1u == (gen + 1u) * nloc) {
            __builtin_amdgcn_fence(__ATOMIC_RELEASE, "agent");
            asm volatile("s_waitcnt vmcnt(0)" ::: "memory");
            const unsigned og = xb_add(&bar[XB_TOP], 1u);
            const unsigned tg = og / nx;
            if (og + 1u == (tg + 1u) * nx) xb_add(&bar[XB_TOPGEN], 1u);
            else XB_SPIN(xb_ld(&bar[XB_TOPGEN]) == tg, bar);
            __builtin_amdgcn_fence(__ATOMIC_ACQUIRE, "agent");
            xb_add(&bar[XB_XGEN(b.x)], 1u);
            asm volatile("s_waitcnt vmcnt(0)" ::: "memory");
        } else {
            XB_SPIN(xb_ld(&bar[XB_XGEN(b.x)]) == gen, bar);
            __builtin_amdgcn_fence(__ATOMIC_ACQUIRE, "agent");
            asm volatile("s_waitcnt vmcnt(0)" ::: "memory");
        }
    }
    __syncthreads();
}

typedef const Args __attribute__((address_space(4)))* KArgP;
#define LOAD_ARGS KArgP ap = (KArgP)__builtin_amdgcn_kernarg_segment_ptr(); asm volatile("" : "+s"(ap)); Args A; \
    _Pragma("unroll") for (int i_ = 0; i_ < 19; ++i_) A.in[i_] = ap->in[i_]; A.out = ap->out; A.ws = ap->ws; A.ph_lo = 0; A.ph_hi = 0;
__global__ void __launch_bounds__(512, 2) mega(Args a) {
    extern __shared__ __attribute__((aligned(16))) unsigned char lds[];
    cg::grid_group grid = cg::this_grid();
    PG8_LAS unsigned char* lds3 = (PG8_LAS unsigned char*)lds;
    const int G = gridDim.x, bx = blockIdx.x;
    if (threadIdx.x == 0) { ((volatile LAS unsigned*)((LAS unsigned char*)lds + LDS_MISC))[8] = 0u; ((volatile LAS unsigned*)((LAS unsigned char*)lds + LDS_MISC))[9] = 0u; }
    __syncthreads();
    XcdBarrier xbar = xcd_barrier_post((unsigned*)(a.ws + WS_CTL) + 1024, (volatile LAS unsigned*)((LAS unsigned char*)lds + LDS_MISC) + 8);
    constexpr int ph_hi_ = NPHASE;
#pragma nounroll
    for (int ph = 0; ph < ph_hi_; ++ph) {
      const int nrep = 1 + ((ph == 0 ? (REP_MASK >> 15) : (ph == NPHASE - 1 ? 0 : (REP_MASK >> ((ph - 1) % PPL)))) & 1);
      for (int rep = 0; rep < nrep; ++rep) {
        if (ph == 0) { if (PHMASK & 0x8000) { LOAD_ARGS prologue_phase(A, lds); } }
        else if (ph == NPHASE - 1) { if (PHMASK & 0x4000) { LOAD_ARGS final_norm_rows((const bf16_t*)(A.ws + WS_H), (const float*)(A.ws + WS_X) + (size_t)(3 * NLAYER) * TT * 8, A.in[18], A.out); } }
        else {
            const int L = (ph - 1) / PPL, s = (ph - 1) % PPL;
            if (s == 0) { if (PHMASK & (1 << 0)) {
                LOAD_ARGS unsigned char* wl = A.ws + WS_W0 + (size_t)L * WL_SIZE;
                pg8::Gemm g{(const bf16_t*)(A.ws + WS_H), (const bf16_t*)(wl + WL_IN), TT, INC, DM, DM, 1, 0, 0, 0, DM / 64, 0, 0};
                pg8::StaticOrder S; S.init(TT, INP_MAIN_COLT * 256, G, bx, 1);
                EpiIn E{A.ws, 3 * L * TT};
                pg8::gemm_phase(lds3, g, S, E);
            }} else if (s == 1) { if (PHMASK & (1 << 1)) {
                LOAD_ARGS mixer_phase(A, lds, L, 0, rep);
            }} else if (s == 2) { if (PHMASK & (1 << 2)) {
                LOAD_ARGS mixer_phase(A, lds, L, 1, rep);
            }} else if (s == 3) { if (PHMASK & (1 << 3)) {
                LOAD_ARGS unsigned char* wl = A.ws + WS_W0 + (size_t)L * WL_SIZE;
                pg8::Gemm g{(const bf16_t*)(A.ws + WS_Y), (const bf16_t*)(wl + WL_BR), TT, DM, DM, DM, 3, 0, 512, 1536, 8, 16, 8};
                pg8::StaticOrder S; S.init(TT, DM, G, bx, 3);
                EpiBranch E{A.ws};
                pg8::gemm_phase(lds3, g, S, E);
            }} else if (s == 4) { if (PHMASK & (1 << 4)) {
                LOAD_ARGS unsigned char* wl = A.ws + WS_W0 + (size_t)L * WL_SIZE;
                pg8::Gemm g{(const bf16_t*)(A.ws + WS_MIX), (const bf16_t*)(wl + WL_OUT), TT, DM, DM, DM, 1, 0, 0, 0, DM / 64, 0, 0};
                pg8::StaticOrder S; S.init(TT, DM, G, bx, 1);
                EpiResid E{A.ws, 0, 0, (3 * L + 1) * TT};
                pg8::gemm_phase(lds3, g, S, E);
            }} else if (s == 5) { if (PHMASK & (1 << 5)) {
                LOAD_ARGS unsigned char* wl = A.ws + WS_W0 + (size_t)L * WL_SIZE;
                pg8::Gemm g{(const bf16_t*)(A.ws + WS_H), (const bf16_t*)(wl + WL_GU), TT, 2 * DFF, DM, DM, 1, 0, 0, 0, DM / 64, 0, 0};
                pg8::StaticOrder S; S.init(TT, 2 * DFF, G, bx, 1);
                EpiSwiglu E{A.ws, (3 * L + 1) * TT};
                pg8::gemm_phase(lds3, g, S, E);
                if (rep == 0) pp_queue(A, lds, L);
            }} else if (s == 6) { if (PHMASK & (1 << 6)) {
                LOAD_ARGS unsigned char* wl = A.ws + WS_W0 + (size_t)L * WL_SIZE;
                pg8::Gemm g{(const bf16_t*)(A.ws + WS_ACT), (const bf16_t*)(wl + WL_DN), TT, DM, DFF, DFF, 1, 0, 0, 0, DFF / 64, 0, 0};
                pg8::StaticOrder S; S.init(TT, DM, G, bx, 1);
                EpiResid E{A.ws, 0, (int)(WS_HB - WS_H), (3 * L + 2) * TT};
                pg8::gemm_phase(lds3, g, S, E);
            }} else { if (PHMASK & (1 << 7)) {
                LOAD_ARGS unsigned char* wl = A.ws + WS_W0 + (size_t)L * WL_SIZE;
                pg8::Gemm g{(const bf16_t*)(A.ws + WS_HB), (const bf16_t*)(wl + WL_PG), TT, DM, DM, DM, 1, 0, 0, 0, DM / 64, 0, 0};
                pg8::StaticOrder S; S.init(TT, DM, G, bx, 1);
                EpiPle E{A.ws, (3 * L + 2) * TT};
                pg8::gemm_phase(lds3, g, S, E);
            }}
        }
        if (ph + 1 < ph_hi_ || rep + 1 < nrep) { if (ph == 0) grid.sync(); else xcd_barrier(xbar); }
      }
    }
    for (int i = 0; i < EXTRA_SYNCS; ++i) xcd_barrier(xbar);
}

extern "C" void kernel_launch(void* const* d_in, const int* in_sizes, int n_in, void* d_out, int out_size, void* d_ws, size_t ws_size, hipStream_t stream) {
    static int grid = 0;
    if (grid == 0) {
        if (n_in != 19 || out_size != TT * DM || ws_size < WS_END) { fprintf(stderr, "kernel_launch: unexpected problem (n_in %d out %d ws %zu need %zu)\n", n_in, out_size, ws_size, (size_t)WS_END); grid = -1; return; }
        int dev = 0, cus = 0, per_cu = 0;
        hipGetDevice(&dev); hipDeviceGetAttribute(&cus, hipDeviceAttributeMultiprocessorCount, dev);
        if (hipFuncSetAttribute((const void*)mega, hipFuncAttributeMaxDynamicSharedMemorySize, LDS_BYTES) != hipSuccess) { fprintf(stderr, "kernel_launch: hipFuncSetAttribute failed\n"); grid = -1; return; }
        if (hipOccupancyMaxActiveBlocksPerMultiprocessor(&per_cu, (const void*)mega, 512, LDS_BYTES) != hipSuccess || per_cu < 1) { fprintf(stderr, "kernel_launch: occupancy query gave %d\n", per_cu); per_cu = 1; }
        (void)hipGetLastError();
        grid = cus * per_cu;
        fprintf(stderr, "kernel_launch: grid %d (cus %d x %d)\n", grid, cus, per_cu);
    }
    if (grid < 0) return;
    (void)hipMemsetAsync((char*)d_ws + WS_CTL, 0, CTL_ZERO, stream);
    Args a{};
    for (int i = 0; i < 19; ++i) a.in[i] = (const float*)d_in[i];
    a.out = (float*)d_out; a.ws = (unsigned char*)d_ws;
#if MK_MULTI
    for (int ph = 0; ph < NPHASE; ++ph) { a.ph_lo = ph; a.ph_hi = ph + 1; hipLaunchKernelGGL(mega, dim3(grid), dim3(512), LDS_BYTES, stream, a); }
#else
    a.ph_lo = 0; a.ph_hi = NPHASE;
    void* args[] = {&a};
    hipError_t e = hipLaunchCooperativeKernel((const void*)mega, dim3(grid), dim3(512), args, LDS_BYTES, stream);
    if (e != hipSuccess) fprintf(stderr, "kernel_launch: cooperative launch failed: %s (grid %d)\n", hipGetErrorString(e), grid);
#endif
}
```

```cpp
#include <hip/hip_runtime.h>
#include <hip/hip_cooperative_groups.h>
#include <cstdio>
#include <cstdint>
namespace cg = cooperative_groups;

#ifndef PHMASK
#define PHMASK 0xFFFF
#endif
#ifndef REP_MASK
#define REP_MASK 0
#endif
#ifndef EXTRA_SYNCS
#define EXTRA_SYNCS 0
#endif
#ifndef CHAIN_TWICE
#define CHAIN_TWICE 0
#endif
#ifndef MK_MULTI
#define MK_MULTI 0
#endif

typedef unsigned short bf16_t;
typedef short bf16x8 __attribute__((ext_vector_type(8)));
typedef short s16x4 __attribute__((ext_vector_type(4)));
typedef float f32x4 __attribute__((ext_vector_type(4)));
typedef float f32x16 __attribute__((ext_vector_type(16)));
typedef unsigned u32x4 __attribute__((ext_vector_type(4)));
typedef unsigned u32x2 __attribute__((ext_vector_type(2)));

constexpr int TT = 8192, DM = 2048, SEQ = 2048, INC = 11776, DFF = 5632, PLE = 256, NLAYER = 2;
constexpr float EPS = 1e-6f;

typedef float f32x2_t __attribute__((ext_vector_type(2))); typedef __bf16 bf16x2_t __attribute__((ext_vector_type(2)));
__device__ __forceinline__ unsigned cvt_pk_bf16(float lo, float hi) { const f32x2_t v = {lo, hi}; const bf16x2_t b = __builtin_convertvector(v, bf16x2_t); return __builtin_bit_cast(unsigned, b); }
__device__ __forceinline__ float bf2f(unsigned short b) { return __uint_as_float(((unsigned)b) << 16); }
__device__ __forceinline__ float bflo(unsigned w) { return __uint_as_float(w << 16); }
__device__ __forceinline__ float bfhi(unsigned w) { return __uint_as_float(w & 0xffff0000u); }
__device__ __forceinline__ float sigmoidf_(float x) { return __builtin_amdgcn_rcpf(1.0f + __builtin_amdgcn_exp2f(x * -1.4426950408889634f)); }
__device__ __forceinline__ bf16x8 pack8(float a0, float a1, float a2, float a3, float a4, float a5, float a6, float a7) {
    u32x4 w; w.x = cvt_pk_bf16(a0, a1); w.y = cvt_pk_bf16(a2, a3); w.z = cvt_pk_bf16(a4, a5); w.w = cvt_pk_bf16(a6, a7);
    return __builtin_bit_cast(bf16x8, w);
}
__device__ __forceinline__ int crow(int r, int hi) { return (r & 3) + 8 * (r >> 2) + 4 * hi; }
__device__ __forceinline__ int opaque_tid() { int t = threadIdx.x; asm volatile("" : "+v"(t)); return t; }
__device__ __forceinline__ float shflx(float v, int m, int lane) { return __int_as_float(__builtin_amdgcn_ds_bpermute((lane ^ m) << 2, __float_as_int(v))); }
#define MFMA32(a, b, c) __builtin_amdgcn_mfma_f32_32x32x16_bf16((a), (b), (c), 0, 0, 0)

namespace pg8 {
#define PG8_LAS __attribute__((address_space(3)))
constexpr int BM = 256, BK = 64, HALF = 128, HTB = HALF * BK * 2, STAGE_BYTES = 8 * HTB, NXCD = 8, WGM = 8;
__host__ __device__ __forceinline__ int lds_byte(int r, int c) { const int st = (r >> 4) * 2 + (c >> 5), rr = r & 15, cc = c & 31, ob = rr * 64 + cc * 2; return st * 1024 + (ob ^ (((ob >> 9) & 1) << 5)); }
__host__ __device__ __forceinline__ void stage_rc(int b, int& R, int& C) { const int st = b / 1024, sb = b % 1024, swz = sb ^ (((sb >> 9) & 1) << 5); R = (st >> 1) * 16 + swz / 64; C = (st & 1) * 32 + (swz % 64) / 2; }
__host__ __device__ __forceinline__ int perm32(int rho) { const int n = rho >> 4, i = rho & 15; return 8 * (i >> 2) + 4 * n + (i & 3); }

struct Unit { int pm, pn, kind; };
struct Gemm { const bf16_t* A; const bf16_t* Bt; int M, N, lda, ldb; int nseg; int kofs0, kofs1, kofs2; int nt0, nt1, nt2; };

struct StaticOrder {
    int nM, nN, nwg, G, c, nseg;
    __device__ void init(int M, int N, int G_, int c_, int nseg_) { nM = M / BM; nN = N / BM; nwg = nM * nN; G = G_; c = c_; nseg = nseg_; }
    __device__ bool next(int i, Unit& u) const {
        int j = i, kd = 0; if (nseg == 3) { j = i / 3; kd = i - 3 * j; }
        u.kind = kd;
        const long L = (long)j * G + c; if (L >= nwg) return false;
        int wgid = (int)L; { const int q = nwg / NXCD, r = nwg % NXCD, xcd = wgid % NXCD, off = wgid / NXCD; wgid = (xcd < r ? xcd * (q + 1) : r * (q + 1) + (xcd - r) * q) + off; }
        const int nig = WGM * nN, gid = wgid / nig, fm = gid * WGM, gsz = (nM - fm) < WGM ? (nM - fm) : WGM;
        u.pm = fm + ((wgid % nig) % gsz); u.pn = (wgid % nig) / gsz; return true;
    }
};

struct OneUnit { int pm, pn; __device__ bool next(int i, Unit& u) const { u.pm = pm; u.pn = pn; u.kind = 0; return i == 0; } };
template <class Epi, class Sched>
__device__ __forceinline__ void gemm_phase(PG8_LAS unsigned char* lds, const Gemm g, const Sched& S, const Epi& E) {
    const int tid = opaque_tid(), wid = __builtin_amdgcn_readfirstlane(tid >> 6), lane = tid & 63, wr = wid >> 2, wc = wid & 3, fr = lane & 15, fq = lane >> 4;
    unsigned voffA, voffB;
    { int R, C; stage_rc(tid * 16, R, C); const int Rb = (R & ~31) + perm32(R & 31);
      voffA = (unsigned)(R * g.lda + C) * 2u; voffB = (unsigned)(Rb * g.ldb + C) * 2u; }
    const size_t qstepoffA = (size_t)64 * g.lda * 2, qstepoffB = (size_t)64 * g.ldb * 2;
    const size_t kstep = (size_t)(BK * 2);
    const size_t hstepA = (size_t)HALF * g.lda * 2, hstepB = (size_t)HALF * g.ldb * 2;
    const size_t tstepA = 2 * hstepA, tstepB = 2 * hstepB;
    const unsigned ldsw = (unsigned)wid * 1024u;
    const int aoff = lds_byte(wr * 64 + fr, fq * 8), boff = lds_byte(wc * 32 + fr, fq * 8);
#define PG8_SA(b, h) (((b) * 2 + (h)) * HTB)
#define PG8_SB(b, h) ((4 + (b) * 2 + (h)) * HTB)
#define PG8_STAGE(bufoff, gbase, voff) do { _Pragma("unroll") for (int _i = 0; _i < 2; ++_i) \
        __builtin_amdgcn_global_load_lds((const unsigned*)((const char*)(gbase) + (size_t)_i * qstep##voff + v##voff), (PG8_LAS unsigned*)(lds + (bufoff) + ldsw + _i * 8192), 16, 0, 0); } while (0)
#define PG8_LDA(dst, b, h) do { _Pragma("unroll") for (int m = 0; m < 4; ++m) _Pragma("unroll") for (int k = 0; k < 2; ++k) dst[m][k] = *(const PG8_LAS bf16x8*)(lds + PG8_SA(b, h) + aoff + m * 2048 + k * 1024); } while (0)
#define PG8_LDB(dst, b, h) do { _Pragma("unroll") for (int n = 0; n < 2; ++n) _Pragma("unroll") for (int k = 0; k < 2; ++k) dst[n][k] = *(const PG8_LAS bf16x8*)(lds + PG8_SB(b, h) + boff + n * 2048 + k * 1024); } while (0)
#define PG8_MMA(ai, bj, At, Bt) do { __builtin_amdgcn_s_setprio(1); _Pragma("unroll") for (int m = 0; m < 4; ++m) _Pragma("unroll") for (int n = 0; n < 2; ++n) _Pragma("unroll") for (int k = 0; k < 2; ++k) \
        acc[ai][bj][m][n] = __builtin_amdgcn_mfma_f32_16x16x32_bf16(Bt[n][k], At[m][k], acc[ai][bj][m][n], 0, 0, 0); __builtin_amdgcn_s_setprio(0); } while (0)
#define PG8_WAIT_V(n) asm volatile("s_waitcnt vmcnt(" #n ")" ::: "memory")
#define PG8_WAIT_L(n) asm volatile("s_waitcnt lgkmcnt(" #n ")" ::: "memory")
#define PG8_BAR __builtin_amdgcn_s_barrier()
#define PG8_SCHED __builtin_amdgcn_sched_barrier(0)
#define PG8_KOFS(u) ((u).kind == 0 ? g.kofs0 : ((u).kind == 1 ? g.kofs1 : g.kofs2))
#define PG8_NT(u) ((u).kind == 0 ? g.nt0 : ((u).kind == 1 ? g.nt1 : g.nt2))
    Unit cur, nxt; int ui = 0;
    if (!S.next(0, cur)) return;
    f32x4 acc[2][2][4][2];
#pragma unroll
    for (int a = 0; a < 2; ++a)
#pragma unroll
        for (int b = 0; b < 2; ++b)
#pragma unroll
            for (int m = 0; m < 4; ++m)
#pragma unroll
                for (int n = 0; n < 2; ++n) acc[a][b][m][n] = (f32x4){0.f, 0.f, 0.f, 0.f};
    bf16x8 At[4][2], B0[2][2], B1[2][2];
    const char* cA = (const char*)g.A + (size_t)cur.pm * tstepA + (size_t)PG8_KOFS(cur) * 2; const char* cB = (const char*)g.Bt + (size_t)cur.pn * tstepB + (size_t)PG8_KOFS(cur) * 2;
    PG8_STAGE(PG8_SB(0, 0), cB, offB); PG8_STAGE(PG8_SB(0, 1), cB + hstepB, offB); PG8_STAGE(PG8_SA(0, 0), cA, offA); PG8_STAGE(PG8_SA(0, 1), cA + hstepA, offA);
    if (wr == 1) PG8_BAR;
    PG8_WAIT_V(2); PG8_BAR;
    PG8_STAGE(PG8_SB(1, 0), cB + kstep, offB); PG8_STAGE(PG8_SA(1, 0), cA + kstep, offA); PG8_STAGE(PG8_SB(1, 1), cB + hstepB + kstep, offB);
    PG8_WAIT_V(6); PG8_BAR;
    for (;;) {
        const bool has_next = S.next(ui + 1, nxt);
        const char* nA = has_next ? (const char*)g.A + (size_t)nxt.pm * tstepA + (size_t)PG8_KOFS(nxt) * 2 : cA;
        const char* nB = has_next ? (const char*)g.Bt + (size_t)nxt.pn * tstepB + (size_t)PG8_KOFS(nxt) * 2 : cB;
        const int nt = PG8_NT(cur);
        for (int t = 0; t < nt; t += 2) {
            const bool last = (t == nt - 2);
            const char* a1 = cA + (size_t)(t + 1) * kstep;
            const char* a2 = last ? nA : cA + (size_t)(t + 2) * kstep; const char* b2 = last ? nB : cB + (size_t)(t + 2) * kstep;
            const char* a3 = a2 + kstep; const char* b3 = b2 + kstep;
            PG8_LDB(B0, 0, 0); PG8_LDB(B1, 0, 1); PG8_SCHED; PG8_LDA(At, 0, 0); PG8_STAGE(PG8_SA(1, 1), a1 + hstepA, offA);
            PG8_WAIT_V(8); PG8_WAIT_L(0); PG8_BAR; PG8_MMA(0, 0, At, B0); PG8_MMA(0, 1, At, B1); PG8_BAR; PG8_SCHED;
            PG8_LDA(At, 0, 1); PG8_STAGE(PG8_SB(0, 0), b2, offB); PG8_STAGE(PG8_SB(0, 1), b2 + hstepB, offB); PG8_STAGE(PG8_SA(0, 0), a2, offA);
            PG8_WAIT_V(8); PG8_WAIT_L(0); PG8_BAR; PG8_MMA(1, 0, At, B0); PG8_MMA(1, 1, At, B1); PG8_BAR; PG8_SCHED;
            PG8_LDB(B0, 1, 0); PG8_LDB(B1, 1, 1); PG8_SCHED; PG8_LDA(At, 1, 0); PG8_STAGE(PG8_SA(0, 1), a2 + hstepA, offA);
            PG8_WAIT_V(8); PG8_WAIT_L(0); PG8_BAR; PG8_MMA(0, 0, At, B0); PG8_MMA(0, 1, At, B1); PG8_BAR; PG8_SCHED;
            PG8_LDA(At, 1, 1); PG8_STAGE(PG8_SB(1, 0), b3, offB); PG8_STAGE(PG8_SB(1, 1), b3 + hstepB, offB); PG8_STAGE(PG8_SA(1, 0), a3, offA);
            PG8_WAIT_V(8); PG8_WAIT_L(0); PG8_BAR; PG8_MMA(1, 0, At, B0); PG8_MMA(1, 1, At, B1); PG8_BAR; PG8_SCHED;
        }
        if (wr == 0) PG8_BAR;
        const bool keep = E(acc, cur, wr, wc, fr, fq);
        if (!has_next) break;
        if (!keep) {
#pragma unroll
        for (int a = 0; a < 2; ++a)
#pragma unroll
            for (int b = 0; b < 2; ++b)
#pragma unroll
                for (int m = 0; m < 4; ++m)
#pragma unroll
                    for (int n = 0; n < 2; ++n) acc[a][b][m][n] = (f32x4){0.f, 0.f, 0.f, 0.f};
        }
        cur = nxt; cA = nA; cB = nB; ++ui;
        if (wr == 1) PG8_BAR;
    }
    PG8_WAIT_V(0);
    PG8_BAR;
#undef PG8_SA
#undef PG8_SB
#undef PG8_STAGE
#undef PG8_LDA
#undef PG8_LDB
#undef PG8_MMA
#undef PG8_WAIT_V
#undef PG8_WAIT_L
#undef PG8_BAR
#undef PG8_SCHED
#undef PG8_KOFS
#undef PG8_NT
}
}

constexpr size_t MiB = 1u << 20;
constexpr size_t WS_CTL = 0;
constexpr size_t WS_W0 = 1 * MiB;
constexpr size_t WL_IN = 0, WL_BR = 46 * MiB, WL_OUT = 54 * MiB, WL_GU = 62 * MiB, WL_DN = 106 * MiB, WL_PG = 128 * MiB, WL_PP = 136 * MiB, WL_SIZE = 137 * MiB;
constexpr size_t WS_H = WS_W0 + 2 * WL_SIZE;
constexpr size_t WS_X = WS_H + 32 * MiB;
constexpr size_t WS_U = WS_X + 64 * MiB;
constexpr size_t WS_SQ = WS_U + 16 * MiB;
constexpr size_t WS_SK = WS_SQ + 16 * MiB;
constexpr size_t WS_VT = WS_SK + 16 * MiB;
constexpr size_t WS_ZF = WS_VT + 16 * MiB;
constexpr size_t WS_HV = WS_ZF + 16 * MiB;
constexpr size_t WS_HQ = WS_HV + 8 * MiB;
constexpr size_t WS_OG = WS_HQ + 16 * MiB;
constexpr size_t WS_GT = WS_OG + 8 * MiB;
constexpr size_t WS_ACT = WS_GT;
constexpr size_t WS_Y = WS_GT + 96 * MiB;
constexpr size_t WS_MIX = WS_Y + 32 * MiB;
constexpr size_t WS_PB = WS_MIX + 32 * MiB;
constexpr size_t WS_HVT = WS_PB + 8 * MiB;
constexpr size_t WS_HDEC = WS_HVT + 8 * MiB;
constexpr size_t WS_HB = WS_HDEC + 1 * MiB;
constexpr size_t WS_PPB = WS_HB + 32 * MiB;
constexpr size_t WS_PWT = WS_PPB + 32 * MiB;
constexpr size_t WS_END = WS_PWT + 1 * MiB;
constexpr size_t WS_HOI = WS_MIX;
constexpr size_t WS_HQD = WS_MIX + 16 * MiB;
constexpr size_t WS_HKD = WS_MIX + 24 * MiB;
constexpr size_t CTL_SS = 65536;
constexpr size_t CTL_ZERO = CTL_SS + 7 * TT * 4;

constexpr int LDS_PSUM_OFF = 132096;
typedef f32x4 AccT[2][2][4][2];
#define EPI_LOOP_BEGIN  const int row0_ = u.pm * 256 + wr * 64 + fr; \
    _Pragma("unroll") for (int ai = 0; ai < 2; ++ai) _Pragma("unroll") for (int m = 0; m < 4; ++m) { const int row = row0_ + ai * 128 + m * 16; \
    _Pragma("unroll") for (int bj = 0; bj < 2; ++bj) { const int col = u.pn * 256 + bj * 128 + wc * 32 + 8 * fq; f32x4 v0 = acc[ai][bj][m][0], v1 = acc[ai][bj][m][1];
#define EPI_LOOP_END }}
__device__ __forceinline__ float rstd_of(float ss) { return __builtin_amdgcn_rsqf(ss * (1.0f / DM) + EPS); }
__device__ __forceinline__ float rstd_row(const float* SSP, int row) { const f32x4 a = *(const f32x4*)(SSP + (size_t)row * 8), b = *(const f32x4*)(SSP + (size_t)row * 8 + 4);
    return rstd_of(((a[0] + a[1]) + (a[2] + a[3])) + ((b[0] + b[1]) + (b[2] + b[3]))); }
__device__ __forceinline__ void ps_write(int rit, int wc, float sq) {
    extern __shared__ __attribute__((aligned(16))) unsigned char lds_e_[];
    ((float*)(lds_e_ + LDS_PSUM_OFF))[rit * 4 + wc] = sq;
}
__device__ __forceinline__ void ps_finish(float* SSP, const pg8::Unit& u, int wr, int wc, int fr, int fq) {
    extern __shared__ __attribute__((aligned(16))) unsigned char lds_e_[];
    const float* PS = (const float*)(lds_e_ + LDS_PSUM_OFF);
    asm volatile("s_waitcnt lgkmcnt(0)" ::: "memory"); __builtin_amdgcn_s_barrier(); asm volatile("" ::: "memory");
    const int t_ = (wr * 4 + wc) * 64 + fq * 16 + fr;
    if (t_ < 256) { const f32x4 p = *(const f32x4*)(PS + t_ * 4); SSP[(size_t)(u.pm * 256 + t_) * 8 + u.pn] = (p[0] + p[1]) + (p[2] + p[3]); }
}
__device__ __forceinline__ void load_rstd4(const float* SSP, int row0, float (&rs)[4]) {
    f32x4 pa[4], pb[4];
#pragma unroll
    for (int m = 0; m < 4; ++m) { const float* p = SSP + (size_t)(row0 + m * 16) * 8; pa[m] = *(const f32x4*)p; pb[m] = *(const f32x4*)(p + 4); }
#pragma unroll
    for (int m = 0; m < 4; ++m) rs[m] = rstd_of(((pa[m][0] + pa[m][1]) + (pa[m][2] + pa[m][3])) + ((pb[m][0] + pb[m][1]) + (pb[m][2] + pb[m][3])));
    __builtin_amdgcn_sched_barrier(0);
}
#define EPI_LOOP_END_R }}}
#define EPI_LOOP_BEGIN_R(SSP)  const int row0_ = u.pm * 256 + wr * 64 + fr; \
    _Pragma("unroll") for (int ai = 0; ai < 2; ++ai) { float rs4_[4]; load_rstd4((SSP), row0_ + ai * 128, rs4_); \
    _Pragma("unroll") for (int m = 0; m < 4; ++m) { const int row = row0_ + ai * 128 + m * 16; const float rs_ = rs4_[m]; \
    _Pragma("unroll") for (int bj = 0; bj < 2; ++bj) { const int col = u.pn * 256 + bj * 128 + wc * 32 + 8 * fq; f32x4 v0 = acc[ai][bj][m][0] * rs_, v1 = acc[ai][bj][m][1] * rs_;

__device__ __forceinline__ u32x4 pack8v(f32x4 v0, f32x4 v1) { u32x4 w; w.x = cvt_pk_bf16(v0[0], v0[1]); w.y = cvt_pk_bf16(v0[2], v0[3]); w.z = cvt_pk_bf16(v1[0], v1[1]); w.w = cvt_pk_bf16(v1[2], v1[3]); return w; }

struct EpiIn {
    unsigned char* ws; int ssofs;
    __device__ __forceinline__ bool operator()(AccT& acc, const pg8::Unit& u, int wr, int wc, int fr, int fq) const {
        float* U = (float*)(ws + WS_U); bf16_t* SQ = (bf16_t*)(ws + WS_SQ); bf16_t* SK = (bf16_t*)(ws + WS_SK); bf16_t* VT = (bf16_t*)(ws + WS_VT); float* ZF = (float*)(ws + WS_ZF);
        bf16_t* HV = (bf16_t*)(ws + WS_HV); float* HQ = (float*)(ws + WS_HQ); bf16_t* OG = (bf16_t*)(ws + WS_OG); bf16_t* GT = (bf16_t*)(ws + WS_GT);
        const float* SS = (const float*)(ws + WS_X) + (size_t)ssofs * 8; const float qscale = 0.08838834764831845f * 1.4426950408889634f;
        const int colt = u.pn * 256;
        if (colt < 512) {
            EPI_LOOP_BEGIN_R(SS) float* p = U + (size_t)row * 512 + col; *(f32x4*)p = v0; *(f32x4*)(p + 4) = v1; EPI_LOOP_END_R
        } else if (colt < 1536) {
            const float s = qscale;
            EPI_LOOP_BEGIN_R(SS) *(u32x4*)(SQ + (size_t)row * 1024 + (col - 512)) = pack8v(v0 * s, v1 * s); EPI_LOOP_END_R
        } else if (colt < 2560) {
            EPI_LOOP_BEGIN_R(SS) *(u32x4*)(SK + (size_t)row * 1024 + (col - 1536)) = pack8v(v0, v1); EPI_LOOP_END_R
        } else if (colt < 3584) {
            EPI_LOOP_BEGIN_R(SS) const int cc = col - 2560, hh = cc >> 7, d = cc & 127, b = row >> 11, s = row & 2047;
                bf16_t* p = VT + (((size_t)(b * 8 + hh) * 128 + d) << 11) + s; const u32x4 w = pack8v(v0, v1);
                p[0] = (bf16_t)(w.x & 0xffff); p[2048] = (bf16_t)(w.x >> 16); p[2 * 2048] = (bf16_t)(w.y & 0xffff); p[3 * 2048] = (bf16_t)(w.y >> 16);
                p[4 * 2048] = (bf16_t)(w.z & 0xffff); p[5 * 2048] = (bf16_t)(w.z >> 16); p[6 * 2048] = (bf16_t)(w.w & 0xffff); p[7 * 2048] = (bf16_t)(w.w >> 16); EPI_LOOP_END_R
        } else if (colt < 4096) {
            EPI_LOOP_BEGIN_R(SS) float* p = ZF + (size_t)row * 512 + (col - 3584); *(f32x4*)p = v0; *(f32x4*)(p + 4) = v1; EPI_LOOP_END_R
        } else if (colt < 4608) {
            EPI_LOOP_BEGIN_R(SS) *(u32x4*)(HV + (size_t)row * 512 + (col - 4096)) = pack8v(v0, v1); EPI_LOOP_END_R
        } else if (colt < 5120) {
            EPI_LOOP_BEGIN_R(SS)
#pragma unroll
                for (int j = 0; j < 4; ++j) { v0[j] = v0[j] * sigmoidf_(v0[j]); v1[j] = v1[j] * sigmoidf_(v1[j]); }
                float* p = HQ + (size_t)row * 512 + (col - 4608); *(f32x4*)p = v0; *(f32x4*)(p + 4) = v1; EPI_LOOP_END_R
        } else if (colt < 5632) {
            EPI_LOOP_BEGIN_R(SS)
#pragma unroll
                for (int j = 0; j < 4; ++j) { v0[j] = v0[j] * sigmoidf_(v0[j]); v1[j] = v1[j] * sigmoidf_(v1[j]); }
                *(u32x4*)(OG + (size_t)row * 512 + (col - 5120)) = pack8v(v0, v1); EPI_LOOP_END_R
        } else {
            EPI_LOOP_BEGIN_R(SS)
#pragma unroll
                for (int j = 0; j < 4; ++j) { v0[j] = sigmoidf_(v0[j]); v1[j] = sigmoidf_(v1[j]); }
                *(u32x4*)(GT + (size_t)row * 6144 + (col - 5632)) = pack8v(v0, v1); EPI_LOOP_END_R
        }
        return false;
    }
};
struct EpiBranch {
    unsigned char* ws;
    __device__ __forceinline__ bool operator()(AccT& acc, const pg8::Unit& u, int wr, int wc, int fr, int fq) const {
        const bf16_t* GT = (const bf16_t*)(ws + WS_GT); bf16_t* MIX = (bf16_t*)(ws + WS_MIX);
        const int kind = u.kind;
        const int row0_ = u.pm * 256 + wr * 64 + fr;
#pragma unroll
        for (int ai = 0; ai < 2; ++ai) {
            u32x4 ga[4][2], gb[4][2];
#pragma unroll
            for (int m = 0; m < 4; ++m)
#pragma unroll
                for (int bj = 0; bj < 2; ++bj) { const size_t go = (size_t)(row0_ + ai * 128 + m * 16) * 6144 + u.pn * 256 + bj * 128 + wc * 32 + 8 * fq;
                    ga[m][bj] = *(const u32x4*)(GT + go + kind * 2048); gb[m][bj] = *(const u32x4*)(GT + go + (kind < 2 ? kind + 1 : 2) * 2048); }
            __builtin_amdgcn_sched_barrier(0);
#pragma unroll
            for (int m = 0; m < 4; ++m) { const int row = row0_ + ai * 128 + m * 16;
#pragma unroll
                for (int bj = 0; bj < 2; ++bj) { const int col = u.pn * 256 + bj * 128 + wc * 32 + 8 * fq;
                    const u32x4 gaw = ga[m][bj], gbw = gb[m][bj];
                    float a[8] = {bflo(gaw.x), bfhi(gaw.x), bflo(gaw.y), bfhi(gaw.y), bflo(gaw.z), bfhi(gaw.z), bflo(gaw.w), bfhi(gaw.w)};
#pragma unroll
                    for (int j = 0; j < 8; ++j) a[j] = fmaxf(a[j], 1e-30f);
                    if (kind < 2) {
                        float b[8] = {bflo(gbw.x), bfhi(gbw.x), bflo(gbw.y), bfhi(gbw.y), bflo(gbw.z), bfhi(gbw.z), bflo(gbw.w), bfhi(gbw.w)};
#pragma unroll
                        for (int j = 0; j < 8; ++j) { const float rr = a[j] * __builtin_amdgcn_rcpf(fmaxf(b[j], 1e-30f)); if (j < 4) acc[ai][bj][m][0][j] *= rr; else acc[ai][bj][m][1][j - 4] *= rr; }
                    } else {
                        f32x4 v0 = acc[ai][bj][m][0], v1 = acc[ai][bj][m][1];
#pragma unroll
                        for (int j = 0; j < 4; ++j) { v0[j] *= a[j]; v1[j] *= a[j + 4]; }
                        *(u32x4*)(MIX + (size_t)row * 2048 + col) = pack8v(v0, v1);
                    }
                } }
            __builtin_amdgcn_sched_barrier(0);
        }
        return kind < 2;
    }
};
struct EpiResid {
    unsigned char* ws; int rboff, xboff, ssofs;
    __device__ __forceinline__ bool operator()(AccT& acc, const pg8::Unit& u, int wr, int wc, int fr, int fq) const {
        const bf16_t* RB = (const bf16_t*)(ws + WS_H + (size_t)rboff); bf16_t* XB = (bf16_t*)(ws + WS_H + (size_t)xboff); float* SSO = (float*)(ws + WS_X) + (size_t)ssofs * 8;
        const int row0_ = u.pm * 256 + wr * 64 + fr;
#pragma unroll
        for (int ai = 0; ai < 2; ++ai) {
            u32x4 rwv[4][2];
#pragma unroll
            for (int m = 0; m < 4; ++m)
#pragma unroll
                for (int bj = 0; bj < 2; ++bj) rwv[m][bj] = *(const u32x4*)(RB + (size_t)(row0_ + ai * 128 + m * 16) * 2048 + u.pn * 256 + bj * 128 + wc * 32 + 8 * fq);
            __builtin_amdgcn_sched_barrier(0);
#pragma unroll
            for (int m = 0; m < 4; ++m) { const int row = row0_ + ai * 128 + m * 16; float sq = 0.f;
#pragma unroll
                for (int bj = 0; bj < 2; ++bj) { const int col = u.pn * 256 + bj * 128 + wc * 32 + 8 * fq; const size_t o = (size_t)row * 2048 + col;
                    const u32x4 rw = rwv[m][bj]; f32x4 v0 = acc[ai][bj][m][0], v1 = acc[ai][bj][m][1];
                    v0[0] += bflo(rw.x); v0[1] += bfhi(rw.x); v0[2] += bflo(rw.y); v0[3] += bfhi(rw.y); v1[0] += bflo(rw.z); v1[1] += bfhi(rw.z); v1[2] += bflo(rw.w); v1[3] += bfhi(rw.w);
                    *(u32x4*)(XB + o) = pack8v(v0, v1);
                    sq += (v0[0] * v0[0] + v0[1] * v0[1]) + (v0[2] * v0[2] + v0[3] * v0[3]) + (v1[0] * v1[0] + v1[1] * v1[1]) + (v1[2] * v1[2] + v1[3] * v1[3]); }
                sq += shflx(sq, 16, fr + 16 * fq); sq += shflx(sq, 32, fr + 16 * fq); if (fq == 0) ps_write(ai * 128 + wr * 64 + m * 16 + fr, wc, sq); }
            __builtin_amdgcn_sched_barrier(0);
        }
        ps_finish(SSO, u, wr, wc, fr, fq);
        return false;
    }
};
struct EpiSwiglu {
    unsigned char* ws; int ssofs;
    __device__ __forceinline__ bool operator()(AccT& acc, const pg8::Unit& u, int wr, int wc, int fr, int fq) const {
        bf16_t* ACT = (bf16_t*)(ws + WS_ACT); const float* SS = (const float*)(ws + WS_X) + (size_t)ssofs * 8;
        const int row0_ = u.pm * 256 + wr * 64 + fr;
#pragma unroll
        for (int ai = 0; ai < 2; ++ai) { float rs4_[4]; load_rstd4(SS, row0_ + ai * 128, rs4_);
#pragma unroll
            for (int m = 0; m < 4; ++m) { const int row = row0_ + ai * 128 + m * 16; const int col = u.pn * 128 + wc * 32 + 8 * fq; const float rs_ = rs4_[m];
                f32x4 g0 = acc[ai][0][m][0] * rs_, g1 = acc[ai][0][m][1] * rs_; const f32x4 u0 = acc[ai][1][m][0] * rs_, u1 = acc[ai][1][m][1] * rs_;
#pragma unroll
                for (int j = 0; j < 4; ++j) { g0[j] = g0[j] * sigmoidf_(g0[j]) * u0[j]; g1[j] = g1[j] * sigmoidf_(g1[j]) * u1[j]; }
                *(u32x4*)(ACT + (size_t)row * DFF + col) = pack8v(g0, g1); } }
        return false;
    }
};
struct EpiBf16 {
    unsigned char* ws;
    __device__ __forceinline__ bool operator()(AccT& acc, const pg8::Unit& u, int wr, int wc, int fr, int fq) const {
        bf16_t* OUT = (bf16_t*)(ws + WS_PPB);
        EPI_LOOP_BEGIN *(u32x4*)(OUT + (size_t)row * 2048 + col) = pack8v(v0, v1); EPI_LOOP_END
        return false;
    }
};
struct EpiPle {
    unsigned char* ws; int ssofs;
    __device__ __forceinline__ bool operator()(AccT& acc, const pg8::Unit& u, int wr, int wc, int fr, int fq) const {
        const bf16_t* RB = (const bf16_t*)(ws + WS_HB); const bf16_t* PP = (const bf16_t*)(ws + WS_PPB); bf16_t* XB = (bf16_t*)(ws + WS_H);
        const float* SS = (const float*)(ws + WS_X) + (size_t)ssofs * 8; float* SSO = (float*)(ws + WS_X) + (size_t)(ssofs + TT) * 8;
        const int row0_ = u.pm * 256 + wr * 64 + fr;
#pragma unroll
        for (int ai = 0; ai < 2; ++ai) { float rs4_[4]; load_rstd4(SS, row0_ + ai * 128, rs4_);
#pragma unroll
          for (int mh = 0; mh < 2; ++mh) {
            u32x4 rwv[2][2], pwv[2][2];
#pragma unroll
            for (int mm = 0; mm < 2; ++mm)
#pragma unroll
                for (int bj = 0; bj < 2; ++bj) { const size_t o = (size_t)(row0_ + ai * 128 + (2 * mh + mm) * 16) * 2048 + u.pn * 256 + bj * 128 + wc * 32 + 8 * fq;
                    rwv[mm][bj] = *(const u32x4*)(RB + o); pwv[mm][bj] = *(const u32x4*)(PP + o); }
            __builtin_amdgcn_sched_barrier(0);
#pragma unroll
            for (int mm = 0; mm < 2; ++mm) { const int m = 2 * mh + mm; const int row = row0_ + ai * 128 + m * 16; const float rs_ = rs4_[m]; float sq = 0.f;
#pragma unroll
                for (int bj = 0; bj < 2; ++bj) { const int col = u.pn * 256 + bj * 128 + wc * 32 + 8 * fq; const size_t o = (size_t)row * 2048 + col;
                    const u32x4 rw = rwv[mm][bj], pw = pwv[mm][bj];
                    f32x4 v0 = acc[ai][bj][m][0] * rs_, v1 = acc[ai][bj][m][1] * rs_;
                    v0[0] = bflo(rw.x) + sigmoidf_(v0[0]) * bflo(pw.x); v0[1] = bfhi(rw.x) + sigmoidf_(v0[1]) * bfhi(pw.x); v0[2] = bflo(rw.y) + sigmoidf_(v0[2]) * bflo(pw.y); v0[3] = bfhi(rw.y) + sigmoidf_(v0[3]) * bfhi(pw.y);
                    v1[0] = bflo(rw.z) + sigmoidf_(v1[0]) * bflo(pw.z); v1[1] = bfhi(rw.z) + sigmoidf_(v1[1]) * bfhi(pw.z); v1[2] = bflo(rw.w) + sigmoidf_(v1[2]) * bflo(pw.w); v1[3] = bfhi(rw.w) + sigmoidf_(v1[3]) * bfhi(pw.w);
                    *(u32x4*)(XB + o) = pack8v(v0, v1);
                    sq += (v0[0] * v0[0] + v0[1] * v0[1]) + (v0[2] * v0[2] + v0[3] * v0[3]) + (v1[0] * v1[0] + v1[1] * v1[1]) + (v1[2] * v1[2] + v1[3] * v1[3]); }
                sq += shflx(sq, 16, fr + 16 * fq); sq += shflx(sq, 32, fr + 16 * fq); if (fq == 0) ps_write(ai * 128 + wr * 64 + m * 16 + fr, wc, sq); }
            __builtin_amdgcn_sched_barrier(0);
          } }
        ps_finish(SSO, u, wr, wc, fr, fq);
        return false;
    }
};

constexpr int LDS_MISC = 131072, LDS_PSUM = 132096, LDS_BYTES = 132096 + 4096;
constexpr int PPL = 8;
constexpr int NPHASE = 2 + PPL * NLAYER;

struct Args { const float* in[19]; float* out; unsigned char* ws; int ph_lo, ph_hi; };

__device__ __forceinline__ float wave_sum(float v, int lane) {
#pragma unroll
    for (int o = 1; o < 64; o <<= 1) v += shflx(v, o, lane);
    return v;
}
template <bool F32OUT>
__device__ __forceinline__ void rmsnorm_rows(const float* X, const float* G, bf16_t* OB, float* OF) {
    const int tid_ = opaque_tid(); const int lane = tid_ & 63, gw = blockIdx.x * 8 + (tid_ >> 6), ngw = gridDim.x * 8;
    for (int row = gw; row < TT; row += ngw) {
        const f32x4* xr = (const f32x4*)(X + (size_t)row * DM) + lane;
        f32x4 v[8]; float s = 0.f;
#pragma unroll
        for (int j = 0; j < 8; ++j) { v[j] = xr[64 * j]; s += (v[j][0] * v[j][0] + v[j][1] * v[j][1]) + (v[j][2] * v[j][2] + v[j][3] * v[j][3]); }
        const float rstd = 1.0f / sqrtf(wave_sum(s, lane) * (1.0f / DM) + EPS);
#pragma unroll
        for (int j = 0; j < 8; ++j) { const f32x4 gg = ((const f32x4*)G)[lane + 64 * j]; const f32x4 y = v[j] * rstd * gg;
            if (F32OUT) ((f32x4*)(OF + (size_t)row * DM))[lane + 64 * j] = y;
            else { u32x2 w; w.x = cvt_pk_bf16(y[0], y[1]); w.y = cvt_pk_bf16(y[2], y[3]); ((u32x2*)(OB + (size_t)row * DM))[lane + 64 * j] = w; } }
    }
}

__device__ __forceinline__ void final_norm_rows(const bf16_t* XB, const float* SS, const float* G, float* OF) {
    const int tid_ = opaque_tid(); const int lane = tid_ & 63, gw = blockIdx.x * 8 + (tid_ >> 6), ngw = gridDim.x * 8;
    for (int row = gw; row < TT; row += ngw) {
        const float rstd = rstd_row(SS, row);
#pragma unroll
        for (int j = 0; j < 4; ++j) { const u32x4 w = ((const u32x4*)(XB + (size_t)row * DM))[lane + 64 * j];
            const f32x4 ga = ((const f32x4*)G)[2 * (lane + 64 * j)], gb = ((const f32x4*)G)[2 * (lane + 64 * j) + 1];
            f32x4 y0, y1; y0[0] = bflo(w.x) * rstd * ga[0]; y0[1] = bfhi(w.x) * rstd * ga[1]; y0[2] = bflo(w.y) * rstd * ga[2]; y0[3] = bfhi(w.y) * rstd * ga[3];
            y1[0] = bflo(w.z) * rstd * gb[0]; y1[1] = bfhi(w.z) * rstd * gb[1]; y1[2] = bflo(w.w) * rstd * gb[2]; y1[3] = bfhi(w.w) * rstd * gb[3];
            ((f32x4*)(OF + (size_t)row * DM))[2 * (lane + 64 * j)] = y0; ((f32x4*)(OF + (size_t)row * DM))[2 * (lane + 64 * j) + 1] = y1; }
    }
}
__device__ __forceinline__ void rows_bf16_ss(const float* X, bf16_t* OB, float* SSO) {
    const int tid_ = opaque_tid(); const int lane = tid_ & 63, gw = blockIdx.x * 8 + (tid_ >> 6), ngw = gridDim.x * 8;
    for (int row = gw; row < TT; row += ngw) {
        const f32x4* xr = (const f32x4*)(X + (size_t)row * DM) + lane; float s = 0.f;
#pragma unroll
        for (int j = 0; j < 8; ++j) { const f32x4 v = xr[64 * j]; s += (v[0] * v[0] + v[1] * v[1]) + (v[2] * v[2] + v[3] * v[3]);
            u32x2 w; w.x = cvt_pk_bf16(v[0], v[1]); w.y = cvt_pk_bf16(v[2], v[3]); ((u32x2*)(OB + (size_t)row * DM))[lane + 64 * j] = w; }
        s = wave_sum(s, lane); if (lane == 0) { float z = 0.f; asm volatile("" : "+v"(z)); *(f32x4*)(SSO + (size_t)row * 8) = (f32x4){s, z, z, z}; *(f32x4*)(SSO + (size_t)row * 8 + 4) = (f32x4){z, z, z, z}; }
    }
}
struct TJob { const float* src; const float* gain; bf16_t* dst; int N, ldd, k0, n0, drow0, dk0; };
__device__ __forceinline__ TJob tjob_decode(const Args& a, int it) {
    constexpr int C_IN = 16 * 92, C_BP = 4 * 16, C_BS = 8 * 16, C_BH = 4 * 16, C_OUT = 256, C_GU = 16 * 88, C_DN = 44 * 16, C_PG = 256, C_PP = 2 * 16;
    constexpr int PER_L = C_IN + C_BP + C_BS + C_BH + C_OUT + C_GU + C_DN + C_PG + C_PP;
    const int L = it / PER_L; int r = it - L * PER_L;
    unsigned char* wl = a.ws + WS_W0 + (size_t)L * WL_SIZE;
    TJob J; J.gain = nullptr; J.dk0 = 0; int nkb, gu = 0;
    if (r < C_IN) { J.src = a.in[3] + (size_t)L * DM * INC; J.N = INC; J.dst = (bf16_t*)(wl + WL_IN); J.ldd = DM; nkb = 16; J.gain = a.in[2] + (size_t)L * DM; }
    else if ((r -= C_IN) < C_BP) { J.src = a.in[8] + (size_t)L * 512 * DM; J.N = DM; J.dst = (bf16_t*)(wl + WL_BR); J.ldd = DM; nkb = 4; }
    else if ((r -= C_BP) < C_BS) { J.src = a.in[9] + (size_t)L * 1024 * DM; J.N = DM; J.dst = (bf16_t*)(wl + WL_BR); J.ldd = DM; J.dk0 = 512; nkb = 8; }
    else if ((r -= C_BS) < C_BH) { J.src = a.in[10] + (size_t)L * 512 * DM; J.N = DM; J.dst = (bf16_t*)(wl + WL_BR); J.ldd = DM; J.dk0 = 1536; nkb = 4; }
    else if ((r -= C_BH) < C_OUT) { J.src = a.in[11] + (size_t)L * DM * DM; J.N = DM; J.dst = (bf16_t*)(wl + WL_OUT); J.ldd = DM; nkb = 16; }
    else if ((r -= C_OUT) < C_GU) { J.src = a.in[13] + (size_t)L * DM * 2 * DFF; J.N = 2 * DFF; J.dst = (bf16_t*)(wl + WL_GU); J.ldd = DM; nkb = 16; gu = 1; J.gain = a.in[12] + (size_t)L * DM; }
    else if ((r -= C_GU) < C_DN) { J.src = a.in[14] + (size_t)L * DFF * DM; J.N = DM; J.dst = (bf16_t*)(wl + WL_DN); J.ldd = DFF; nkb = 44; }
    else if ((r -= C_DN) < C_PG) { J.src = a.in[16] + (size_t)L * DM * DM; J.N = DM; J.dst = (bf16_t*)(wl + WL_PG); J.ldd = DM; nkb = 16; J.gain = a.in[15] + (size_t)L * DM; }
    else { r -= C_PG; J.src = a.in[17] + (size_t)L * PLE * DM; J.N = DM; J.dst = (bf16_t*)(wl + WL_PP); J.ldd = PLE; nkb = 2; }
    const int nb = r / nkb, kb = r - nb * nkb;
    J.drow0 = nb * 128; if (gu) J.drow0 = nb < 44 ? 256 * nb : 256 * (nb - 44) + 128;
    J.k0 = kb * 128; J.n0 = nb * 128;
    return J;
}
__device__ __forceinline__ void tjob_load(const TJob& J, int tid, f32x4 (&v)[8]) {
#pragma unroll
    for (int p = 0; p < 8; ++p) { const int k = p * 16 + (tid >> 5), c = (tid & 31) * 4;
        v[p] = __builtin_nontemporal_load((const f32x4*)(J.src + (size_t)(J.k0 + k) * J.N + J.n0 + c)); if (J.gain) v[p] = v[p] * J.gain[J.k0 + k]; }
}
__device__ __forceinline__ void tjob_finish(const TJob& J, int tid, const f32x4 (&v)[8], float* sm) {
#pragma unroll
    for (int p = 0; p < 8; ++p) { const int k = p * 16 + (tid >> 5), c = (tid & 31) * 4; float* s = sm + k * 129 + c; s[0] = v[p][0]; s[1] = v[p][1]; s[2] = v[p][2]; s[3] = v[p][3]; }
    __syncthreads();
#pragma unroll
    for (int i = 0; i < 4; ++i) { const int item = tid + 512 * i, c = item & 15, n = item >> 4; const float* s = sm + (8 * c) * 129 + n;
        u32x4 w; w.x = cvt_pk_bf16(s[0], s[129]); w.y = cvt_pk_bf16(s[2 * 129], s[3 * 129]); w.z = cvt_pk_bf16(s[4 * 129], s[5 * 129]); w.w = cvt_pk_bf16(s[6 * 129], s[7 * 129]);
        *(u32x4*)(J.dst + (size_t)(J.drow0 + n) * J.ldd + J.dk0 + J.k0 + 8 * c) = w; }
    __syncthreads();
}

__device__ __forceinline__ void prologue_phase(const Args& a, unsigned char* lds) {
    float* sm = (float*)lds;
    constexpr int N_ITEMS = NLAYER * (16 * 92 + 4 * 16 + 8 * 16 + 4 * 16 + 256 + 16 * 88 + 44 * 16 + 256 + 2 * 16);
    {   const int tid = opaque_tid();
        int it = blockIdx.x;
        if (it < N_ITEMS) {
            TJob J = tjob_decode(a, it); f32x4 v[8]; tjob_load(J, tid, v);
            for (;;) {
                const int itn = it + gridDim.x; const bool more = itn < N_ITEMS;
                TJob Jn = J; f32x4 vn[8];
#pragma unroll
                for (int p = 0; p < 8; ++p) vn[p] = v[p];
                if (more) { Jn = tjob_decode(a, itn); tjob_load(Jn, tid, vn); }
                tjob_finish(J, tid, v, sm);
                if (!more) break;
                J = Jn; it = itn;
#pragma unroll
                for (int p = 0; p < 8; ++p) v[p] = vn[p];
            }
        }
    }
    { for (int i = blockIdx.x * 512 + opaque_tid(); i < NLAYER * 4 * 128 * 128; i += gridDim.x * 512) { const int c = i & 127, d = (i >> 7) & 127, lg = i >> 14;
        ((bf16_t*)(a.ws + WS_PWT))[i] = (bf16_t)(cvt_pk_bf16(a.in[4][((size_t)lg * 128 + c) * 128 + d], 0.f) & 0xffff); } }
    { const f32x4* ps = (const f32x4*)a.in[1]; u32x2* pd = (u32x2*)(a.ws + WS_PB); const int n4 = NLAYER * TT * PLE / 4;
      for (int i = blockIdx.x * 512 + opaque_tid(); i < n4; i += gridDim.x * 512) { const f32x4 v = ps[i]; u32x2 w; w.x = cvt_pk_bf16(v[0], v[1]); w.y = cvt_pk_bf16(v[2], v[3]); pd[i] = w; } }
    rows_bf16_ss(a.in[0], (bf16_t*)(a.ws + WS_H), (float*)(a.ws + WS_X));
}

__device__ __forceinline__ void pool_unit(unsigned char* lds, int tile, int gi, int L, const Args& a) {
    float* uw = (float*)lds; unsigned char* MX = lds + 47 * 128 * 4;
    const int tid = opaque_tid(), lane = tid & 63, wid = tid >> 6, r = lane & 31, hi = lane >> 5;
    const float* U = (const float*)(a.ws + WS_U);
    const int t0 = tile * 32, s0 = t0 & (SEQ - 1);
    for (int i = tid; i < 47 * 32; i += 512) { const int rr = i >> 5, c4 = i & 31; const int sp = s0 - 15 + rr;
        f32x4 v = (f32x4){0.f, 0.f, 0.f, 0.f};
        if (sp >= 0) v = *(const f32x4*)(U + (size_t)(t0 - 15 + rr) * 512 + gi * 128 + c4 * 4);
        ((f32x4*)uw)[i] = v; }
    bf16x8 bw[8];
    if (wid < 4) { const bf16_t* wp = (const bf16_t*)(a.ws + WS_PWT) + ((size_t)(L * 4 + gi) * 128 + 32 * wid + r) * 128 + 8 * hi;
#pragma unroll
        for (int ks = 0; ks < 8; ++ks) bw[ks] = *(const bf16x8*)(wp + 16 * ks); }
    __syncthreads();
    const int w = 2 << gi;
    for (int i = tid; i < 32 * 128; i += 512) { const int tt = i >> 7, c = i & 127; float s = 0.f;
        for (int j = 0; j < w; ++j) s += uw[(15 + tt - j) * 128 + c];
        const int cnt = min(s0 + tt + 1, w);
        *(bf16_t*)(MX + tt * 272 + c * 2) = (bf16_t)(cvt_pk_bf16(s / (float)cnt - uw[(15 + tt) * 128 + c], 0.f) & 0xffff); }
    __syncthreads();
    if (wid < 4) {
        f32x16 o;
#pragma unroll
        for (int j = 0; j < 16; ++j) o[j] = 0.f;
#pragma unroll
        for (int ks = 0; ks < 8; ++ks) { const bf16x8 am = *(const bf16x8*)(MX + r * 272 + (16 * ks + 8 * hi) * 2); o = MFMA32(am, bw[ks], o); }
        const int d = gi * 128 + 32 * wid + r;
        const float sc = a.in[5][(size_t)L * 512 + d];
        bf16_t* Y = (bf16_t*)(a.ws + WS_Y);
#pragma unroll
        for (int reg = 0; reg < 16; ++reg) Y[(size_t)(t0 + crow(reg, hi)) * 2048 + d] = (bf16_t)(cvt_pk_bf16(o[reg] * sc, 0.f) & 0xffff);
    }
    __syncthreads();
}

__device__ __forceinline__ void attn_unit(unsigned char* lds, int b, int h, int qb, const Args& a) {
    const bf16_t* SQ = (const bf16_t*)(a.ws + WS_SQ); const bf16_t* SK = (const bf16_t*)(a.ws + WS_SK); const bf16_t* VT = (const bf16_t*)(a.ws + WS_VT);
    bf16_t* Y = (bf16_t*)(a.ws + WS_Y);
    const int tid = opaque_tid(), lane = tid & 63, wid = tid >> 6, r = lane & 31, hi = lane >> 5;
    const int q0 = qb * 256, qw0 = q0 + wid * 32;
    const size_t rowbase = (size_t)b * SEQ;
    constexpr int KBY = 64 * 272, VBY = 128 * 144, BUF = KBY + VBY;
    volatile unsigned* FLG = (volatile unsigned*)(lds + 2 * BUF);
    bf16x8 qf[8];
    { const bf16_t* qp = SQ + (rowbase + qw0 + r) * 1024 + h * 128 + hi * 8;
#pragma unroll
      for (int ds = 0; ds < 8; ++ds) qf[ds] = *(const bf16x8*)(qp + ds * 16); }
    f32x16 o[4];
#pragma unroll
    for (int i = 0; i < 4; ++i)
#pragma unroll
        for (int j = 0; j < 16; ++j) o[i][j] = 0.f;
    float R = 1.f;
    const int jmax = qb * 4 + 3;
    u32x4 st[4];
#define ATT_LOAD(jj) do { _Pragma("unroll") for (int i = 0; i < 2; ++i) { const int ch = tid + 512 * i; \
        st[i] = *(const u32x4*)(SK + (rowbase + 64 * (jj) + (ch >> 4)) * 1024 + h * 128 + (ch & 15) * 8); \
        st[2 + i] = *(const u32x4*)(VT + (((size_t)(b * 8 + h) * 128 + (ch >> 3)) << 11) + 64 * (jj) + (ch & 7) * 8); } } while (0)
#define ATT_STORE(bufp) do { _Pragma("unroll") for (int i = 0; i < 2; ++i) { const int ch = tid + 512 * i; \
        *(u32x4*)((bufp) + (ch >> 4) * 272 + (ch & 15) * 16) = st[i]; *(u32x4*)((bufp) + KBY + (ch >> 3) * 144 + (ch & 7) * 16) = st[2 + i]; } } while (0)
    ATT_LOAD(jmax); ATT_STORE(lds);
    __syncthreads();
    for (int j = jmax; j >= 0; --j) {
        const int cur = (jmax - j) & 1;
        if (j > 0) ATT_LOAD(j - 1);
        if (64 * j <= qw0 + 31) {
            const unsigned char* Kb = lds + cur * BUF; const unsigned char* Vb = Kb + KBY;
            f32x16 p[2];
#pragma unroll
            for (int hh = 0; hh < 2; ++hh) {
#pragma unroll
                for (int jj = 0; jj < 16; ++jj) p[hh][jj] = 0.f;
#pragma unroll
                for (int ds = 0; ds < 8; ++ds) { const bf16x8 ka = *(const bf16x8*)(Kb + (32 * hh + r) * 272 + (16 * ds + 8 * hi) * 2); p[hh] = MFMA32(ka, qf[ds], p[hh]); }
            }
            const int t = qw0 + r; const int sbase = 64 * j + 4 * hi;
            float G[8];
#define ATT_ELEM(MASKED) \
            _Pragma("unroll") for (int hh = 0; hh < 2; ++hh) \
                _Pragma("unroll") for (int g = 0; g < 4; ++g) { \
                    float mm[4], bb[4]; \
                    _Pragma("unroll") for (int i = 0; i < 4; ++i) { const float uu = __builtin_amdgcn_exp2f(p[hh][4 * g + i]); \
                        const float mi = __builtin_amdgcn_rcpf(1.0f + uu); \
                        if (MASKED) { const int s = sbase + 32 * hh + 8 * g + i; const bool valid = s < t; mm[i] = valid ? mi : 1.0f; bb[i] = valid ? 1.0f - mi : 0.0f; } \
                        else { mm[i] = mi; bb[i] = 1.0f - mi; } } \
                    const float e2 = mm[3], e1 = mm[2] * e2, e0 = mm[1] * e1; \
                    G[hh * 4 + g] = mm[0] * e0; \
                    p[hh][4 * g + 0] = bb[0] * e0; p[hh][4 * g + 1] = bb[1] * e1; p[hh][4 * g + 2] = bb[2] * e2; p[hh][4 * g + 3] = bb[3]; \
                }
            if (64 * j + 63 < qw0) { ATT_ELEM(false) } else { ATT_ELEM(true) }
#undef ATT_ELEM
            float X = 1.0f;
#pragma unroll
            for (int idx = 7; idx >= 0; --idx) { const float gp = shflx(G[idx], 32, lane); const float f = X * (hi == 0 ? gp : 1.0f) * R;
                const int hh = idx >> 2, g = idx & 3;
#pragma unroll
                for (int i = 0; i < 4; ++i) p[hh][4 * g + i] *= f;
                X *= G[idx] * gp; }
            R *= X;
            bf16x8 pa[4];
#pragma unroll
            for (int kb = 0; kb < 4; ++kb) { const int hh = kb >> 1, b8 = (kb & 1) * 8;
                pa[kb] = pack8(p[hh][b8], p[hh][b8 + 1], p[hh][b8 + 2], p[hh][b8 + 3], p[hh][b8 + 4], p[hh][b8 + 5], p[hh][b8 + 6], p[hh][b8 + 7]); }
#pragma unroll
            for (int kb = 0; kb < 4; ++kb)
#pragma unroll
                for (int db = 0; db < 4; ++db) { const unsigned char* vp = Vb + (32 * db + r) * 144 + (16 * kb + 4 * hi) * 2;
                    const s16x4 lo = *(const s16x4*)vp, hi4 = *(const s16x4*)(vp + 16);
                    const bf16x8 vf = (bf16x8){lo[0], lo[1], lo[2], lo[3], hi4[0], hi4[1], hi4[2], hi4[3]};
                    o[db] = MFMA32(pa[kb], vf, o[db]); }
        }
        { const bool wdone = __builtin_amdgcn_ballot_w64(R != 0.0f) == 0ull;
          if (lane == 0) FLG[cur * 8 + wid] = wdone ? 1u : 0u; }
        if (j > 0) ATT_STORE(lds + (cur ^ 1) * BUF);
        __syncthreads();
        unsigned alld = 1u;
#pragma unroll
        for (int w = 0; w < 8; ++w) alld &= FLG[cur * 8 + w];
        if (alld) break;
    }
#undef ATT_LOAD
#undef ATT_STORE
#pragma unroll
    for (int db = 0; db < 4; ++db)
#pragma unroll
        for (int reg = 0; reg < 16; ++reg)
            Y[(rowbase + qw0 + crow(reg, hi)) * 2048 + 512 + h * 128 + 32 * db + r] = (bf16_t)(cvt_pk_bf16(o[db][reg], 0.f) & 0xffff);
    __syncthreads();
}

__device__ __forceinline__ void hgrn_prep_unit(unsigned char* lds, int bh, int c, int L, const Args& a) {
    const float* ZF = (const float*)(a.ws + WS_ZF); const float* HQ = (const float*)(a.ws + WS_HQ); const bf16_t* HV = (const bf16_t*)(a.ws + WS_HV);
    bf16_t* HQD = (bf16_t*)(a.ws + WS_HQD); bf16_t* HKD = (bf16_t*)(a.ws + WS_HKD); bf16_t* HVT = (bf16_t*)(a.ws + WS_HVT);
    float* HDEC = (float*)(a.ws + WS_HDEC); float* HOI = (float*)(a.ws + WS_HOI);
    const int b = bh >> 2, h = bh & 3;
    const int tid = opaque_tid(), lane = tid & 63, wid = tid >> 6, r = lane & 31, hi = lane >> 5;
    float* TOT = (float*)lds; unsigned char* QD = lds + 2048; unsigned char* KT = QD + 32 * 272; unsigned char* VTl = KT + 32 * 272;
    const int k = tid & 127, tq = tid >> 7;
    float lbA, lbB, oml;
    { const int ch = h * 128 + k; const float h0 = a.in[6][ch], h1 = a.in[6][512 + ch]; const float mxv = fmaxf(h0, h1);
      const float e0 = __expf(h0 - mxv), e1 = __expf(h1 - mxv); float lb = (L == 0) ? 0.f : e1 / (e0 + e1);
      lb = fminf(fmaxf(lb, 0.f), 1.f); lbA = fmaxf(lb, 1e-20f); lbB = 1.0f - fminf(lb, 1.0f - 1e-6f); oml = 1.0f - lb; }
    const size_t row0 = (size_t)b * SEQ + c * 32;
    const size_t gbase = (row0 + tq * 8) * 512 + h * 128 + k;
    const size_t fidx = (size_t)(bh * 64 + c) * 4096 + (size_t)((((k >> 5) * 2 + (tq >> 1)) * 64 + (tq & 1) * 32 + (k & 31)) * 8);
    float kk[8], bl[8], qv[8]; float bs = 0.f;
#pragma unroll
    for (int i = 0; i < 8; ++i) { float zf = ZF[gbase + (size_t)i * 512]; qv[i] = HQ[gbase + (size_t)i * 512];
        zf = fminf(fmaxf(zf, -80.f), 80.f); const float e = __expf(-zf); const float sg = __builtin_amdgcn_rcpf(1.0f + e);
        const float f = lbA + lbB * sg; bs += logf(f); bl[i] = bs; kk[i] = oml * e * sg; }
    TOT[tq * 128 + k] = bs;
    { unsigned short x[8];
#pragma unroll
      for (int i = 0; i < 8; ++i) x[i] = HV[gbase + (size_t)i * 512];
      u32x4 w; w.x = x[0] | ((unsigned)x[1] << 16); w.y = x[2] | ((unsigned)x[3] << 16); w.z = x[4] | ((unsigned)x[5] << 16); w.w = x[6] | ((unsigned)x[7] << 16);
      *(u32x4*)(VTl + k * 80 + tq * 16) = w; *(u32x4*)(HVT + fidx) = w; }
    __syncthreads();
    float off = 0.f, tot = 0.f;
#pragma unroll
    for (int q = 0; q < 4; ++q) { const float v = TOT[q * 128 + k]; tot += v; if (q < tq) off += v; }
    float kd[8];
#pragma unroll
    for (int i = 0; i < 8; ++i) { const float bt = off + bl[i]; const int t = tq * 8 + i;
        *(bf16_t*)(QD + t * 272 + k * 2) = (bf16_t)(cvt_pk_bf16(qv[i] * __expf(bt), 0.f) & 0xffff);
        *(bf16_t*)(KT + t * 272 + k * 2) = (bf16_t)(cvt_pk_bf16(kk[i] * __expf(fminf(-bt, 80.f)), 0.f) & 0xffff);
        kd[i] = kk[i] * __expf(tot - bt); }
    *(bf16x8*)(HKD + fidx) = pack8(kd[0], kd[1], kd[2], kd[3], kd[4], kd[5], kd[6], kd[7]);
    if (tq == 0) HDEC[(size_t)(bh * 64 + c) * 128 + k] = __expf(tot);
    __syncthreads();
    { const int k0 = 32 * (wid >> 1) + 16 * (wid & 1) + 4 * hi; const unsigned char* p = QD + r * 272 + k0 * 2;
      const s16x4 lo = *(const s16x4*)p, hi4 = *(const s16x4*)(p + 16);
      *(bf16x8*)(HQD + (size_t)(bh * 64 + c) * 4096 + (wid * 64 + lane) * 8) = (bf16x8){lo[0], lo[1], lo[2], lo[3], hi4[0], hi4[1], hi4[2], hi4[3]}; }
    if (wid < 4) {
        const int w = wid;
        f32x16 pt;
#pragma unroll
        for (int j = 0; j < 16; ++j) pt[j] = 0.f;
#pragma unroll
        for (int ks = 0; ks < 8; ++ks) { const bf16x8 ka = *(const bf16x8*)(KT + r * 272 + (16 * ks + 8 * hi) * 2); const bf16x8 qa = *(const bf16x8*)(QD + r * 272 + (16 * ks + 8 * hi) * 2);
            pt = MFMA32(ka, qa, pt); }
#pragma unroll
        for (int reg = 0; reg < 16; ++reg) { if (crow(reg, hi) > r) pt[reg] = 0.f; }
        const bf16x8 pa0 = pack8(pt[0], pt[1], pt[2], pt[3], pt[4], pt[5], pt[6], pt[7]);
        const bf16x8 pa1 = pack8(pt[8], pt[9], pt[10], pt[11], pt[12], pt[13], pt[14], pt[15]);
        f32x16 o;
#pragma unroll
        for (int j = 0; j < 16; ++j) o[j] = 0.f;
#pragma unroll
        for (int s16 = 0; s16 < 2; ++s16) { const unsigned char* vp = VTl + (32 * w + r) * 80 + (16 * s16 + 4 * hi) * 2;
            const s16x4 lo = *(const s16x4*)vp, hi4 = *(const s16x4*)(vp + 16);
            const bf16x8 vf = (bf16x8){lo[0], lo[1], lo[2], lo[3], hi4[0], hi4[1], hi4[2], hi4[3]};
            o = MFMA32(s16 ? pa1 : pa0, vf, o); }
#pragma unroll
        for (int reg = 0; reg < 16; ++reg) HOI[(row0 + crow(reg, hi)) * 512 + h * 128 + 32 * w + r] = o[reg];
    }
    __syncthreads();
}

__device__ __forceinline__ float dpp_sum16(float v) {
    v += __int_as_float(__builtin_amdgcn_update_dpp(0, __float_as_int(v), 0xB1, 0xF, 0xF, true));
    v += __int_as_float(__builtin_amdgcn_update_dpp(0, __float_as_int(v), 0x4E, 0xF, 0xF, true));
    v += __int_as_float(__builtin_amdgcn_update_dpp(0, __float_as_int(v), 0x141, 0xF, 0xF, true));
    v += __int_as_float(__builtin_amdgcn_update_dpp(0, __float_as_int(v), 0x140, 0xF, 0xF, true));
    return v;
}
__device__ __forceinline__ void hgrn_chain_unit(unsigned char* lds, int bh, int L, const Args& a) {
    const bf16_t* HQD = (const bf16_t*)(a.ws + WS_HQD); const bf16_t* HKD = (const bf16_t*)(a.ws + WS_HKD); const bf16_t* HVT = (const bf16_t*)(a.ws + WS_HVT);
    const float* HDEC = (const float*)(a.ws + WS_HDEC); const float* HOI = (const float*)(a.ws + WS_HOI);
    const bf16_t* OG = (const bf16_t*)(a.ws + WS_OG); bf16_t* Y = (bf16_t*)(a.ws + WS_Y);
    const int b = bh >> 2, h = bh & 3;
    const int tid = opaque_tid(), lane = tid & 63, wid = tid >> 6, r = lane & 31, hi = lane >> 5;
    constexpr int BUFB = 25088;
    float* OB = (float*)(lds + 3 * BUFB);
    f32x16 Sacc[4];
#pragma unroll
    for (int i = 0; i < 4; ++i)
#pragma unroll
        for (int j = 0; j < 16; ++j) Sacc[i][j] = 0.f;
    const size_t cb = (size_t)bh * 64;
    const size_t rowb = (size_t)b * SEQ;
    u32x4 stA[3], stB[3]; f32x4 sdA = (f32x4){0.f, 0.f, 0.f, 0.f}, sdB = sdA;
#define HG_LOAD(cc, st, sd) do { const int cc_ = (cc) < 63 ? (cc) : 63; const size_t e_ = (cb + cc_) * 4096 + (size_t)tid * 8; st[0] = *(const u32x4*)(HQD + e_); st[1] = *(const u32x4*)(HKD + e_); st[2] = *(const u32x4*)(HVT + e_); \
        sd = *(const f32x4*)(HDEC + (cb + cc_) * 128 + (tid & 31) * 4); } while (0)
#define HG_STORE(bi, st, sd) do { unsigned char* B_ = lds + (bi) * BUFB; *(u32x4*)(B_ + tid * 16) = st[0]; *(u32x4*)(B_ + 8192 + tid * 16) = st[1]; *(u32x4*)(B_ + 16384 + tid * 16) = st[2]; \
        if (tid < 32) *(f32x4*)(B_ + 24576 + tid * 16) = sd; } while (0)
    HG_LOAD(0, stA, sdA); HG_STORE(0, stA, sdA); HG_LOAD(1, stA, sdA); HG_STORE(1, stA, sdA);
    HG_LOAD(2, stB, sdB);
    const int pt_ = tid >> 4, seg = tid & 15; const int ch = h * 128 + seg * 8;
    const float* gn = a.in[7] + (size_t)L * 512 + ch; const f32x4 g0 = *(const f32x4*)gn, g1 = *(const f32x4*)(gn + 4);
    f32x4 oiA0, oiA1, oiB0, oiB1; u32x4 ogA, ogB;
#define HG_PLOAD(cc, o0, o1, og_) do { const int cp_ = (cc) < 63 ? (cc) : 63; const size_t row_ = rowb + cp_ * 32 + pt_; o0 = *(const f32x4*)(HOI + row_ * 512 + ch); o1 = *(const f32x4*)(HOI + row_ * 512 + ch + 4); og_ = *(const u32x4*)(OG + row_ * 512 + ch); } while (0)
    HG_PLOAD(0, oiA0, oiA1, ogA);
    __syncthreads();
#define HG_ITER(c, stX, sdX, stY, sdY, oiC0, oiC1, ogC, oiN0, oiN1, ogN) do { \
        const int bi = (c) % 3; \
        HG_LOAD((c) + 3, stX, sdX); \
        HG_PLOAD((c) + 1, oiN0, oiN1, ogN); \
        if (wid < 4) { \
            const int w = wid; const unsigned char* B = lds + bi * BUFB; \
            f32x16 o, o2; \
            _Pragma("unroll") for (int j = 0; j < 16; ++j) { o[j] = 0.f; o2[j] = 0.f; } \
            _Pragma("unroll") for (int kb = 0; kb < 4; ++kb) \
                _Pragma("unroll") for (int s16 = 0; s16 < 2; ++s16) { const bf16x8 aq = *(const bf16x8*)(B + ((kb * 2 + s16) * 64 + lane) * 16); const int b8 = 8 * s16; \
                    const bf16x8 bsv = pack8(Sacc[kb][b8], Sacc[kb][b8 + 1], Sacc[kb][b8 + 2], Sacc[kb][b8 + 3], Sacc[kb][b8 + 4], Sacc[kb][b8 + 5], Sacc[kb][b8 + 6], Sacc[kb][b8 + 7]); \
                    if (kb < 2) o = MFMA32(aq, bsv, o); else o2 = MFMA32(aq, bsv, o2); } \
            _Pragma("unroll") for (int kb = 0; kb < 4; ++kb) { \
                _Pragma("unroll") for (int g = 0; g < 4; ++g) { const f32x4 dd = *(const f32x4*)(B + 24576 + (32 * kb + 8 * g + 4 * hi) * 4); \
                    _Pragma("unroll") for (int i = 0; i < 4; ++i) Sacc[kb][4 * g + i] *= dd[i]; } \
                _Pragma("unroll") for (int s16 = 0; s16 < 2; ++s16) { const bf16x8 ka = *(const bf16x8*)(B + 8192 + ((kb * 2 + s16) * 64 + lane) * 16); \
                    const bf16x8 va = *(const bf16x8*)(B + 16384 + ((w * 2 + s16) * 64 + lane) * 16); \
                    Sacc[kb] = MFMA32(ka, va, Sacc[kb]); } \
            } \
            _Pragma("unroll") for (int reg = 0; reg < 16; ++reg) OB[crow(reg, hi) * 132 + 32 * w + r] = o[reg] + o2[reg]; \
        } \
        __syncthreads(); \
        { const size_t row = rowb + (c) * 32 + pt_; const float* op = OB + pt_ * 132 + seg * 8; \
          const f32x4 x0 = *(const f32x4*)op + oiC0, x1 = *(const f32x4*)(op + 4) + oiC1; \
          float ss = (x0[0] * x0[0] + x0[1] * x0[1]) + (x0[2] * x0[2] + x0[3] * x0[3]) + (x1[0] * x1[0] + x1[1] * x1[1]) + (x1[2] * x1[2] + x1[3] * x1[3]); \
          ss = dpp_sum16(ss); \
          const float rstd = __builtin_amdgcn_rsqf(ss * (1.0f / 128.0f) + EPS); \
          f32x4 y0, y1; \
          y0[0] = x0[0] * rstd * g0[0] * bflo(ogC.x); y0[1] = x0[1] * rstd * g0[1] * bfhi(ogC.x); y0[2] = x0[2] * rstd * g0[2] * bflo(ogC.y); y0[3] = x0[3] * rstd * g0[3] * bfhi(ogC.y); \
          y1[0] = x1[0] * rstd * g1[0] * bflo(ogC.z); y1[1] = x1[1] * rstd * g1[1] * bfhi(ogC.z); y1[2] = x1[2] * rstd * g1[2] * bflo(ogC.w); y1[3] = x1[3] * rstd * g1[3] * bfhi(ogC.w); \
          *(u32x4*)(Y + row * 2048 + 1536 + ch) = pack8v(y0, y1); } \
        HG_STORE(((c) + 2) % 3, stY, sdY); \
        __syncthreads(); \
    } while (0)
    for (int c = 0; c < 64; c += 2) {
        HG_ITER(c, stA, sdA, stB, sdB, oiA0, oiA1, ogA, oiB0, oiB1, ogB);
        HG_ITER(c + 1, stB, sdB, stA, sdA, oiB0, oiB1, ogB, oiA0, oiA1, ogA);
    }
#undef HG_ITER
#undef HG_PLOAD
#undef HG_LOAD
#undef HG_STORE
}

#define WQ_NEXT(cw) ({ if (threadIdx.x == 0) sh[0] = atomicAdd((cw), 1u); __syncthreads(); const int u_ = (int)sh[0]; __syncthreads(); u_; })
constexpr int INP_MAIN_COLT = 32;
__device__ __forceinline__ void mixer_phase(const Args& a, unsigned char* lds, int L, int mp, int rep) {
    unsigned* ctr = (unsigned*)(a.ws + WS_CTL) + 64 * (L * 4 + mp * 2 + rep);
    volatile unsigned* sh = (volatile unsigned*)(lds + LDS_MISC);
    if (mp == 0) {
        for (;;) { const int u = WQ_NEXT(ctr); if (u >= 2048) break;
            if (u < 1024) hgrn_prep_unit(lds, u >> 6, u & 63, L, a);
            else { const int x = u - 1024; pool_unit(lds, x >> 2, x & 3, L, a); } }
    } else {
        { const int u = WQ_NEXT(ctr); if (u < 16) { hgrn_chain_unit(lds, u, L, a); if (CHAIN_TWICE) { __syncthreads(); hgrn_chain_unit(lds, u, L, a); } } }
        for (;;) { const int x = WQ_NEXT(ctr + 8); if (x >= 32 * (46 - INP_MAIN_COLT)) break;
            pg8::Gemm g{(const bf16_t*)(a.ws + WS_H), (const bf16_t*)(a.ws + WS_W0 + (size_t)L * WL_SIZE + WL_IN), TT, INC, DM, DM, 1, 0, 0, 0, DM / 64, 0, 0};
            pg8::OneUnit S1{x / (46 - INP_MAIN_COLT), INP_MAIN_COLT + x % (46 - INP_MAIN_COLT)};
            EpiIn E{a.ws, 3 * L * TT};
            pg8::gemm_phase((PG8_LAS unsigned char*)lds, g, S1, E); }
        for (;;) { const int x = WQ_NEXT(ctr + 16); if (x >= 256) break;
            attn_unit(lds, (x & 31) >> 3, x & 7, 7 - (x >> 5), a); }
    }
}
__device__ __forceinline__ void pp_queue(const Args& a, unsigned char* lds, int L) {
    unsigned* ctr = (unsigned*)(a.ws + WS_CTL) + 64 * (L * 4 + 2) + 24;
    volatile unsigned* sh = (volatile unsigned*)(lds + LDS_MISC);
    for (;;) { const int x = WQ_NEXT(ctr); if (x >= 256) break;
        pg8::Gemm g{(const bf16_t*)(a.ws + WS_PB) + (size_t)L * TT * PLE, (const bf16_t*)(a.ws + WS_W0 + (size_t)L * WL_SIZE + WL_PP), TT, DM, PLE, PLE, 1, 0, 0, 0, PLE / 64, 0, 0};
        pg8::OneUnit S1{x >> 3, x & 7};
        EpiBf16 E{a.ws};
        pg8::gemm_phase((PG8_LAS unsigned char*)lds, g, S1, E); }
}

#define LAS __attribute__((address_space(3)))
#define XB_TMO      128
#define XB_XCNT(j)  (256  + 64 * (j))
#define XB_XSUB(j)  (1280 + 64 * (j))
#define XB_XGEN(j)  (2304 + 64 * (j))
#define XB_TOP      3328
#define XB_TOPGEN   3392
#define XCD_BAR_WORDS 3456
#define XB_SPIN_CAP (1u << 20)
__device__ __forceinline__ unsigned xb_ld(unsigned* p)              { return __hip_atomic_load(p, __ATOMIC_RELAXED, __HIP_MEMORY_SCOPE_AGENT); }
__device__ __forceinline__ unsigned xb_add(unsigned* p, unsigned v) { return __hip_atomic_fetch_add(p, v, __ATOMIC_RELAXED, __HIP_MEMORY_SCOPE_AGENT); }
__device__ __forceinline__ unsigned xb_xcc_id() { return (unsigned)__builtin_amdgcn_s_getreg((3 << 11) | 20) & 0xFu; }
#define XB_SPIN(cond, bar) do { unsigned _sp = 0; while (cond) { __builtin_amdgcn_s_sleep(1); \
    if ((++_sp & 255u) == 0u) { if (xb_ld(&(bar)[XB_TMO])) break; if (_sp > XB_SPIN_CAP) { atomicAdd(&(bar)[XB_TMO], 1u); break; } } } } while (0)
struct XcdBarrier { unsigned* bar; unsigned x; volatile LAS unsigned* st; };
__device__ __forceinline__ XcdBarrier xcd_barrier_post(unsigned* bar, volatile LAS unsigned* st) {
    XcdBarrier b; b.bar = bar; b.x = xb_xcc_id(); b.st = st;
    if (threadIdx.x == 0) (void)xb_add(&bar[XB_XCNT(b.x)], 1u);
    return b;
}
__device__ __forceinline__ void xcd_barrier_complete(unsigned* bar, unsigned x, unsigned& nloc, unsigned& nx) {
    const unsigned G = gridDim.x * gridDim.y * gridDim.z;
    unsigned sum, cnt, mine, sp = 0u;
    for (;;) {
        sum = 0u; cnt = 0u; mine = 0u;
#pragma nounroll
        for (unsigned j = 0; j < 16; ++j) { const unsigned c = xb_ld(&bar[XB_XCNT(j)]); sum += c; cnt += (c > 0u) ? 1u : 0u; mine = (j == x) ? c : mine; }
        if (sum == G) break;
        __builtin_amdgcn_s_sleep(1);
        if ((++sp & 255u) == 0u) { if (xb_ld(&bar[XB_TMO])) break; if (sp > XB_SPIN_CAP) { atomicAdd(&bar[XB_TMO], 1u); break; } }
    }
    nloc = mine > 0u ? mine : 1u; nx = cnt > 0u ? cnt : 1u;
}
__device__ __forceinline__ void xcd_barrier(const XcdBarrier& b) {
    asm volatile("s_waitcnt vmcnt(0)" ::: "memory");
    __syncthreads();
    if (threadIdx.x == 0) {
        unsigned* bar = b.bar; asm volatile("" : "+s"(bar));
        __builtin_amdgcn_s_waitcnt(0);
        unsigned nloc = b.st[0], nx = b.st[1];
        if (nloc == 0u) { xcd_barrier_complete(bar, b.x, nloc, nx); b.st[0] = nloc; b.st[1] = nx; }
        const unsigned old = xb_add(&bar[XB_XSUB(b.x)], 1u);
        const unsigned gen = old / nloc;
        if (old + 1u == (gen + 1u) * nloc) {
            __builtin_amdgcn_fence(__ATOMIC_RELEASE, "agent");
            asm volatile("s_waitcnt vmcnt(0)" ::: "memory");
            const unsigned og = xb_add(&bar[XB_TOP], 1u);
            const unsigned tg = og / nx;
            if (og + 1u == (tg + 1u) * nx) xb_add(&bar[XB_TOPGEN], 1u);
            else XB_SPIN(xb_ld(&bar[XB_TOPGEN]) == tg, bar);
            __builtin_amdgcn_fence(__ATOMIC_ACQUIRE, "agent");
            xb_add(&bar[XB_XGEN(b.x)], 1u);
            asm volatile("s_waitcnt vmcnt(0)" ::: "memory");
        } else {
            XB_SPIN(xb_ld(&bar[XB_XGEN(b.x)]) == gen, bar);
            __builtin_amdgcn_fence(__ATOMIC_ACQUIRE, "agent");
            asm volatile("s_waitcnt vmcnt(0)" ::: "memory");
        }
    }
    __syncthreads();
}

typedef const Args __attribute__((address_space(4)))* KArgP;
#define LOAD_ARGS KArgP ap = (KArgP)__builtin_amdgcn_kernarg_segment_ptr(); asm volatile("" : "+s"(ap)); Args A; \
    _Pragma("unroll") for (int i_ = 0; i_ < 19; ++i_) A.in[i_] = ap->in[i_]; A.out = ap->out; A.ws = ap->ws; A.ph_lo = 0; A.ph_hi = 0;
__global__ void __launch_bounds__(512, 2) mega(Args a) {
    extern __shared__ __attribute__((aligned(16))) unsigned char lds[];
    cg::grid_group grid = cg::this_grid();
    PG8_LAS unsigned char* lds3 = (PG8_LAS unsigned char*)lds;
    const int G = gridDim.x, bx = blockIdx.x;
    if (threadIdx.x == 0) { ((volatile LAS unsigned*)((LAS unsigned char*)lds + LDS_MISC))[8] = 0u; ((volatile LAS unsigned*)((LAS unsigned char*)lds + LDS_MISC))[9] = 0u; }
    __syncthreads();
    XcdBarrier xbar = xcd_barrier_post((unsigned*)(a.ws + WS_CTL) + 1024, (volatile LAS unsigned*)((LAS unsigned char*)lds + LDS_MISC) + 8);
    constexpr int ph_hi_ = NPHASE;
#pragma nounroll
    for (int ph = 0; ph < ph_hi_; ++ph) {
      const int nrep = 1 + ((ph == 0 ? (REP_MASK >> 15) : (ph == NPHASE - 1 ? 0 : (REP_MASK >> ((ph - 1) % PPL)))) & 1);
      for (int rep = 0; rep < nrep; ++rep) {
        if (ph == 0) { if (PHMASK & 0x8000) { LOAD_ARGS prologue_phase(A, lds); } }
        else if (ph == NPHASE - 1) { if (PHMASK & 0x4000) { LOAD_ARGS final_norm_rows((const bf16_t*)(A.ws + WS_H), (const float*)(A.ws + WS_X) + (size_t)(3 * NLAYER) * TT * 8, A.in[18], A.out); } }
        else {
            const int L = (ph - 1) / PPL, s = (ph - 1) % PPL;
            if (s == 0) { if (PHMASK & (1 << 0)) {
                LOAD_ARGS unsigned char* wl = A.ws + WS_W0 + (size_t)L * WL_SIZE;
                pg8::Gemm g{(const bf16_t*)(A.ws + WS_H), (const bf16_t*)(wl + WL_IN), TT, INC, DM, DM, 1, 0, 0, 0, DM / 64, 0, 0};
                pg8::StaticOrder S; S.init(TT, INP_MAIN_COLT * 256, G, bx, 1);
                EpiIn E{A.ws, 3 * L * TT};
                pg8::gemm_phase(lds3, g, S, E);
            }} else if (s == 1) { if (PHMASK & (1 << 1)) {
                LOAD_ARGS mixer_phase(A, lds, L, 0, rep);
            }} else if (s == 2) { if (PHMASK & (1 << 2)) {
                LOAD_ARGS mixer_phase(A, lds, L, 1, rep);
            }} else if (s == 3) { if (PHMASK & (1 << 3)) {
                LOAD_ARGS unsigned char* wl = A.ws + WS_W0 + (size_t)L * WL_SIZE;
                pg8::Gemm g{(const bf16_t*)(A.ws + WS_Y), (const bf16_t*)(wl + WL_BR), TT, DM, DM, DM, 3, 0, 512, 1536, 8, 16, 8};
                pg8::StaticOrder S; S.init(TT, DM, G, bx, 3);
                EpiBranch E{A.ws};
                pg8::gemm_phase(lds3, g, S, E);
            }} else if (s == 4) { if (PHMASK & (1 << 4)) {
                LOAD_ARGS unsigned char* wl = A.ws + WS_W0 + (size_t)L * WL_SIZE;
                pg8::Gemm g{(const bf16_t*)(A.ws + WS_MIX), (const bf16_t*)(wl + WL_OUT), TT, DM, DM, DM, 1, 0, 0, 0, DM / 64, 0, 0};
                pg8::StaticOrder S; S.init(TT, DM, G, bx, 1);
                EpiResid E{A.ws, 0, 0, (3 * L + 1) * TT};
                pg8::gemm_phase(lds3, g, S, E);
            }} else if (s == 5) { if (PHMASK & (1 << 5)) {
                LOAD_ARGS unsigned char* wl = A.ws + WS_W0 + (size_t)L * WL_SIZE;
                pg8::Gemm g{(const bf16_t*)(A.ws + WS_H), (const bf16_t*)(wl + WL_GU), TT, 2 * DFF, DM, DM, 1, 0, 0, 0, DM / 64, 0, 0};
                pg8::StaticOrder S; S.init(TT, 2 * DFF, G, bx, 1);
                EpiSwiglu E{A.ws, (3 * L + 1) * TT};
                pg8::gemm_phase(lds3, g, S, E);
                if (rep == 0) pp_queue(A, lds, L);
            }} else if (s == 6) { if (PHMASK & (1 << 6)) {
                LOAD_ARGS unsigned char* wl = A.ws + WS_W0 + (size_t)L * WL_SIZE;
                pg8::Gemm g{(const bf16_t*)(A.ws + WS_ACT), (const bf16_t*)(wl + WL_DN), TT, DM, DFF, DFF, 1, 0, 0, 0, DFF / 64, 0, 0};
                pg8::StaticOrder S; S.init(TT, DM, G, bx, 1);
                EpiResid E{A.ws, 0, (int)(WS_HB - WS_H), (3 * L + 2) * TT};
                pg8::gemm_phase(lds3, g, S, E);
            }} else { if (PHMASK & (1 << 7)) {
                LOAD_ARGS unsigned char* wl = A.ws + WS_W0 + (size_t)L * WL_SIZE;
                pg8::Gemm g{(const bf16_t*)(A.ws + WS_HB), (const bf16_t*)(wl + WL_PG), TT, DM, DM, DM, 1, 0, 0, 0, DM / 64, 0, 0};
                pg8::StaticOrder S; S.init(TT, DM, G, bx, 1);
                EpiPle E{A.ws, (3 * L + 2) * TT};
                pg8::gemm_phase(lds3, g, S, E);
            }}
        }
        if (ph + 1 < ph_hi_ || rep + 1 < nrep) { if (ph == 0) grid.sync(); else xcd_barrier(xbar); }
      }
    }
    for (int i = 0; i < EXTRA_SYNCS; ++i) xcd_barrier(xbar);
}

extern "C" void kernel_launch(void* const* d_in, const int* in_sizes, int n_in, void* d_out, int out_size, void* d_ws, size_t ws_size, hipStream_t stream) {
    static int grid = 0;
    if (grid == 0) {
        if (n_in != 19 || out_size != TT * DM || ws_size < WS_END) { fprintf(stderr, "kernel_launch: unexpected problem (n_in %d out %d ws %zu need %zu)\n", n_in, out_size, ws_size, (size_t)WS_END); grid = -1; return; }
        int dev = 0, cus = 0, per_cu = 0;
        hipGetDevice(&dev); hipDeviceGetAttribute(&cus, hipDeviceAttributeMultiprocessorCount, dev);
        if (hipFuncSetAttribute((const void*)mega, hipFuncAttributeMaxDynamicSharedMemorySize, LDS_BYTES) != hipSuccess) { fprintf(stderr, "kernel_launch: hipFuncSetAttribute failed\n"); grid = -1; return; }
        if (hipOccupancyMaxActiveBlocksPerMultiprocessor(&per_cu, (const void*)mega, 512, LDS_BYTES) != hipSuccess || per_cu < 1) { fprintf(stderr, "kernel_launch: occupancy query gave %d\n", per_cu); per_cu = 1; }
        (void)hipGetLastError();
        grid = cus * per_cu;
        fprintf(stderr, "kernel_launch: grid %d (cus %d x %d)\n", grid, cus, per_cu);
    }
    if (grid < 0) return;
    (void)hipMemsetAsync((char*)d_ws + WS_CTL, 0, CTL_ZERO, stream);
    Args a{};
    for (int i = 0; i < 19; ++i) a.in[i] = (const float*)d_in[i];
    a.out = (float*)d_out; a.ws = (unsigned char*)d_ws;
#if MK_MULTI
    for (int ph = 0; ph < NPHASE; ++ph) { a.ph_lo = ph; a.ph_hi = ph + 1; hipLaunchKernelGGL(mega, dim3(grid), dim3(512), LDS_BYTES, stream, a); }
#else
    a.ph_lo = 0; a.ph_hi = NPHASE;
    void* args[] = {&a};
    hipError_t e = hipLaunchCooperativeKernel((const void*)mega, dim3(grid), dim3(512), args, LDS_BYTES, stream);
    if (e != hipSuccess) fprintf(stderr, "kernel_launch: cooperative launch failed: %s (grid %d)\n", hipGetErrorString(e), grid);
#endif
}
```
